# Optimizing an MI355X kernel written in HIP

```python
import jax
import jax.numpy as jnp
from jax import lax

D_MODEL = 1024
BATCH = 32
SEQ = 256
DEPTH = 1
DEC_BATCH = 4
DEC_SEQ = 2048
PAST_LEN = 256

GRID_W = 64
D_MIX = D_MODEL
M_HEADS = 4
M_HEAD_DIM = 128
M_WIDTH = M_HEADS * M_HEAD_DIM
M_CHUNK = 64
A_HEADS = 8
A_NOPE = 64
A_ROPE = 32
A_QK = A_NOPE + A_ROPE
A_VDIM = 64
A_WIDTH = A_HEADS * A_VDIM
Q_LORA = 384
KV_LORA = 256
ROPE_BASE = 10000.0
D_FF = 4 * D_MODEL
EPS = 1e-6
Q_BLOCK = 128
IN_SIZES = (M_WIDTH, M_WIDTH, M_WIDTH, M_WIDTH, 4 * M_HEADS, Q_LORA, KV_LORA, A_ROPE)
N_IN = 4 * M_WIDTH + 4 * M_HEADS + Q_LORA + KV_LORA + A_ROPE

kernel_name = "hymba_mlstm_mla_prefix_diffusion_step"


def _rmsnorm(x, g):
    xf = x.astype(jnp.float32)
    y = xf * lax.rsqrt(jnp.mean(xf * xf, axis=-1, keepdims=True) + EPS)
    return (y * g.astype(jnp.float32)).astype(x.dtype)


def _split_cols(a, sizes):
    idx, acc = [], 0
    for s in sizes[:-1]:
        acc += s
        idx.append(acc)
    return jnp.split(a, idx, axis=-1)


def _rope_2d(rows):
    row = jnp.repeat(jnp.arange(rows, dtype=jnp.float32), GRID_W)
    col = jnp.tile(jnp.arange(GRID_W, dtype=jnp.float32), rows)
    half = A_ROPE // 2
    inv = ROPE_BASE ** (-jnp.arange(0, half, 2, dtype=jnp.float32) / half)
    ang = jnp.concatenate([row[:, None] * inv, col[:, None] * inv], axis=-1)
    return jnp.cos(ang), jnp.sin(ang)


def _apply_rope(x, cos, sin):
    x1, x2 = jnp.split(x, 2, axis=-1)
    c = cos[:, None, :].astype(x.dtype)
    s = sin[:, None, :].astype(x.dtype)
    return jnp.concatenate([x1 * c - x2 * s, x1 * s + x2 * c], axis=-1)


def _mlstm_chunkwise(q, k, v, ig, lf, C0, n0, m0):
    B, H, T, Dh = q.shape
    nc = T // M_CHUNK
    L = M_CHUNK

    def to_chunks(a):
        return jnp.moveaxis(a.reshape(B, H, nc, L, *a.shape[3:]), 2, 0)

    tril = jnp.tril(jnp.ones((L, L), dtype=bool))

    def step(carry, inp):
        C, n, m = carry
        qc, kc, vc, ic, fc = inp
        b = jnp.cumsum(fc, axis=-1)
        dmat = b[..., :, None] - b[..., None, :] + ic[..., None, :]
        dmat = jnp.where(tril, dmat, -jnp.inf)
        m_inter = b + m[..., None]
        m_t = jnp.maximum(m_inter, jnp.max(dmat, axis=-1))
        w_intra = jnp.exp(dmat - m_t[..., None])
        w_inter = jnp.exp(m_inter - m_t)
        s = jnp.einsum('bhtk,bhsk->bhts', qc, kc) * w_intra
        num = jnp.einsum('bhts,bhsv->bhtv', s, vc) + w_inter[..., None] * jnp.einsum('bhtk,bhkv->bhtv', qc, C)
        den = jnp.sum(s, axis=-1) + w_inter * jnp.einsum('bhtk,bhk->bht', qc, n)
        h = num / jnp.maximum(jnp.abs(den), jnp.exp(-m_t))[..., None]
        b_last = b[..., -1]
        log_w = b_last[..., None] - b + ic
        m_new = jnp.maximum(b_last + m, jnp.max(log_w, axis=-1))
        w = jnp.exp(log_w - m_new[..., None])
        decay = jnp.exp(b_last + m - m_new)
        C_new = decay[..., None, None] * C + jnp.einsum('bhs,bhsk,bhsv->bhkv', w, kc, vc)
        n_new = decay[..., None] * n + jnp.einsum('bhs,bhsk->bhk', w, kc)
        return (C_new, n_new, m_new), h

    carry0 = (C0.astype(jnp.float32), n0.astype(jnp.float32), m0.astype(jnp.float32))
    (C, n, m), hs = lax.scan(step, carry0, (to_chunks(q), to_chunks(k), to_chunks(v), to_chunks(ig), to_chunks(lf)))
    h = jnp.moveaxis(hs, 0, 2).reshape(B, H, T, Dh)
    return h, (C, n, m)


def _mlstm_bidir(q, k, v, ig, fg, C0, n0, m0):
    qh = jnp.transpose(q.astype(jnp.float32), (0, 2, 1, 3))
    kh = jnp.transpose(k.astype(jnp.float32), (0, 2, 1, 3)) * (M_HEAD_DIM ** -0.5)
    vh = jnp.transpose(v.astype(jnp.float32), (0, 2, 1, 3))
    ig = jnp.transpose(ig, (0, 2, 3, 1))
    lf = jax.nn.log_sigmoid(jnp.transpose(fg, (0, 2, 3, 1)))
    flip = lambda a: jnp.flip(a, axis=2)
    h_f, (Cf, nf, mf) = _mlstm_chunkwise(qh, kh, vh, ig[:, 0], lf[:, 0], C0[:, 0], n0[:, 0], m0[:, 0])
    h_b, (Cb, nb, mb) = _mlstm_chunkwise(flip(qh), flip(kh), flip(vh), flip(ig[:, 1]), flip(lf[:, 1]),
                                         C0[:, 1], n0[:, 1], m0[:, 1])
    h = jnp.transpose(h_f + flip(h_b), (0, 2, 1, 3))
    return h, jnp.stack([Cf, Cb], axis=1), jnp.stack([nf, nb], axis=1), jnp.stack([mf, mb], axis=1)


def _mla_queries(q_lat, q_lora_g, w_q_up, q_head_g, rope):
    B, T, _ = q_lat.shape
    q = (_rmsnorm(q_lat, q_lora_g) @ w_q_up).reshape(B, T, A_HEADS, A_QK)
    q = _rmsnorm(q, q_head_g)
    if rope is not None:
        q = jnp.concatenate([q[..., :A_NOPE], _apply_rope(q[..., A_NOPE:], *rope)], axis=-1)
    return q


def _mla_keys_values(ckv, k_rope, w_kv_up, k_head_g, rope):
    B, T, _ = ckv.shape
    kv = (ckv @ w_kv_up).reshape(B, T, A_HEADS, A_NOPE + A_VDIM)
    k_nope, v = kv[..., :A_NOPE], kv[..., A_NOPE:]
    k = jnp.concatenate([k_nope, jnp.broadcast_to(k_rope[:, :, None, :], (B, T, A_HEADS, A_ROPE))], axis=-1)
    k = _rmsnorm(k, k_head_g)
    if rope is not None:
        k = jnp.concatenate([k[..., :A_NOPE], _apply_rope(k[..., A_NOPE:], *rope)], axis=-1)
    return k, v


def _block_attention(q, k, v):
    B, Tq, H, Dq = q.shape
    nb = Tq // Q_BLOCK
    scale = Dq ** -0.5
    qb = jnp.moveaxis(q.astype(jnp.float32).reshape(B, nb, Q_BLOCK, H, Dq), 1, 0)
    kf = k.astype(jnp.float32)
    vf = v.astype(jnp.float32)

    def one(qi):
        s = jnp.einsum('bqhd,bkhd->bhqk', qi, kf) * scale
        p = jax.nn.softmax(s, axis=-1)
        return jnp.einsum('bhqk,bkhd->bqhd', p, vf)

    out = lax.map(one, qb)
    return jnp.moveaxis(out, 0, 1).reshape(B, Tq, H, v.shape[-1]).astype(q.dtype)


def _layer(x, cond, ctx_C, ctx_n, ctx_m, ctx_ckv, ctx_krope, rope,
           norm1_g, norm2_g, w_ada, b_ada, w_in, mlstm_gate_b, mlstm_norm_g,
           q_lora_g, kv_lora_g, w_q_up, w_kv_up, q_head_g, k_head_g, w_out, w_mlp_up, w_mlp_down):
    B, T, _ = x.shape
    mod = (jax.nn.silu(cond) @ w_ada + b_ada)[..., None, :]
    sh1, sc1, g1, sh2, sc2, g2 = jnp.split(mod, 6, axis=-1)
    h = _rmsnorm(x, norm1_g) * (1 + sc1) + sh1
    mq, mk, mv, mo, gates, q_lat, kv_lat, k_rope = _split_cols(h @ w_in, IN_SIZES)
    gates = (gates + mlstm_gate_b).astype(jnp.float32).reshape(B, T, 2, 2, M_HEADS)
    hm, C_new, n_new, m_new = _mlstm_bidir(mq.reshape(B, T, M_HEADS, M_HEAD_DIM),
                                           mk.reshape(B, T, M_HEADS, M_HEAD_DIM),
                                           mv.reshape(B, T, M_HEADS, M_HEAD_DIM),
                                           gates[:, :, :, 0], gates[:, :, :, 1], ctx_C, ctx_n, ctx_m)
    hm = _rmsnorm(hm, mlstm_norm_g.reshape(M_HEADS, M_HEAD_DIM)).astype(x.dtype)
    hm = (hm * jax.nn.sigmoid(mo.reshape(B, T, M_HEADS, M_HEAD_DIM))).reshape(B, T, M_WIDTH)
    ckv = _rmsnorm(kv_lat, kv_lora_g)
    q = _mla_queries(q_lat, q_lora_g, w_q_up, q_head_g, rope)
    k, v = _mla_keys_values(ckv, k_rope, w_kv_up, k_head_g, rope)
    if ctx_ckv is not None:
        kc, vc = _mla_keys_values(ctx_ckv, ctx_krope, w_kv_up, k_head_g, None)
        k = jnp.concatenate([k, kc.astype(k.dtype)], axis=1)
        v = jnp.concatenate([v, vc.astype(v.dtype)], axis=1)
    ha = _block_attention(q, k, v).reshape(B, T, A_WIDTH)
    x = x + g1 * (jnp.concatenate([hm, ha], axis=-1) @ w_out)
    h2 = _rmsnorm(x, norm2_g) * (1 + sc2) + sh2
    x = x + g2 * (jnp.square(jax.nn.relu(h2 @ w_mlp_up)) @ w_mlp_down)
    return x, (ckv, k_rope, C_new, n_new, m_new)


def setup_inputs(seed: int = 0) -> dict:
    key = jax.random.key(seed)
    ks = jax.random.split(key, 32)
    f32 = jnp.float32

    def nrm(k, shape, s):
        return s * jax.random.normal(k, shape, f32)

    L = DEPTH
    i_bias = nrm(ks[20], (L, 2, 1, M_HEADS), 0.1)
    f_bias = jnp.linspace(3.0, 6.0, M_HEADS, dtype=f32) + nrm(ks[21], (L, 2, 1, M_HEADS), 0.1)
    return {
        "x_prompt": nrm(ks[0], (BATCH, SEQ, D_MODEL), 1.0),
        "x_sample": nrm(ks[1], (DEC_BATCH, DEC_SEQ, D_MODEL), 1.0),
        "cache_mla_ckv": nrm(ks[2], (DEC_BATCH, L, PAST_LEN, KV_LORA), 1.0),
        "cache_mla_krope": nrm(ks[3], (DEC_BATCH, L, PAST_LEN, A_ROPE), 1.0),
        "state_mlstm_C": nrm(ks[4], (DEC_BATCH, L, 2, M_HEADS, M_HEAD_DIM, M_HEAD_DIM), 0.05),
        "state_mlstm_n": nrm(ks[5], (DEC_BATCH, L, 2, M_HEADS, M_HEAD_DIM), 0.5),
        "state_mlstm_m": jax.random.uniform(ks[6], (DEC_BATCH, L, 2, M_HEADS), f32, -1.0, 2.0),
        "c": nrm(ks[7], (DEC_BATCH, D_MODEL), 1.0),
        "c_ctx": nrm(ks[8], (D_MODEL,), 1.0),
        "norm1_g": 1.0 + nrm(ks[9], (L, D_MODEL), 0.02),
        "norm2_g": 1.0 + nrm(ks[10], (L, D_MODEL), 0.02),
        "w_ada": nrm(ks[11], (L, D_MODEL, 6 * D_MODEL), 0.5 * D_MODEL ** -0.5),
        "b_ada": nrm(ks[12], (L, 6 * D_MODEL), 0.02),
        "w_in": nrm(ks[13], (L, D_MODEL, N_IN), D_MODEL ** -0.5),
        "mlstm_gate_b": jnp.concatenate([i_bias, f_bias], axis=2).reshape(L, 4 * M_HEADS),
        "mlstm_norm_g": 1.0 + nrm(ks[14], (L, M_WIDTH), 0.02),
        "q_lora_g": 1.0 + nrm(ks[15], (L, Q_LORA), 0.02),
        "kv_lora_g": 1.0 + nrm(ks[16], (L, KV_LORA), 0.02),
        "w_q_up": nrm(ks[17], (L, Q_LORA, A_HEADS * A_QK), Q_LORA ** -0.5),
        "w_kv_up": nrm(ks[18], (L, KV_LORA, A_HEADS * (A_NOPE + A_VDIM)), KV_LORA ** -0.5),
        "q_head_g": 1.0 + nrm(ks[19], (L, A_QK), 0.02),
        "k_head_g": 1.0 + nrm(ks[22], (L, A_QK), 0.02),
        "w_out": nrm(ks[23], (L, D_MIX, D_MODEL), D_MIX ** -0.5),
        "w_mlp_up": nrm(ks[24], (L, D_MODEL, D_FF), D_MODEL ** -0.5),
        "w_mlp_down": nrm(ks[25], (L, D_FF, D_MODEL), D_FF ** -0.5),
    }


def reference(x_prompt, x_sample, cache_mla_ckv, cache_mla_krope, state_mlstm_C, state_mlstm_n, state_mlstm_m,
              c, c_ctx, norm1_g, norm2_g, w_ada, b_ada, w_in, mlstm_gate_b, mlstm_norm_g,
              q_lora_g, kv_lora_g, w_q_up, w_kv_up, q_head_g, k_head_g, w_out, w_mlp_up, w_mlp_down):
    Bp = x_prompt.shape[0]
    zero_C = jnp.zeros((Bp, 2, M_HEADS, M_HEAD_DIM, M_HEAD_DIM), jnp.float32)
    zero_n = jnp.zeros((Bp, 2, M_HEADS, M_HEAD_DIM), jnp.float32)
    zero_m = jnp.zeros((Bp, 2, M_HEADS), jnp.float32)
    y = x_prompt
    ckvs, kropes, Cs, ns, ms = [], [], [], [], []
    for l in range(DEPTH):
        y, (ckv, krope, Cl, nl, ml) = _layer(
            y, c_ctx, zero_C, zero_n, zero_m, None, None, None,
            norm1_g[l], norm2_g[l], w_ada[l], b_ada[l], w_in[l], mlstm_gate_b[l], mlstm_norm_g[l],
            q_lora_g[l], kv_lora_g[l], w_q_up[l], w_kv_up[l], q_head_g[l], k_head_g[l],
            w_out[l], w_mlp_up[l], w_mlp_down[l])
        ckvs.append(ckv)
        kropes.append(krope)
        Cs.append(Cl)
        ns.append(nl)
        ms.append(ml)
    rows = x_sample.shape[1] // GRID_W
    rope = _rope_2d(rows)
    z = x_sample
    for l in range(DEPTH):
        z, _ = _layer(
            z, c, state_mlstm_C[:, l], state_mlstm_n[:, l], state_mlstm_m[:, l],
            cache_mla_ckv[:, l], cache_mla_krope[:, l], rope,
            norm1_g[l], norm2_g[l], w_ada[l], b_ada[l], w_in[l], mlstm_gate_b[l], mlstm_norm_g[l],
            q_lora_g[l], kv_lora_g[l], w_q_up[l], w_kv_up[l], q_head_g[l], k_head_g[l],
            w_out[l], w_mlp_up[l], w_mlp_down[l])
    return (y, z, jnp.stack(ckvs, axis=1), jnp.stack(kropes, axis=1), jnp.stack(Cs, axis=1),
            jnp.stack(ns, axis=1), jnp.stack(ms, axis=1))
```

```cpp
#include <hip/hip_runtime.h>
#include <hip/hip_bf16.h>
#include <cstdio>
#include <cstdint>


#define LAS __attribute__((address_space(3)))
#define GAS __attribute__((address_space(1)))
typedef unsigned short bf16_t;
typedef short bf16x8 __attribute__((ext_vector_type(8)));
typedef short s16x4 __attribute__((ext_vector_type(4)));
typedef float f32x4 __attribute__((ext_vector_type(4)));
typedef float f32x2 __attribute__((ext_vector_type(2)));
typedef float f32x16 __attribute__((ext_vector_type(16)));
typedef unsigned u32x4 __attribute__((ext_vector_type(4)));
typedef unsigned u32x2 __attribute__((ext_vector_type(2)));

constexpr int DM = 1024, MC = 8192, ML = 8192, M = 16384, TC = 256, TL = 2048, NBC = 32, NBL = 4;
constexpr int NIN = 2736, NINP = 2816;
constexpr int C_MQ = 0, C_MK = 512, C_MV = 1024, C_MO = 1536, C_QLAT = 2048, C_KVLAT = 2432, C_KROPE = 2688, C_GATE = 2720;
constexpr int QLORA = 384, KVLORA = 256, NQ = 768, NQP = 1024  , NKV = 1024, FF = 4096;
constexpr int MKV = M + NBL * 256;
constexpr float EPS = 1e-6f;

constexpr size_t O_Y = 0, O_Z = 8388608, O_CKV = 16777216, O_KROPE = 18874368, O_C = 19136512, O_N = 23330816, O_M = 23363584, O_END = 23363840;

constexpr size_t MiB = 1u << 20;
constexpr size_t WS_CTL = 0, CTL_ZERO_BYTES = 1 * MiB;
constexpr size_t WS_MOD = 1 * MiB, WS_ROPE = 1 * MiB + 131072;
constexpr size_t WS_WIN = 2 * MiB, WS_WQ = 8 * MiB, WS_WKV = 9 * MiB, WS_WO = 10 * MiB, WS_WUP = 12 * MiB, WS_WDN = 20 * MiB, WS_GATES = 28 * MiB, WS_KRC = 29 * MiB;
constexpr size_t WS_H = 32 * MiB;
constexpr size_t WS_QN = 32 * MiB, WS_CKVN = 44 * MiB;
constexpr size_t WS_PROJ = 64 * MiB, WS_Q = 152 * MiB, WS_KVRAW = 176 * MiB, WS_K = 210 * MiB;
constexpr size_t WS_X1 = 192 * MiB, WS_END = 256 * MiB;
constexpr size_t WS_U = 32 * MiB;
constexpr size_t WS_XG = 160 * MiB;
constexpr size_t WS_BIAS2 = 30 * MiB;
constexpr int CW_TMO = 0, CW_QUEUE = 64, CW_BAR = 4096, CW_ROWSQ = 131072;

__device__ __forceinline__ unsigned cvt_pk_bf16(float lo, float hi) { unsigned r; asm volatile("v_cvt_pk_bf16_f32 %0, %1, %2" : "=v"(r) : "v"(lo), "v"(hi)); return r; }
__device__ __forceinline__ float bf2f(unsigned short x) { return __uint_as_float(((unsigned)x) << 16); }
__device__ __forceinline__ float bflo(unsigned w) { return __uint_as_float(w << 16); }
__device__ __forceinline__ float bfhi(unsigned w) { return __uint_as_float(w & 0xffff0000u); }
__device__ __forceinline__ void unpack8(u32x4 w, float* f) { f[0] = bflo(w.x); f[1] = bfhi(w.x); f[2] = bflo(w.y); f[3] = bfhi(w.y); f[4] = bflo(w.z); f[5] = bfhi(w.z); f[6] = bflo(w.w); f[7] = bfhi(w.w); }
__device__ __forceinline__ u32x4 pack8(const float* f) { u32x4 w; w.x = cvt_pk_bf16(f[0], f[1]); w.y = cvt_pk_bf16(f[2], f[3]); w.z = cvt_pk_bf16(f[4], f[5]); w.w = cvt_pk_bf16(f[6], f[7]); return w; }
__device__ __forceinline__ float wave_sum(float v) {
#pragma unroll
    for (int o = 1; o < 64; o <<= 1) v += __shfl_xor(v, o);
    return v;
}
__device__ __forceinline__ int fresh_lane() { int l; asm volatile("v_mbcnt_lo_u32_b32 %0, -1, 0\n\tv_mbcnt_hi_u32_b32 %0, -1, %0" : "=v"(l)); return l; }
#define LDS_WAIT() asm volatile("s_waitcnt lgkmcnt(0)" ::: "memory")
#define VM_WAIT() asm volatile("s_waitcnt vmcnt(0)" ::: "memory")
#define SBAR() __builtin_amdgcn_sched_barrier(0)
typedef short v4i16_t __attribute__((ext_vector_type(4)));
__device__ __forceinline__ s16x4 tr16(const LAS unsigned char* p) { return __builtin_bit_cast(s16x4, __builtin_amdgcn_ds_read_tr16_b64_v4i16((LAS v4i16_t*)p)); }
#define MK8(L, H) (bf16x8){L[0], L[1], L[2], L[3], H[0], H[1], H[2], H[3]}

namespace pg8 {
#define PG8_LAS __attribute__((address_space(3)))
typedef PG8_LAS float* PG8_LAS_float_ptr;
constexpr int BM = 256, BK = 64, HALF = 128, HTB = HALF * BK * 2  , STAGE_BYTES = 8 * HTB, NXCD = 8, WGM = 8;

__host__ __device__ __forceinline__ int lds_byte(int r, int c) { const int st = (r >> 4) * 2 + (c >> 5), rr = r & 15, cc = c & 31, ob = rr * 64 + cc * 2; return st * 1024 + (ob ^ (((ob >> 9) & 1) << 5)); }
__host__ __device__ __forceinline__ void stage_rc(int b, int& R, int& C) { const int st = b / 1024, sb = b % 1024, swz = sb ^ (((sb >> 9) & 1) << 5); R = (st >> 1) * 16 + swz / 64; C = (st & 1) * 32 + (swz % 64) / 2; }
__host__ __device__ __forceinline__ int perm32(int rho) { const int n = rho >> 4, i = rho & 15; return 8 * (i >> 2) + 4 * n + (i & 3); }

struct Unit { int pm, pn; };
struct Gemm { const bf16_t* A; const bf16_t* Bt; int M, N, K; };

struct StaticOrder {
    int nM, nN, nwg, G, c;
    __host__ __device__ void init(int M, int N, int G_, int c_) { nM = M / BM; nN = N / BM; nwg = nM * nN; G = G_; c = c_; }
    __host__ __device__ bool next(int i, Unit& u) const {
        const long L = (long)i * G + c; if (L >= nwg) return false;
        int wgid = (int)L; { const int q = nwg / NXCD, r = nwg % NXCD, xcd = wgid % NXCD, off = wgid / NXCD; wgid = (xcd < r ? xcd * (q + 1) : r * (q + 1) + (xcd - r) * q) + off; }
        const int nig = WGM * nN, gid = wgid / nig, fm = gid * WGM, gsz = (nM - fm) < WGM ? (nM - fm) : WGM;
        u.pm = fm + ((wgid % nig) % gsz); u.pn = (wgid % nig) / gsz; return true;
    }
    __device__ __forceinline__ void a_ready(const Unit&) const {}
    __device__ __forceinline__ void done(const Unit&) const {}
};


template <int ACT> struct EpiBf16 {
    static constexpr bool PERM = true, AFTER_DRAIN = false;
    bf16_t* O; int ldc;
    __device__ __forceinline__ void operator()(const f32x4 (&acc)[2][2][4][2], const Unit& u, int wr, int wc, int fr, int fq) const {
        const int row0 = u.pm * BM + wr * 64 + fr, col0 = u.pn * BM + wc * 32 + 8 * fq;
#pragma unroll
        for (int ai = 0; ai < 2; ++ai)
#pragma unroll
            for (int m = 0; m < 4; ++m) { bf16_t* rowp = O + (size_t)(row0 + ai * HALF + m * 16) * ldc + col0;
#pragma unroll
                for (int bj = 0; bj < 2; ++bj) { f32x4 v0 = acc[ai][bj][m][0], v1 = acc[ai][bj][m][1];
                    if (ACT == 2) {
#pragma unroll
                        for (int e = 0; e < 4; ++e) { const float a = fmaxf(v0[e], 0.f), b = fmaxf(v1[e], 0.f); v0[e] = a * a; v1[e] = b * b; } }
                    u32x4 w; w.x = cvt_pk_bf16(v0[0], v0[1]); w.y = cvt_pk_bf16(v0[2], v0[3]); w.z = cvt_pk_bf16(v1[0], v1[1]); w.w = cvt_pk_bf16(v1[2], v1[3]);
                    *(u32x4*)(rowp + bj * HALF) = w; } }
    }
};
struct EpiProj {
    static constexpr bool PERM = true, AFTER_DRAIN = false;
    bf16_t* O; float* gates;
    __device__ __forceinline__ void operator()(const f32x4 (&acc)[2][2][4][2], const Unit& u, int wr, int wc, int fr, int fq) const {
        const int row0 = u.pm * BM + wr * 64 + fr, col0 = u.pn * BM + wc * 32 + 8 * fq;
        const float ksc = (u.pn == 2 || u.pn == 3) ? 0.08838834764831845f : 1.0f;
#pragma unroll
        for (int ai = 0; ai < 2; ++ai)
#pragma unroll
            for (int m = 0; m < 4; ++m) { const int row = row0 + ai * HALF + m * 16; bf16_t* rowp = O + (size_t)row * NINP + col0;
#pragma unroll
                for (int bj = 0; bj < 2; ++bj) { const f32x4 v0 = acc[ai][bj][m][0] * ksc, v1 = acc[ai][bj][m][1] * ksc; const int c = col0 + bj * HALF;
                    if (c >= C_GATE && c < C_GATE + 16) { float* gp = gates + (size_t)row * 16 + (c - C_GATE); *(f32x4*)gp = v0; *(f32x4*)(gp + 4) = v1; }
                    u32x4 w; w.x = cvt_pk_bf16(v0[0], v0[1]); w.y = cvt_pk_bf16(v0[2], v0[3]); w.z = cvt_pk_bf16(v1[0], v1[1]); w.w = cvt_pk_bf16(v1[2], v1[3]);
                    *(u32x4*)(rowp + bj * HALF) = w; } }
    }
};
__device__ __forceinline__ float sum_x16_x32(float v) {
    auto a = __builtin_amdgcn_permlane16_swap(__float_as_uint(v), __float_as_uint(v), false, false); v = __uint_as_float(a[0]) + __uint_as_float(a[1]);
    auto b = __builtin_amdgcn_permlane32_swap(__float_as_uint(v), __float_as_uint(v), false, false); return __uint_as_float(b[0]) + __uint_as_float(b[1]);
}
__device__ __forceinline__ float partner_x32(float v, bool upper) {
    auto b = __builtin_amdgcn_permlane32_swap(__float_as_uint(v), __float_as_uint(v), false, false); return __uint_as_float(upper ? b[0] : b[1]);
}
template <int IS_KV> struct EpiHead {
    static constexpr bool PERM = true, AFTER_DRAIN = false;
    bf16_t* O; bf16_t* V; const float* gain; const float* rope; const bf16_t* proj; const bf16_t* krc; PG8_LAS float* X;
    __device__ __forceinline__ void operator()(const f32x4 (&acc)[2][2][4][2], const Unit& u, int wr, int wc, int fr, int fq) const {
        { const int l_ = fresh_lane(); fr = l_ & 15; fq = l_ >> 4; }
        const bool lat = u.pm >= MC / BM && u.pm < M / BM;
        PG8_LAS float* Xr = X + 2048;
        const int c8 = 32 * wc + 8 * fq;
#pragma unroll
        for (int ai = 0; ai < 2; ++ai)
#pragma unroll
            for (int m = 0; m < 4; ++m) { const int rl = ai * HALF + wr * 64 + m * 16 + fr;
#pragma unroll
                for (int bj = 0; bj < 2; ++bj) { const f32x4 v0 = acc[ai][bj][m][0], v1 = acc[ai][bj][m][1];
                    float ss = ((v0.x * v0.x + v0.y * v0.y) + (v0.z * v0.z + v0.w * v0.w)) + ((v1.x * v1.x + v1.y * v1.y) + (v1.z * v1.z + v1.w * v1.w));
                    ss = sum_x16_x32(ss);
                    if (fq == 0) X[(rl * 2 + bj) * 4 + wc] = ss; }
                if (IS_KV && wc == 2) { const int row = u.pm * BM + rl;
                    const u32x4 kw = *(const u32x4*)(row < M ? proj + (size_t)row * NINP + C_KROPE + 8 * fq : krc + (size_t)(row - M) * 32 + 8 * fq);
                    float kr[8]; unpack8(kw, kr); float ss = 0.f;
#pragma unroll
                    for (int e = 0; e < 8; ++e) ss += kr[e] * kr[e];
                    ss = sum_x16_x32(ss);
                    if (fq == 0) Xr[rl] = ss; }
                asm volatile("" ::: "memory"); }
        asm volatile("s_waitcnt lgkmcnt(0)" ::: "memory"); __builtin_amdgcn_s_barrier(); asm volatile("" ::: "memory");
#pragma unroll
        for (int ai = 0; ai < 2; ++ai)
#pragma unroll
            for (int m = 0; m < 4; ++m) { const int rl = ai * HALF + wr * 64 + m * 16 + fr, row = u.pm * BM + rl;
                const float* cs = rope + (size_t)((row - MC) & (TL - 1)) * 32 + 8 * (fq & 1);
#pragma unroll
                for (int bj = 0; bj < 2; ++bj) { const int hd = 2 * u.pn + bj;
                    const f32x4 xp = *(const PG8_LAS f32x4*)(X + (rl * 2 + bj) * 4);
                    const float tot = IS_KV ? (xp.x + xp.y) + Xr[rl] : (xp.x + xp.y) + (xp.z + xp.w);
                    const float rstd = 1.0f / sqrtf(tot * (1.0f / 96.0f) + EPS);
                    if (IS_KV && wc >= 2) {
                        const f32x4 v0 = acc[ai][bj][m][0], v1 = acc[ai][bj][m][1];
                        u32x4 w; w.x = cvt_pk_bf16(v0[0], v0[1]); w.y = cvt_pk_bf16(v0[2], v0[3]); w.z = cvt_pk_bf16(v1[0], v1[1]); w.w = cvt_pk_bf16(v1[2], v1[3]);
                        *(u32x4*)(V + (size_t)row * NKV + hd * 128 + 64 + (c8 - 64)) = w; }
                    if (IS_KV ? wc <= 2 : wc < 3) {
                        float v[8];
                        if (IS_KV && wc == 2) { const u32x4 kw = *(const u32x4*)(row < M ? proj + (size_t)row * NINP + C_KROPE + 8 * fq : krc + (size_t)(row - M) * 32 + 8 * fq); unpack8(kw, v); }
                        else {
#pragma unroll
                            for (int e = 0; e < 4; ++e) { v[e] = acc[ai][bj][m][0][e]; v[4 + e] = acc[ai][bj][m][1][e]; } }
#pragma unroll
                        for (int hq = 0; hq < 2; ++hq) {
                            const f32x4 gq = *(const f32x4*)(gain + c8 + 4 * hq);
#pragma unroll
                            for (int e = 0; e < 4; ++e) v[4 * hq + e] *= rstd * gq[e];
                            if (wc == 2) {
                                float p[4];
#pragma unroll
                                for (int e = 0; e < 4; ++e) p[e] = partner_x32(v[4 * hq + e], fq >= 2);
                                if (lat) { const f32x4 cq = *(const f32x4*)(cs + 4 * hq), sq = *(const f32x4*)(cs + 16 + 4 * hq);
#pragma unroll
                                    for (int e = 0; e < 4; ++e) v[4 * hq + e] = fq < 2 ? v[4 * hq + e] * cq[e] - p[e] * sq[e] : p[e] * sq[e] + v[4 * hq + e] * cq[e]; } }
                            asm volatile("" ::: "memory"); }
                        u32x4 w; w.x = cvt_pk_bf16(v[0], v[1]); w.y = cvt_pk_bf16(v[2], v[3]); w.z = cvt_pk_bf16(v[4], v[5]); w.w = cvt_pk_bf16(v[6], v[7]);
                        *(u32x4*)(O + (size_t)row * NQ + hd * 96 + c8) = w; } }
                asm volatile("" ::: "memory"); }
        asm volatile("s_waitcnt lgkmcnt(0)" ::: "memory"); __builtin_amdgcn_s_barrier(); asm volatile("" ::: "memory");
    }
};
struct EpiUp {
    static constexpr bool PERM = true, AFTER_DRAIN = false;
    bf16_t* O; const float* rowsq; const float* bias;
    __device__ __forceinline__ void operator()(const f32x4 (&acc)[2][2][4][2], const Unit& u, int wr, int wc, int fr, int fq) const {
        const int row0 = u.pm * BM + wr * 64 + fr, col0 = u.pn * BM + wc * 32 + 8 * fq;
        const int cond = u.pm < (MC / BM) ? 0 : 1 + (u.pm - MC / BM) / (TL / BM);
        const float* bp = bias + cond * FF + col0;
        f32x4 bv[2][2];
#pragma unroll
        for (int bj = 0; bj < 2; ++bj) { bv[bj][0] = *(const f32x4*)(bp + bj * HALF); bv[bj][1] = *(const f32x4*)(bp + bj * HALF + 4); }
#pragma unroll
        for (int ai = 0; ai < 2; ++ai)
#pragma unroll
            for (int m = 0; m < 4; ++m) { const int row = row0 + ai * HALF + m * 16; bf16_t* rowp = O + (size_t)row * FF + col0;
                const float rstd = 1.0f / sqrtf(__hip_atomic_load(rowsq + row, __ATOMIC_RELAXED, __HIP_MEMORY_SCOPE_AGENT) * (1.0f / DM) + EPS);
#pragma unroll
                for (int bj = 0; bj < 2; ++bj) { f32x4 v0 = acc[ai][bj][m][0] * rstd + bv[bj][0], v1 = acc[ai][bj][m][1] * rstd + bv[bj][1];
#pragma unroll
                    for (int e = 0; e < 4; ++e) { const float a = fmaxf(v0[e], 0.f), b = fmaxf(v1[e], 0.f); v0[e] = a * a; v1[e] = b * b; }
                    u32x4 w; w.x = cvt_pk_bf16(v0[0], v0[1]); w.y = cvt_pk_bf16(v0[2], v0[3]); w.z = cvt_pk_bf16(v1[0], v1[1]); w.w = cvt_pk_bf16(v1[2], v1[3]);
                    *(u32x4*)(rowp + bj * HALF) = w; } }
    }
};
struct EpiMix {
    static constexpr bool PERM = false, AFTER_DRAIN = false;
    const float* xa; const float* xb; float* x1; bf16_t* xg; const float* mod; const float* n2g; float* rowsq;
    __device__ __forceinline__ void operator()(const f32x4 (&acc)[2][2][4][2], const Unit& u, int wr, int wc, int fr, int fq) const {
        const int col0 = u.pn * BM + wc * 32 + 4 * fq;
        const int cond = u.pm < (MC / BM) ? 0 : 1 + (u.pm - MC / BM) / (TL / BM);
        const float* g = mod + cond * 6144 + 2048 + col0; const float* sc = mod + cond * 6144 + 4096 + col0; const float* ng = n2g + col0;
        f32x4 gv[2][2], gm[2][2];
#pragma unroll
        for (int bj = 0; bj < 2; ++bj)
#pragma unroll
            for (int n = 0; n < 2; ++n) { gv[bj][n] = *(const f32x4*)(g + bj * HALF + n * 16); gm[bj][n] = *(const f32x4*)(ng + bj * HALF + n * 16) * (*(const f32x4*)(sc + bj * HALF + n * 16) + 1.0f); }
#pragma unroll
        for (int ai = 0; ai < 2; ++ai)
#pragma unroll
            for (int m = 0; m < 4; ++m) { const int row = u.pm * BM + ai * HALF + wr * 64 + m * 16 + fr;
                const float* xr = (row < MC ? xa + (size_t)row * DM : xb + (size_t)(row - MC) * DM) + col0; float* orow = x1 + (size_t)row * DM + col0; bf16_t* grow = xg + (size_t)row * DM + col0;
                float ss = 0.f;
#pragma unroll
                for (int bj = 0; bj < 2; ++bj)
#pragma unroll
                    for (int n = 0; n < 2; ++n) { const f32x4 xv = *(const f32x4*)(xr + bj * HALF + n * 16); const f32x4 o = xv + gv[bj][n] * acc[ai][bj][m][n];
                        *(f32x4*)(orow + bj * HALF + n * 16) = o; ss += (o.x * o.x + o.y * o.y) + (o.z * o.z + o.w * o.w);
                        const f32x4 og = o * gm[bj][n]; u32x2 w; w.x = cvt_pk_bf16(og.x, og.y); w.y = cvt_pk_bf16(og.z, og.w); *(u32x2*)(grow + bj * HALF + n * 16) = w; }
                ss += __shfl_xor(ss, 16); ss += __shfl_xor(ss, 32);
                if (fq == 0) __hip_atomic_fetch_add(rowsq + row, ss, __ATOMIC_RELAXED, __HIP_MEMORY_SCOPE_AGENT); }
    }
};
struct EpiResGate {
    static constexpr bool PERM = false, AFTER_DRAIN = false;
    const float* xa; const float* xb; float* out; const float* mod; int goff;
    __device__ __forceinline__ void operator()(const f32x4 (&acc)[2][2][4][2], const Unit& u, int wr, int wc, int fr, int fq) const {
        const int col0 = u.pn * BM + wc * 32 + 4 * fq;
        const int cond = u.pm < (MC / BM) ? 0 : 1 + (u.pm - MC / BM) / (TL / BM);
        const float* g = mod + cond * 6144 + goff + col0;
        f32x4 gv[2][2];
#pragma unroll
        for (int bj = 0; bj < 2; ++bj)
#pragma unroll
            for (int n = 0; n < 2; ++n) gv[bj][n] = *(const f32x4*)(g + bj * HALF + n * 16);
#pragma unroll
        for (int ai = 0; ai < 2; ++ai)
#pragma unroll
            for (int m = 0; m < 4; ++m) { const int row = u.pm * BM + ai * HALF + wr * 64 + m * 16 + fr;
                const float* xr = (row < MC ? xa + (size_t)row * DM : xb + (size_t)(row - MC) * DM) + col0; float* orow = out + (size_t)row * DM + col0;
#pragma unroll
                for (int bj = 0; bj < 2; ++bj)
#pragma unroll
                    for (int n = 0; n < 2; ++n) { const f32x4 xv = *(const f32x4*)(xr + bj * HALF + n * 16); *(f32x4*)(orow + bj * HALF + n * 16) = xv + gv[bj][n] * acc[ai][bj][m][n]; } }
    }
};

template <class Epi, class Sched, bool ALIGN_EPI = false, bool SP2 = false>
__device__ __forceinline__ void gemm_phase(PG8_LAS unsigned char* lds, const Gemm g, const Sched& S, const Epi& E, const int wid  ) {
    const int lane = fresh_lane(), tid = wid * 64 + lane;
    const int wr = wid >> 2, wc = wid & 3, fr = lane & 15, fq = lane >> 4;
    const int K = g.K, nt = K / BK;
    unsigned voffA[2], voffB[2];
#pragma unroll
    for (int i = 0; i < 2; ++i) { int R, C; stage_rc(tid * 16 + i * 8192, R, C); const int Rb = Epi::PERM ? ((R & ~31) + perm32(R & 31)) : R;
        voffA[i] = (unsigned)(R * K + C) * 2u; voffB[i] = (unsigned)(Rb * K + C) * 2u; }
    const size_t kstep = (size_t)(BK * 2);
    const size_t hstep = (size_t)HALF * K * 2;
    const size_t tstep = 2 * hstep;
    const unsigned ldsw = (unsigned)wid * 1024u;
    const int aoff = lds_byte(wr * 64 + fr, fq * 8), boff = lds_byte(wc * 32 + fr, fq * 8);
#define PG8_SA(b, h) (((b) * 2 + (h)) * HTB)
#define PG8_SB(b, h) ((4 + (b) * 2 + (h)) * HTB)
#define PG8_STAGE(bufoff, gbase, voff) do { _Pragma("unroll") for (int _i = 0; _i < 2; ++_i) \
        __builtin_amdgcn_global_load_lds((const unsigned*)((const char*)(gbase) + (voff)[_i]), (PG8_LAS unsigned*)(lds + (bufoff) + ldsw + _i * 8192), 16, 0, 0); } while (0)
#define PG8_LDA(dst, b, h) do { _Pragma("unroll") for (int m = 0; m < 4; ++m) _Pragma("unroll") for (int k = 0; k < 2; ++k) dst[m][k] = *(const PG8_LAS bf16x8*)(lds + PG8_SA(b, h) + aoff + m * 2048 + k * 1024); } while (0)
#define PG8_LDB(dst, b, h) do { _Pragma("unroll") for (int n = 0; n < 2; ++n) _Pragma("unroll") for (int k = 0; k < 2; ++k) dst[n][k] = *(const PG8_LAS bf16x8*)(lds + PG8_SB(b, h) + boff + n * 2048 + k * 1024); } while (0)
#define PG8_MMA(ai, bj, At, Bt) do { __builtin_amdgcn_s_setprio(1); _Pragma("unroll") for (int m = 0; m < 4; ++m) _Pragma("unroll") for (int n = 0; n < 2; ++n) _Pragma("unroll") for (int k = 0; k < 2; ++k) \
        acc[ai][bj][m][n] = __builtin_amdgcn_mfma_f32_16x16x32_bf16(Bt[n][k], At[m][k], acc[ai][bj][m][n], 0, 0, 0); __builtin_amdgcn_s_setprio(0); } while (0)
#define PG8_WAIT_V(n) asm volatile("s_waitcnt vmcnt(" #n ")" ::: "memory")
#define PG8_WAIT_L(n) asm volatile("s_waitcnt lgkmcnt(" #n ")" ::: "memory")
#define PG8_BAR __builtin_amdgcn_s_barrier()
#define PG8_SCHED __builtin_amdgcn_sched_barrier(0)
    Unit cur, nxt; int ui = 0;
    if (!S.next(0, cur)) return;
    f32x4 acc[2][2][4][2];
#pragma unroll
    for (int a = 0; a < 2; ++a)
#pragma unroll
        for (int b = 0; b < 2; ++b)
#pragma unroll
            for (int m = 0; m < 4; ++m)
#pragma unroll
                for (int n = 0; n < 2; ++n) acc[a][b][m][n] = (f32x4){0.f, 0.f, 0.f, 0.f};
    bf16x8 At[4][2], B0[2][2], B1[2][2];
    const char* cA = (const char*)g.A + (size_t)cur.pm * tstep; const char* cB = (const char*)g.Bt + (size_t)cur.pn * tstep;
    S.a_ready(cur);
    if constexpr (SP2) {
        PG8_STAGE(PG8_SB(0, 0), cB, voffB); PG8_STAGE(PG8_SB(0, 1), cB + hstep, voffB); PG8_STAGE(PG8_SA(0, 0), cA, voffA); PG8_STAGE(PG8_SA(0, 1), cA + hstep, voffA);
        if (wr == 1) PG8_BAR;
        PG8_WAIT_V(2); PG8_BAR;
        PG8_STAGE(PG8_SB(1, 0), cB + kstep, voffB); PG8_STAGE(PG8_SA(1, 0), cA + kstep, voffA); PG8_STAGE(PG8_SB(1, 1), cB + hstep + kstep, voffB);
        PG8_WAIT_V(6); PG8_BAR;
    } else {
        PG8_STAGE(PG8_SB(0, 0), cB, voffB); PG8_STAGE(PG8_SA(0, 0), cA, voffA); PG8_STAGE(PG8_SB(0, 1), cB + hstep, voffB); PG8_STAGE(PG8_SA(0, 1), cA + hstep, voffA);
        if (wr == 1) PG8_BAR;
        PG8_WAIT_V(4); PG8_BAR;
        PG8_STAGE(PG8_SB(1, 0), cB + kstep, voffB); PG8_STAGE(PG8_SA(1, 0), cA + kstep, voffA); PG8_STAGE(PG8_SB(1, 1), cB + hstep + kstep, voffB);
        PG8_WAIT_V(6); PG8_BAR;
    }
    for (;;) {
        const bool has_next = S.next(ui + 1, nxt);
        const char* nA = has_next ? (const char*)g.A + (size_t)nxt.pm * tstep : cA; const char* nB = has_next ? (const char*)g.Bt + (size_t)nxt.pn * tstep : cB;
        for (int t = 0; t < nt; t += 2) {
            const bool last = (t == nt - 2);
            const char* a1 = cA + (size_t)(t + 1) * kstep;
            const char* a2 = last ? nA : cA + (size_t)(t + 2) * kstep; const char* b2 = last ? nB : cB + (size_t)(t + 2) * kstep;
            const char* a3 = a2 + kstep; const char* b3 = b2 + kstep;
            if (last && has_next) S.a_ready(nxt);
            if constexpr (SP2) {
            PG8_LDB(B0, 0, 0); PG8_LDB(B1, 0, 1); PG8_SCHED; PG8_LDA(At, 0, 0); PG8_STAGE(PG8_SA(1, 1), a1 + hstep, voffA);
            PG8_WAIT_V(8); PG8_WAIT_L(0); PG8_BAR; PG8_MMA(0, 0, At, B0); PG8_MMA(0, 1, At, B1); PG8_BAR; PG8_SCHED;
            PG8_LDA(At, 0, 1); PG8_STAGE(PG8_SB(0, 0), b2, voffB); PG8_STAGE(PG8_SB(0, 1), b2 + hstep, voffB); PG8_STAGE(PG8_SA(0, 0), a2, voffA);
            PG8_WAIT_V(8); PG8_WAIT_L(0); PG8_BAR; PG8_MMA(1, 0, At, B0); PG8_MMA(1, 1, At, B1); PG8_BAR; PG8_SCHED;
            PG8_LDB(B0, 1, 0); PG8_LDB(B1, 1, 1); PG8_SCHED; PG8_LDA(At, 1, 0); PG8_STAGE(PG8_SA(0, 1), a2 + hstep, voffA);
            PG8_WAIT_V(8); PG8_WAIT_L(0); PG8_BAR; PG8_MMA(0, 0, At, B0); PG8_MMA(0, 1, At, B1); PG8_BAR; PG8_SCHED;
            PG8_LDA(At, 1, 1); PG8_STAGE(PG8_SB(1, 0), b3, voffB); PG8_STAGE(PG8_SB(1, 1), b3 + hstep, voffB); PG8_STAGE(PG8_SA(1, 0), a3, voffA);
            PG8_WAIT_V(8); PG8_WAIT_L(0); PG8_BAR; PG8_MMA(1, 0, At, B0); PG8_MMA(1, 1, At, B1); PG8_BAR; PG8_SCHED;
            } else {
            PG8_LDB(B0, 0, 0); PG8_SCHED; PG8_LDA(At, 0, 0); PG8_STAGE(PG8_SA(1, 1), a1 + hstep, voffA);
            PG8_WAIT_L(8); PG8_BAR; PG8_WAIT_L(0); PG8_MMA(0, 0, At, B0); PG8_BAR; PG8_SCHED;
            PG8_LDB(B1, 0, 1); PG8_STAGE(PG8_SB(0, 0), b2, voffB);
            PG8_BAR; PG8_WAIT_L(0); PG8_MMA(0, 1, At, B1); PG8_BAR;
            PG8_LDA(At, 0, 1); PG8_STAGE(PG8_SA(0, 0), a2, voffA);
            PG8_BAR; PG8_WAIT_L(0); PG8_MMA(1, 0, At, B0); PG8_BAR; PG8_SCHED;
            PG8_STAGE(PG8_SB(0, 1), b2 + hstep, voffB);
            PG8_WAIT_V(6); PG8_BAR; PG8_MMA(1, 1, At, B1); PG8_BAR;
            PG8_LDB(B0, 1, 0); PG8_SCHED; PG8_LDA(At, 1, 0); PG8_STAGE(PG8_SA(0, 1), a2 + hstep, voffA);
            PG8_WAIT_L(8); PG8_BAR; PG8_WAIT_L(0); PG8_MMA(0, 0, At, B0); PG8_BAR; PG8_SCHED;
            PG8_LDB(B1, 1, 1); PG8_STAGE(PG8_SB(1, 0), b3, voffB);
            PG8_BAR; PG8_WAIT_L(0); PG8_MMA(0, 1, At, B1); PG8_BAR;
            PG8_LDA(At, 1, 1); PG8_STAGE(PG8_SA(1, 0), a3, voffA);
            PG8_BAR; PG8_WAIT_L(0); PG8_MMA(1, 0, At, B0); PG8_BAR; PG8_SCHED;
            PG8_STAGE(PG8_SB(1, 1), b3 + hstep, voffB);
            PG8_WAIT_V(6); PG8_BAR; PG8_MMA(1, 1, At, B1); PG8_BAR;
            }
        }
        if constexpr (ALIGN_EPI) { if (wr == 0) PG8_BAR; }
        if constexpr (!Epi::AFTER_DRAIN) { E(acc, cur, wr, wc, fr, fq); S.done(cur); }
        if (!has_next) break;
#pragma unroll
        for (int a = 0; a < 2; ++a)
#pragma unroll
            for (int b = 0; b < 2; ++b)
#pragma unroll
                for (int m = 0; m < 4; ++m)
#pragma unroll
                    for (int n = 0; n < 2; ++n) acc[a][b][m][n] = (f32x4){0.f, 0.f, 0.f, 0.f};
        cur = nxt; cA = nA; cB = nB; ++ui;
        if constexpr (ALIGN_EPI) { if (wr == 1) PG8_BAR; }
    }
    PG8_WAIT_V(0);
    if constexpr (!ALIGN_EPI) { if (wr == 0) PG8_BAR; }
    PG8_BAR;
    if constexpr (Epi::AFTER_DRAIN) { E.fused(acc, cur, wr, wc, fr, fq, lds, wid, lane); S.done(cur); }
#undef PG8_SA
#undef PG8_SB
#undef PG8_STAGE
#undef PG8_LDA
#undef PG8_LDB
#undef PG8_MMA
#undef PG8_WAIT_V
#undef PG8_WAIT_L
#undef PG8_BAR
#undef PG8_SCHED
}
}
#define XB_TMO      128
#define XB_XCNT(j)  (256  + 64 * (j))
#define XB_XSUB(j)  (1280 + 64 * (j))
#define XB_XGEN(j)  (2304 + 64 * (j))
#define XB_TOP      3328
#define XB_TOPGEN   3392
#define XCD_BAR_WORDS 3456
#define XB_SPIN_CAP (1u << 18)

__device__ __forceinline__ unsigned xb_ld(unsigned* p)              { return __hip_atomic_load(p, __ATOMIC_RELAXED, __HIP_MEMORY_SCOPE_AGENT); }
__device__ __forceinline__ unsigned xb_add(unsigned* p, unsigned v) { return __hip_atomic_fetch_add(p, v, __ATOMIC_RELAXED, __HIP_MEMORY_SCOPE_AGENT); }
__device__ __forceinline__ unsigned xb_xcc_id() { return (unsigned)__builtin_amdgcn_s_getreg((3 << 11) | 20) & 0xFu; }
#define XB_SPIN(cond, bar) do { unsigned _sp = 0; while (cond) { __builtin_amdgcn_s_sleep(1); \
    if ((++_sp & 255u) == 0u) { if (xb_ld(&(bar)[XB_TMO])) break; if (_sp > XB_SPIN_CAP) { atomicAdd(&(bar)[XB_TMO], 1u); break; } } } } while (0)

struct XcdBarrier {
    unsigned* bar; unsigned x; unsigned w;
    volatile LAS unsigned* st;
};

__device__ __forceinline__ XcdBarrier xcd_barrier_post(unsigned* bar, volatile LAS unsigned* st, unsigned wave) {
    XcdBarrier b; b.bar = bar; b.x = xb_xcc_id(); b.st = st; b.w = wave;
    if (wave == 0u && fresh_lane() == 0) (void)xb_add(&bar[XB_XCNT(b.x)], 1u);
    return b;
}
__device__ __forceinline__ void xcd_barrier_complete(unsigned* bar, unsigned x, unsigned& nloc, unsigned& nx) {
    const unsigned G = gridDim.x * gridDim.y * gridDim.z;
    unsigned sum, cnt, mine, sp = 0u;
    for (;;) {
        sum = 0u; cnt = 0u; mine = 0u;
#pragma unroll
        for (unsigned j = 0; j < 16; ++j) { const unsigned c = xb_ld(&bar[XB_XCNT(j)]); sum += c; cnt += (c > 0u) ? 1u : 0u; mine = (j == x) ? c : mine; }
        if (sum == G) break;
        __builtin_amdgcn_s_sleep(1);
        if ((++sp & 255u) == 0u) { if (xb_ld(&bar[XB_TMO])) break; if (sp > XB_SPIN_CAP) { atomicAdd(&bar[XB_TMO], 1u); break; } }
    }
    nloc = mine > 0u ? mine : 1u; nx = cnt > 0u ? cnt : 1u;
}

__device__ __forceinline__ void xcd_barrier(const XcdBarrier& b) {
    asm volatile("s_waitcnt vmcnt(0)" ::: "memory");
    __syncthreads();
    if (b.w == 0u && fresh_lane() == 0) {
        unsigned* bar = b.bar;
        __builtin_amdgcn_s_waitcnt(0);
        unsigned nloc = b.st[0], nx = b.st[1];
        if (nloc == 0u) { xcd_barrier_complete(bar, b.x, nloc, nx); b.st[0] = nloc; b.st[1] = nx; }
        const unsigned old = xb_add(&bar[XB_XSUB(b.x)], 1u);
        const unsigned gen = old / nloc;
        if (old + 1u == (gen + 1u) * nloc) {
            __builtin_amdgcn_fence(__ATOMIC_RELEASE, "agent");
            asm volatile("s_waitcnt vmcnt(0)" ::: "memory");
            const unsigned og = xb_add(&bar[XB_TOP], 1u);
            const unsigned tg = og / nx;
            if (og + 1u == (tg + 1u) * nx) xb_add(&bar[XB_TOPGEN], 1u);
            else XB_SPIN(xb_ld(&bar[XB_TOPGEN]) == tg, bar);
            __builtin_amdgcn_fence(__ATOMIC_ACQUIRE, "agent");
            xb_add(&bar[XB_XGEN(b.x)], 1u);
            asm volatile("s_waitcnt vmcnt(0)" ::: "memory");
        } else {
            XB_SPIN(xb_ld(&bar[XB_XGEN(b.x)]) == gen, bar);
            __builtin_amdgcn_fence(__ATOMIC_ACQUIRE, "agent");
            asm volatile("s_waitcnt vmcnt(0)" ::: "memory");
        }
    }
    __syncthreads();
}

constexpr int NWAVES = 8, NTHREADS = 512;
constexpr int RING_BYTES = 131072, LDS_BYTES = 163840, LDSCTL_OFF = LDS_BYTES - 1024, MISC_OFF = LDSCTL_OFF + 320;
static_assert(pg8::STAGE_BYTES <= RING_BYTES, "GEMM stage buffers fit the ring");
struct Args { const float* in[25]; float* out; unsigned char* ws; int ph_lo, ph_hi, li, pad; };
enum { I_XP = 0, I_XS, I_CCKV, I_CKROPE, I_SC, I_SN, I_SM, I_C, I_CCTX, I_N1G, I_N2G, I_WADA, I_BADA, I_WIN, I_GATEB, I_MNG, I_QLG, I_KVLG, I_WQ, I_WKV, I_QHG, I_KHG, I_WOUT, I_WUP, I_WDN };

template <int MODE> __device__ __forceinline__ int src_col(int n) {
    if (MODE == 0) return n;
    if (MODE == 2) return (n & 127) < 96 ? (n >> 7) * 96 + (n & 127) : -1;
    if (n < 2048) return n;
    if (n < C_GATE) return n + 16;
    if (n < NIN) return n - 672;
    return -1;
}
template <int MODE>
__device__ __forceinline__ void transpose_item(const float* W, int K, int Nsrc, int Ndst, bf16_t* WT, LAS float* scr, int item, int lane) {
    const int nblk = Ndst / 32, kb = item / nblk, nb = item % nblk, k0 = 64 * kb, n0 = 32 * nb;
    const int sc = src_col<MODE>(n0 + (lane & 31));
#pragma unroll 8
    for (int i = 0; i < 32; ++i) { const int kk = 2 * i + (lane >> 5); scr[kk * 33 + (lane & 31)] = sc >= 0 ? W[(size_t)(k0 + kk) * Nsrc + sc] : 0.f; }
    LDS_WAIT(); asm volatile("" ::: "memory");
    const int c = lane & 7;
#pragma unroll
    for (int j = 0; j < 4; ++j) { const int n = (lane >> 3) + 8 * j; const LAS float* s = scr + (8 * c) * 33 + n;
        u32x4 o; o.x = cvt_pk_bf16(s[0 * 33], s[1 * 33]); o.y = cvt_pk_bf16(s[2 * 33], s[3 * 33]); o.z = cvt_pk_bf16(s[4 * 33], s[5 * 33]); o.w = cvt_pk_bf16(s[6 * 33], s[7 * 33]);
        *(u32x4*)(WT + (size_t)(n0 + n) * K + k0 + 8 * c) = o; }
    LDS_WAIT(); asm volatile("" ::: "memory");
}
template <int MODE>
__device__ __forceinline__ void gemv5_item(const float* c_in, const float* c_ctx, const float* W, const float* b_ada, float* OUT, LAS unsigned char* lds, int item, int tid, int lane, int wave) {
    constexpr int NW_ = MODE == 0 ? 6144 : FF;
    LAS float* s_l = (LAS float*)lds;
    LAS float* red = (LAS float*)(lds + 20480);
    for (int idx = tid; idx < 5120; idx += NTHREADS) { const int c = idx >> 10, k = idx & 1023; if (MODE == 0) { const float v = c == 0 ? c_ctx[k] : c_in[(c - 1) * 1024 + k]; s_l[idx] = v / (1.f + __expf(-v)); } else s_l[idx] = c_in[c * 6144 + 3072 + k]; }
    __syncthreads();
    const int n0 = item * 64, kq = lane >> 4, cq = lane & 15, kbase = wave * 128;
    f32x4 acc[5];
#pragma unroll
    for (int c = 0; c < 5; ++c) acc[c] = (f32x4){0.f, 0.f, 0.f, 0.f};
    const float* wp = W + (size_t)(kbase + kq) * NW_ + n0 + cq * 4;
#pragma unroll 8
    for (int it = 0; it < 32; ++it) { const f32x4 w = *(const f32x4*)(wp + (size_t)it * 4 * NW_); const int k = kbase + it * 4 + kq;
#pragma unroll
        for (int c = 0; c < 5; ++c) acc[c] += s_l[c * 1024 + k] * w; }
#pragma unroll
    for (int c = 0; c < 5; ++c)
#pragma unroll
        for (int e = 0; e < 4; ++e) { float v = acc[c][e]; v += __shfl_xor(v, 16); v += __shfl_xor(v, 32); acc[c][e] = v; }
    if (kq == 0) {
#pragma unroll
        for (int c = 0; c < 5; ++c) *(LAS f32x4*)(red + (wave * 5 + c) * 64 + cq * 4) = acc[c]; }
    __syncthreads();
    if (tid < 320) { const int c = tid >> 6, n = tid & 63; float s = MODE == 0 ? b_ada[n0 + n] : 0.f;
#pragma unroll
        for (int w = 0; w < 8; ++w) s += red[(w * 5 + c) * 64 + n];
        OUT[c * NW_ + n0 + n] = s; }
    __syncthreads();
}
__device__ __forceinline__ void p0_prologue(const Args& a, LAS unsigned char* lds, int tid, int lane, int wave, int G) {
    unsigned char* ws = a.ws;
    const int bx = blockIdx.x;
    if (bx < 96) gemv5_item<0>(a.in[I_C], a.in[I_CCTX], a.in[I_WADA], a.in[I_BADA], (float*)(ws + WS_MOD), lds, bx, tid, lane, wave);
    LAS float* scr = (LAS float*)(lds + wave * 16384);
    const int gw = bx * NWAVES + wave, NGW = G * NWAVES;
    constexpr int I_1 = (DM / 64) * (NINP / 32), I_2 = (QLORA / 64) * (NQP / 32), I_3 = (KVLORA / 64) * (NKV / 32), I_4 = (DM / 64) * (DM / 32), I_5 = (DM / 64) * (FF / 32), I_6 = (FF / 64) * (DM / 32);
    constexpr int NITEMS = I_1 + I_2 + I_3 + I_4 + I_5 + I_6;
    for (int it = gw; it < NITEMS; it += NGW) {
        int r = it;
        if (r < I_1) { transpose_item<1>(a.in[I_WIN], DM, NIN, NINP, (bf16_t*)(ws + WS_WIN), scr, r, lane); continue; } r -= I_1;
        if (r < I_2) { transpose_item<2>(a.in[I_WQ], QLORA, NQ, NQP, (bf16_t*)(ws + WS_WQ), scr, r, lane); continue; } r -= I_2;
        if (r < I_3) { transpose_item<0>(a.in[I_WKV], KVLORA, NKV, NKV, (bf16_t*)(ws + WS_WKV), scr, r, lane); continue; } r -= I_3;
        if (r < I_4) { transpose_item<0>(a.in[I_WOUT], DM, DM, DM, (bf16_t*)(ws + WS_WO), scr, r, lane); continue; } r -= I_4;
        if (r < I_5) { transpose_item<0>(a.in[I_WUP], DM, FF, FF, (bf16_t*)(ws + WS_WUP), scr, r, lane); continue; } r -= I_5;
        transpose_item<0>(a.in[I_WDN], FF, DM, DM, (bf16_t*)(ws + WS_WDN), scr, r, lane);
    }
    float* rope = (float*)(ws + WS_ROPE);
    for (int idx = bx * NTHREADS + tid; idx < TL * 16; idx += G * NTHREADS) { const int t = idx >> 4, j = idx & 15;
        const float pos = (float)(j < 8 ? (t >> 6) : (t & 63)); const float inv = exp2f(-(float)(j & 7) * 0.125f * 13.287712379549449f);
        float rev = pos * inv * 0.15915494309189535f; rev -= floorf(rev);
        rope[t * 32 + j] = __builtin_amdgcn_cosf(rev); rope[t * 32 + 16 + j] = __builtin_amdgcn_sinf(rev); }
}

__device__ __forceinline__ int cond_of_row(int row) { return row < MC ? 0 : 1 + ((row - MC) >> 11); }
__device__ __forceinline__ void norm_rows(const float* xa, const float* xb, const float* g, const float* MOD, int sh_off, int sc_off, bf16_t* out, int gw, int NGW, int lane) {
    for (int rb = gw * 8; rb < M; rb += NGW * 8) {
        const int cond = cond_of_row(rb);
        const f32x4* g4 = (const f32x4*)g + lane; const f32x4* sc4 = (const f32x4*)(MOD + cond * 6144 + sc_off) + lane; const f32x4* sh4 = (const f32x4*)(MOD + cond * 6144 + sh_off) + lane;
        f32x4 gm[4], sv[4];
#pragma unroll
        for (int j = 0; j < 4; ++j) { gm[j] = g4[64 * j] * (sc4[64 * j] + 1.0f); sv[j] = sh4[64 * j]; }
        for (int r = 0; r < 8; r += 2) {
            f32x4 v[2][4];
#pragma unroll
            for (int q = 0; q < 2; ++q) { const int row = rb + r + q; const f32x4* xr = (const f32x4*)(row < MC ? xa + (size_t)row * DM : xb + (size_t)(row - MC) * DM) + lane;
#pragma unroll
                for (int j = 0; j < 4; ++j) v[q][j] = xr[64 * j]; }
#pragma unroll
            for (int q = 0; q < 2; ++q) { const int row = rb + r + q; float s = 0.f;
#pragma unroll
                for (int j = 0; j < 4; ++j) s += (v[q][j].x * v[q][j].x + v[q][j].y * v[q][j].y) + (v[q][j].z * v[q][j].z + v[q][j].w * v[q][j].w);
                const float rstd = 1.0f / sqrtf(wave_sum(s) * (1.0f / DM) + EPS);
                u32x2* o8 = (u32x2*)(out + (size_t)row * DM) + lane;
#pragma unroll
                for (int j = 0; j < 4; ++j) { const f32x4 o = v[q][j] * rstd * gm[j] + sv[j]; u32x2 w; w.x = cvt_pk_bf16(o.x, o.y); w.y = cvt_pk_bf16(o.z, o.w); o8[64 * j] = w; } } }
    }
}
__device__ __forceinline__ void p3_rows(const Args& a, int gw, int NGW, int lane, int gtid, int NGT) {
    unsigned char* ws = a.ws; const bf16_t* PROJ = (const bf16_t*)(ws + WS_PROJ); bf16_t* QN = (bf16_t*)(ws + WS_QN); bf16_t* CKVN = (bf16_t*)(ws + WS_CKVN);
    float qg[8]; f32x4 kg;
    { const int l8 = lane < 48 ? lane * 8 : 0;
#pragma unroll
      for (int e = 0; e < 8; ++e) qg[e] = a.in[I_QLG][l8 + e];
      kg = *(const f32x4*)(a.in[I_KVLG] + lane * 4); }
    for (int rb = gw * 8; rb < M; rb += NGW * 8)
        for (int r4 = 0; r4 < 8; r4 += 4) {
            u32x4 qw[4]; u32x2 kw4[4]; unsigned short krw[4];
#pragma unroll
            for (int q = 0; q < 4; ++q) { const bf16_t* pr = PROJ + (size_t)(rb + r4 + q) * NINP;
                qw[q] = (u32x4){0u, 0u, 0u, 0u}; if (lane < 48) qw[q] = *(const u32x4*)(pr + C_QLAT + lane * 8);
                kw4[q] = *(const u32x2*)(pr + C_KVLAT + lane * 4); krw[q] = pr[C_KROPE + (lane & 31)]; }
#pragma unroll
            for (int q = 0; q < 4; ++q) { const int row = rb + r4 + q;
                float qv[8]; unpack8(qw[q], qv);
                float s = 0.f;
#pragma unroll
                for (int e = 0; e < 8; ++e) s += qv[e] * qv[e];
                const float rq = 1.0f / sqrtf(wave_sum(s) * (1.0f / QLORA) + EPS);
                if (lane < 48) {
#pragma unroll
                    for (int e = 0; e < 8; ++e) qv[e] *= rq * qg[e];
                    *(u32x4*)(QN + (size_t)row * QLORA + lane * 8) = pack8(qv); }
                const u32x2 kw = kw4[q];
                f32x4 kv = (f32x4){bflo(kw.x), bfhi(kw.x), bflo(kw.y), bfhi(kw.y)};
                const float rk = 1.0f / sqrtf(wave_sum((kv.x * kv.x + kv.y * kv.y) + (kv.z * kv.z + kv.w * kv.w)) * (1.0f / KVLORA) + EPS);
                kv = kv * rk * kg;
                u32x2 ow; ow.x = cvt_pk_bf16(kv.x, kv.y); ow.y = cvt_pk_bf16(kv.z, kv.w);
                *(u32x2*)(CKVN + (size_t)row * KVLORA + lane * 4) = ow;
                if (row < MC) { *(f32x4*)(a.out + O_CKV + (size_t)row * KVLORA + lane * 4) = kv;
                    if (lane < 32) a.out[O_KROPE + (size_t)row * 32 + lane] = bf2f(krw[q]); } } }
    for (int i = gtid; i < NBL * 256 * KVLORA / 8; i += NGT) { const float* s = a.in[I_CCKV] + (size_t)i * 8; float f[8];
#pragma unroll
        for (int e = 0; e < 8; ++e) f[e] = s[e];
        *(u32x4*)(CKVN + (size_t)M * KVLORA + (size_t)i * 8) = pack8(f); }
    for (int i = gtid; i < NBL * 256 * 32 / 8; i += NGT) { const float* s = a.in[I_CKROPE] + (size_t)i * 8; float f[8];
#pragma unroll
        for (int e = 0; e < 8; ++e) f[e] = s[e];
        *(u32x4*)((bf16_t*)(ws + WS_KRC) + (size_t)i * 8) = pack8(f); }
}
__device__ __forceinline__ void p5_headnorm(const Args& a, int gw, int NGW, int lane) {
    unsigned char* ws = a.ws; bf16_t* QB = (bf16_t*)(ws + WS_Q); const bf16_t* KVR = (const bf16_t*)(ws + WS_KVRAW); bf16_t* KB = (bf16_t*)(ws + WS_K);
    const bf16_t* PROJ = (const bf16_t*)(ws + WS_PROJ); const float* rope = (const float*)(ws + WS_ROPE);
    const int half = lane >> 5, hh = (lane >> 2) & 7, q4 = lane & 3;
    const bf16_t* KRC = (const bf16_t*)(ws + WS_KRC);
    constexpr int NP5 = (M + MKV) / 2;
    for (int p0 = gw; p0 < NP5; p0 += 2 * NGW) {
        u32x4 raw[2][3];
#pragma unroll
        for (int q = 0; q < 2; ++q) { const int p = p0 + q * NGW; if (p < NP5) {
            const int idx = 2 * p + half; const bool isq = idx < M; const int kr = isq ? idx : idx - M;
            if (isq) { const bf16_t* src = QB + (size_t)kr * NQ + hh * 96 + q4 * 24;
#pragma unroll
                for (int i = 0; i < 3; ++i) raw[q][i] = *(const u32x4*)(src + 8 * i);
            } else {
#pragma unroll
                for (int i = 0; i < 3; ++i) { const int ci = 3 * q4 + i;
                    const bf16_t* src = ci < 8 ? KVR + (size_t)kr * NKV + hh * 128 + 8 * ci : (kr < M ? PROJ + (size_t)kr * NINP + C_KROPE + 8 * (ci - 8) : KRC + (size_t)(kr - M) * 32 + 8 * (ci - 8));
                    raw[q][i] = *(const u32x4*)src; } } } }
#pragma unroll
        for (int q = 0; q < 2; ++q) { const int p = p0 + q * NGW; if (p < NP5) {
            const int idx = 2 * p + half; const bool isq = idx < M; const int kr = isq ? idx : idx - M;
            float v[24];
#pragma unroll
            for (int i = 0; i < 3; ++i) unpack8(raw[q][i], v + 8 * i);
            const float* g = isq ? a.in[I_QHG] : a.in[I_KHG];
            bf16_t* dst = isq ? QB + (size_t)kr * NQ + hh * 96 + q4 * 24 : KB + (size_t)kr * NQ + hh * 96 + q4 * 24;
            const bool dorope = kr >= MC && kr < M;
            float s = 0.f;
#pragma unroll
            for (int i = 0; i < 24; ++i) s += v[i] * v[i];
            s += __shfl_xor(s, 1); s += __shfl_xor(s, 2);
            const float rstd = 1.0f / sqrtf(s * (1.0f / 96.0f) + EPS);
#pragma unroll
            for (int i = 0; i < 24; ++i) v[i] *= rstd * g[q4 * 24 + i];
            float snd[8], rcv[8];
#pragma unroll
            for (int j = 0; j < 8; ++j) { snd[j] = (q4 == 2) ? v[16 + j] : v[8 + j]; rcv[j] = __shfl_xor(snd[j], 1); }
            if (dorope && q4 >= 2) { const float* cs = rope + (size_t)((kr - MC) & (TL - 1)) * 32;
                if (q4 == 2) {
#pragma unroll
                    for (int j = 0; j < 8; ++j) v[16 + j] = v[16 + j] * cs[j] - rcv[j] * cs[16 + j];
                } else {
#pragma unroll
                    for (int j = 0; j < 8; ++j) { const float x1 = v[j], x2 = v[16 + j], c = cs[8 + j], sn = cs[24 + j]; v[j] = x1 * c - x2 * sn; v[16 + j] = x1 * sn + x2 * c;
                        v[8 + j] = rcv[j] * cs[16 + j] + v[8 + j] * cs[j]; }
                } }
#pragma unroll
            for (int i = 0; i < 3; ++i) *(u32x4*)(dst + 8 * i) = pack8(v + 8 * i);
        } }
    }
}
__device__ __forceinline__ void p6b_hm(const Args& a, int gw, int NGW, int lane) {
    unsigned char* ws = a.ws; const bf16_t* HF = (const bf16_t*)a.out; const bf16_t* HB = HF + (size_t)M * 512; const bf16_t* PROJ = (const bf16_t*)(ws + WS_PROJ); bf16_t* A2 = (bf16_t*)(ws + WS_H);
    float mg[8];
#pragma unroll
    for (int e = 0; e < 8; ++e) mg[e] = a.in[I_MNG][lane * 8 + e];
    for (int row0 = gw; row0 < M; row0 += 2 * NGW) {
        u32x4 rf[2], rb_[2], ro[2];
#pragma unroll
        for (int q = 0; q < 2; ++q) { const int row = row0 + q * NGW; if (row < M) {
            rf[q] = *(const u32x4*)(HF + (size_t)row * 512 + lane * 8); rb_[q] = *(const u32x4*)(HB + (size_t)row * 512 + lane * 8);
            ro[q] = *(const u32x4*)(PROJ + (size_t)row * NINP + C_MO + lane * 8); } }
#pragma unroll
        for (int q = 0; q < 2; ++q) { const int row = row0 + q * NGW; if (row < M) {
            float f[8], b[8], o[8]; unpack8(rf[q], f); unpack8(rb_[q], b); unpack8(ro[q], o);
            float s = 0.f;
#pragma unroll
            for (int e = 0; e < 8; ++e) { f[e] += b[e]; s += f[e] * f[e]; }
            s += __shfl_xor(s, 1); s += __shfl_xor(s, 2); s += __shfl_xor(s, 4); s += __shfl_xor(s, 8);
            const float rstd = 1.0f / sqrtf(s * (1.0f / 128.0f) + EPS);
#pragma unroll
            for (int e = 0; e < 8; ++e) f[e] = f[e] * rstd * mg[e] / (1.0f + __expf(-o[e]));
            *(u32x4*)(A2 + (size_t)row * DM + lane * 8) = pack8(f); } }
    }
}

namespace att {
constexpr int QBLK = 32, KVBLK = 64;
constexpr float SCALE = 0.10206207261596577f;
constexpr float THR = 8.f;
constexpr int SHM_V = 64 * 128 * 2, SHM_K = 64 * 256;
constexpr int LDS_ATT = 2 * SHM_V + 2 * SHM_K + 8 * 64 * 4;
#define KSWZ(row, colB) ((row) * 256 + ((colB) ^ (((row) & 7) << 4)))
__device__ __forceinline__ int crow(int r, int hi) { return (r & 3) + 8 * (r >> 2) + 4 * hi; }
__device__ __forceinline__ void partialSM(f32x16& p0, f32x16& p1, float& m_reg, float& mn, float& alpha) {
  constexpr float C = SCALE * 1.4426950408889634f;
  float pmax = p0[0];
#pragma unroll
  for (int r = 1; r < 16; ++r) pmax = fmaxf(pmax, p0[r]);
#pragma unroll
  for (int r = 0; r < 16; ++r) pmax = fmaxf(pmax, p1[r]);
  { auto rr = __builtin_amdgcn_permlane32_swap(__float_as_uint(pmax), __float_as_uint(pmax), false, false);
    pmax = fmaxf(__uint_as_float(rr[0]), __uint_as_float(rr[1])); }
  if (__builtin_expect(__all(pmax - m_reg <= THR / SCALE), 1)) { mn = m_reg; alpha = 1.f; }
  else { mn = fmaxf(m_reg, pmax); alpha = __builtin_amdgcn_exp2f((m_reg - mn) * C); m_reg = mn; }
  float mnC = -mn * C;
#pragma unroll
  for (int r = 0; r < 16; ++r) p0[r] = fmaf(p0[r], C, mnC);
#pragma unroll
  for (int r = 0; r < 16; ++r) p1[r] = fmaf(p1[r], C, mnC);
#pragma unroll
  for (int r = 0; r < 16; ++r) p0[r] = __builtin_amdgcn_exp2f(p0[r]);
}
__device__ __forceinline__ void finishSM(f32x16& p0, f32x16& p1, float alpha, float& l_reg, bf16x8& pa0, bf16x8& pa1, bf16x8& pa2, bf16x8& pa3) {
#pragma unroll
  for (int r = 0; r < 16; ++r) p1[r] = __builtin_amdgcn_exp2f(p1[r]);
  float ps = 0;
#pragma unroll
  for (int r = 0; r < 16; ++r) ps += p0[r];
#pragma unroll
  for (int r = 0; r < 16; ++r) ps += p1[r];
  { auto rr = __builtin_amdgcn_permlane32_swap(__float_as_uint(ps), __float_as_uint(ps), false, false);
    ps = __uint_as_float(rr[0]) + __uint_as_float(rr[1]); }
  l_reg = l_reg * alpha + ps;
#define PK4(P, BASE, OUT) do { unsigned a0 = cvt_pk_bf16(P[BASE + 0], P[BASE + 1]), a1 = cvt_pk_bf16(P[BASE + 2], P[BASE + 3]);   \
    unsigned b0 = cvt_pk_bf16(P[BASE + 4], P[BASE + 5]), b1 = cvt_pk_bf16(P[BASE + 6], P[BASE + 7]);                              \
    auto r0 = __builtin_amdgcn_permlane32_swap(a0, b0, false, false); auto r1 = __builtin_amdgcn_permlane32_swap(a1, b1, false, false); \
    u32x4 w = {r0[0], r1[0], r0[1], r1[1]}; OUT = *reinterpret_cast<bf16x8*>(&w); } while (0)
  PK4(p0, 0, pa0); PK4(p0, 8, pa1); PK4(p1, 0, pa2); PK4(p1, 8, pa3);
#undef PK4
}
__device__ __forceinline__ void qkt(f32x16& p0, f32x16& p1, const char* Ks, const bf16x8* qr, int r32, int hi) {
  p0 = f32x16{}; p1 = f32x16{};
#pragma unroll
  for (int d0 = 0; d0 < 6; ++d0) { int cb = (d0 * 16 + hi * 8) * 2;
    bf16x8 b0 = *reinterpret_cast<const bf16x8*>(Ks + KSWZ(r32, cb));
    bf16x8 b1 = *reinterpret_cast<const bf16x8*>(Ks + KSWZ(32 + r32, cb));
    p0 = __builtin_amdgcn_mfma_f32_32x32x16_bf16(b0, qr[d0], p0, 0, 0, 0);
    p1 = __builtin_amdgcn_mfma_f32_32x32x16_bf16(b1, qr[d0], p1, 0, 0, 0); }
}
__device__ __forceinline__ int v_st(int k, int c) { const int kk = (k & ~0xC) | ((k & 4) << 1) | ((k & 8) >> 1); return ((kk >> 3) * 4 + (c >> 5)) * 512 + ((kk & 7) * 32 + (c & 31)) * 2; }
__device__ __forceinline__ int v_rd_base(int lane) { return ((lane & 3) << 3) | (((lane >> 2) & 3) << 6) | (((lane >> 4) & 1) << 5) | (((lane >> 5) & 1) << 8); }
constexpr int v_rd_off(int d0, int ks, int half) { return d0 * 512 + ks * 4096 + half * 2048; }
template <int OFF> __device__ __forceinline__ s16x4 tr_read(int vb) {
  s16x4 r; asm volatile("ds_read_b64_tr_b16 %0, %1 offset:%2" : "=&v"(r) : "v"(vb), "i"(OFF) : "memory"); return r;
}
template <int D0> __device__ __forceinline__ void pv_one(f32x16& od, int vb, bf16x8 pa0, bf16x8 pa1, bf16x8 pa2, bf16x8 pa3) {
  const s16x4 l0 = tr_read<v_rd_off(D0, 0, 0)>(vb), h0 = tr_read<v_rd_off(D0, 0, 1)>(vb), l1 = tr_read<v_rd_off(D0, 1, 0)>(vb), h1 = tr_read<v_rd_off(D0, 1, 1)>(vb);
  const s16x4 l2 = tr_read<v_rd_off(D0, 2, 0)>(vb), h2 = tr_read<v_rd_off(D0, 2, 1)>(vb), l3 = tr_read<v_rd_off(D0, 3, 0)>(vb), h3 = tr_read<v_rd_off(D0, 3, 1)>(vb);
  asm volatile("s_waitcnt lgkmcnt(0)" ::: "memory"); SBAR();
  od = __builtin_amdgcn_mfma_f32_32x32x16_bf16(pa0, MK8(l0, h0), od, 0, 0, 0);
  od = __builtin_amdgcn_mfma_f32_32x32x16_bf16(pa1, MK8(l1, h1), od, 0, 0, 0);
  od = __builtin_amdgcn_mfma_f32_32x32x16_bf16(pa2, MK8(l2, h2), od, 0, 0, 0);
  od = __builtin_amdgcn_mfma_f32_32x32x16_bf16(pa3, MK8(l3, h3), od, 0, 0, 0);
}
__device__ __forceinline__ void pv_d0(f32x16* o, int vb, bf16x8 pa0, bf16x8 pa1, bf16x8 pa2, bf16x8 pa3) {
  pv_one<0>(o[0], vb, pa0, pa1, pa2, pa3); pv_one<1>(o[1], vb, pa0, pa1, pa2, pa3);
}
__device__ __forceinline__ void attn_unit(const bf16_t* __restrict__ Qg, const bf16_t* __restrict__ Kg, const bf16_t* __restrict__ Vg, bf16_t* __restrict__ Og,
                                          int qrow0, int h, int rowA, int ntA, int rowB, int NT, char* lds, const int wid) {
  const int lane = fresh_lane(), tid = wid * 64 + lane, r32 = lane & 31, hi = lane >> 5;
  char* V_lds = lds; char* K_lds = lds + 2 * SHM_V;
  float* ws = (float*)(lds + 2 * SHM_V + 2 * SHM_K) + wid * 64; float* li_l = ws; float* al_l = ws + 32;
  float m_reg = -1e30f, l_reg = 0; f32x16 o[2] = {}; bf16x8 qr[6];
  const bf16_t* Qw = Qg + (size_t)(qrow0 + wid * QBLK + r32) * NQ + h * 96 + hi * 8;
#pragma unroll
  for (int d0 = 0; d0 < 6; ++d0) qr[d0] = *reinterpret_cast<const bf16x8*>(Qw + d0 * 16);
  const int sr = tid >> 4, sc = (tid & 15) * 8, vst0 = v_st(sr, sc), vst1 = v_st(32 + sr, sc);
  const int vb0 = (int)(uintptr_t)V_lds + v_rd_base(lane);
  const bf16_t* Kh = Kg + h * 96 + sc; const bf16_t* Vh = Vg + h * 128 + 64 + sc;
  struct { bf16x8 vs0, vs1, ks0, ks1; } sr_[2];
#define TROW(j) ((j) < ntA ? rowA + (j) * KVBLK : rowB + ((j) - ntA) * KVBLK)
#define SLOAD(i, j) do { const size_t r0_ = (size_t)(TROW(j) + sr); \
    sr_[i].vs0 = *reinterpret_cast<const bf16x8*>(Vh + r0_ * NKV); sr_[i].vs1 = *reinterpret_cast<const bf16x8*>(Vh + (r0_ + 32) * NKV); \
    sr_[i].ks0 = *reinterpret_cast<const bf16x8*>(Kh + r0_ * NQ); sr_[i].ks1 = *reinterpret_cast<const bf16x8*>(Kh + (r0_ + 32) * NQ); } while (0)
#define SWRITE(b, i) do { *(bf16x8*)(V_lds + (b) * SHM_V + vst0) = sr_[i].vs0;          \
    *(bf16x8*)(V_lds + (b) * SHM_V + vst1) = sr_[i].vs1; int kc = sc * 2;               \
    *(bf16x8*)(K_lds + (b) * SHM_K + KSWZ(sr, kc)) = sr_[i].ks0;                       \
    *(bf16x8*)(K_lds + (b) * SHM_K + KSWZ(32 + sr, kc)) = sr_[i].ks1; } while (0)
#define SWAIT() asm volatile("s_waitcnt vmcnt(4)" ::: "memory")
#define RESC(a) do { if (__any((a) < 1.f)) { if (hi == 0) al_l[r32] = (a); asm volatile("s_waitcnt lgkmcnt(0)" ::: "memory"); \
    _Pragma("unroll") for (int d = 0; d < 2; ++d) _Pragma("unroll") for (int r = 0; r < 16; ++r) o[d][r] *= al_l[crow(r, hi)]; } } while (0)
  f32x16 pA0, pA1, pB0, pB1; float mnA, mnB, alA, alB; bf16x8 pa0, pa1, pa2, pa3;
  constexpr int SE = 0, SO = 1;
  SLOAD(SE, 0); asm volatile("s_waitcnt vmcnt(0)" ::: "memory"); SWRITE(0, SE); __syncthreads();
  qkt(pA0, pA1, K_lds, qr, r32, hi); partialSM(pA0, pA1, m_reg, mnA, alA);
  SLOAD(SO, 1); if (2 < NT) SLOAD(SE, 2);
  SWAIT(); SWRITE(1, SO); __syncthreads();
  for (int j = 1; j + 1 < NT; j += 2) {
    SBAR(); qkt(pB0, pB1, K_lds + SHM_K, qr, r32, hi);
    finishSM(pA0, pA1, alA, l_reg, pa0, pa1, pa2, pa3); SBAR();
    SLOAD(SO, j + 2); SBAR();
    pv_d0(o, vb0, pa0, pa1, pa2, pa3); partialSM(pB0, pB1, m_reg, mnB, alB);
    __syncthreads(); SWAIT(); SWRITE(0, SE);
    RESC(alB); __syncthreads();
    SBAR(); qkt(pA0, pA1, K_lds, qr, r32, hi);
    finishSM(pB0, pB1, alB, l_reg, pa0, pa1, pa2, pa3); SBAR();
    if (j + 3 < NT) SLOAD(SE, j + 3); SBAR();
    pv_d0(o, vb0 + SHM_V, pa0, pa1, pa2, pa3); partialSM(pA0, pA1, m_reg, mnA, alA);
    __syncthreads(); SWAIT(); SWRITE(1, SO);
    RESC(alA); __syncthreads();
  }
  SBAR(); qkt(pB0, pB1, K_lds + SHM_K, qr, r32, hi);
  finishSM(pA0, pA1, alA, l_reg, pa0, pa1, pa2, pa3); SBAR();
  pv_d0(o, vb0, pa0, pa1, pa2, pa3); partialSM(pB0, pB1, m_reg, mnB, alB);
  __syncthreads(); RESC(alB);
  finishSM(pB0, pB1, alB, l_reg, pa0, pa1, pa2, pa3); SBAR();
  pv_d0(o, vb0 + SHM_V, pa0, pa1, pa2, pa3);
  if (hi == 0) li_l[r32] = l_reg; asm volatile("s_waitcnt lgkmcnt(0)" ::: "memory");
  float rli[16];
#pragma unroll
  for (int r = 0; r < 16; ++r) rli[r] = __builtin_amdgcn_rcpf(li_l[crow(r, hi)]);
  bf16_t* Ow = Og + (size_t)(qrow0 + wid * QBLK) * DM + 512 + h * 64;
#pragma unroll
  for (int r = 0; r < 16; ++r) { const int orow = crow(r, hi);
#pragma unroll
    for (int d0 = 0; d0 < 2; ++d0) Ow[(size_t)orow * DM + d0 * 32 + r32] = (bf16_t)(cvt_pk_bf16(o[d0][r] * rli[r], 0.f) & 0xffffu); }
  __syncthreads();
#undef TROW
#undef SLOAD
#undef SWRITE
#undef SWAIT
#undef RESC
}
}

namespace ml {
constexpr int PQ = 272, PP = 144;
constexpr int OFF_Q = 0, OFF_K = 17408, OFF_V = 34816, OFF_W = 52224  , OFF_P = 69632, OFF_CB = 78848, OFF_N = 113664, OFF_QN = 114176, OFF_DP = 114432, OFF_NP = 114944,
              OFF_AA = 116992  , OFF_AC = 125184  , OFF_AB = 133376  , OFF_MC = 141568  , LDS_ML = 141824;
__device__ __forceinline__ f32x4 mfma16(bf16x8 a, bf16x8 b, f32x4 c) { return __builtin_amdgcn_mfma_f32_16x16x32_bf16(a, b, c, 0, 0, 0); }
__device__ __forceinline__ u32x2 pack4(f32x4 v) { u32x2 w; w.x = cvt_pk_bf16(v.x, v.y); w.y = cvt_pk_bf16(v.z, v.w); return w; }

__device__ __forceinline__ void mlstm_seq(const Args& a, LAS unsigned char* lds, int kind, int b, int h, int dir, const int wave) {
    const int lane = fresh_lane(), tid = wave * 64 + lane, g = lane >> 4, i = lane & 15;
    const int T = kind ? TL : TC, nc = T / 64, rowbase = kind ? MC + b * TL : b * TC;
    const bf16_t* PROJ = (const bf16_t*)(a.ws + WS_PROJ); const float* gates = (const float*)(a.ws + WS_GATES);
    bf16_t* Hout = (bf16_t*)a.out + (dir ? (size_t)M * 512 : 0);
#define ROWP(p) (rowbase + (dir ? T - 1 - (p) : (p)))
    LAS float* const sa = (LAS float*)(lds + OFF_AA); LAS float* const sA = (LAS float*)(lds + OFF_AC); LAS float* const sbb = (LAS float*)(lds + OFF_AB); LAS float* const smc = (LAS float*)(lds + OFF_MC);
    const int s0 = tid >> 4, c8 = tid & 15;
    u32x4 pq[2], pk[2], pv[2];
#define LOADCH(c) do { _Pragma("unroll") for (int e = 0; e < 2; ++e) { const bf16_t* rp = PROJ + (size_t)ROWP(64 * (c) + s0 + 32 * e) * NINP + h * 128 + c8 * 8; \
        pq[e] = *(const u32x4*)(rp + C_MQ); pk[e] = *(const u32x4*)(rp + C_MK); pv[e] = *(const u32x4*)(rp + C_MV); } } while (0)
    LOADCH(0);
    { const float gb_i = a.in[I_GATEB][dir * 8 + h], gb_f = a.in[I_GATEB][dir * 8 + 4 + h];
      for (int c = wave; c < nc; c += 8) { const float* gp = gates + (size_t)ROWP(64 * c + lane) * 16 + dir * 8 + h;
        const float gi = gp[0] + gb_i, gf = gp[4] + gb_f;
        const float lf = fminf(gf, 0.f) - log1pf(__expf(-fabsf(gf))); float bs = lf;
#pragma unroll
        for (int o = 1; o < 64; o <<= 1) { const float t = __shfl_up(bs, o); if (lane >= o) bs += t; }
        const float av = gi - bs; float A = av;
#pragma unroll
        for (int o = 1; o < 64; o <<= 1) { const float t = __shfl_up(A, o); if (lane >= o) A = fmaxf(A, t); }
        sa[64 * c + lane] = av; sA[64 * c + lane] = A; sbb[64 * c + lane] = bs; } }
    const int v0 = wave * 16;
    f32x4 accC[8];
    const size_t sidx = (size_t)((b * 2 + dir) * 4 + h);
    LAS float* nl = (LAS float*)(lds + OFF_N);
    if (kind) { const float* C0 = a.in[I_SC] + sidx * 16384;
#pragma unroll
        for (int kb = 0; kb < 8; ++kb) accC[kb] = *(const f32x4*)(C0 + (size_t)(16 * kb + i) * 128 + v0 + 4 * g);
        if (tid < 128) nl[tid] = a.in[I_SN][sidx * 128 + tid];
    } else {
#pragma unroll
        for (int kb = 0; kb < 8; ++kb) accC[kb] = (f32x4){0.f, 0.f, 0.f, 0.f};
        if (tid < 128) nl[tid] = 0.f;
    }
#pragma unroll
    for (int kb = 0; kb < 8; ++kb) *(LAS u32x2*)(lds + OFF_CB + (16 * kb + i) * PQ + (v0 + 4 * g) * 2) = pack4(accC[kb]);
    __syncthreads();
    f32x4 accN = (f32x4){0.f, 0.f, 0.f, 0.f}; if (g == 0) accN[0] = nl[16 * wave + i];
    if (wave == 0) { const int cc = lane < nc ? lane : 0; const float b63 = sbb[64 * cc + 63], A63 = sA[64 * cc + 63]; float m = kind ? a.in[I_SM][sidx] : 0.f;
        for (int c = 0; c < nc; ++c) { if (lane == c) smc[c] = m; m = __shfl(b63, c) + fmaxf(m, __shfl(A63, c)); }
        if (lane == 0) smc[nc] = m; }
    __syncthreads();
    for (int c = 0; c < nc; ++c) {
        const float m_c = smc[c]; const float M63 = fmaxf(m_c, sA[64 * c + 63]); const float decay = __expf(m_c - M63);
#pragma unroll
        for (int e = 0; e < 2; ++e) { const int off = (s0 + 32 * e) * PQ + c8 * 16;
            *(LAS u32x4*)(lds + OFF_Q + off) = pq[e]; *(LAS u32x4*)(lds + OFF_K + off) = pk[e]; *(LAS u32x4*)(lds + OFF_V + off) = pv[e]; }
        if (tid < 64) ((LAS float*)(lds + OFF_W))[tid] = __expf(sa[64 * c + tid] - M63);
        __syncthreads();
        if (c + 1 < nc) LOADCH(c + 1);
        {
            const int tb = wave >> 1, t = 16 * tb + i; const float Mt = fmaxf(m_c, sA[64 * c + t]); float rs = 0.f;
            bf16x8 qf[4], kf0[4], kf1[4];
#pragma unroll
            for (int kk = 0; kk < 4; ++kk) { qf[kk] = *(const LAS bf16x8*)(lds + OFF_Q + t * PQ + (32 * kk + 8 * g) * 2);
                kf0[kk] = *(const LAS bf16x8*)(lds + OFF_K + (32 * (wave & 1) + i) * PQ + (32 * kk + 8 * g) * 2);
                kf1[kk] = *(const LAS bf16x8*)(lds + OFF_K + (32 * (wave & 1) + 16 + i) * PQ + (32 * kk + 8 * g) * 2); }
            const int tq = tid >> 3, part = tid & 7; float qn_q[16];
            unpack8(*(const LAS u32x4*)(lds + OFF_Q + tq * PQ + part * 32), qn_q); unpack8(*(const LAS u32x4*)(lds + OFF_Q + tq * PQ + part * 32 + 16), qn_q + 8);
            f32x4 acc0 = (f32x4){0.f, 0.f, 0.f, 0.f}, acc1 = (f32x4){0.f, 0.f, 0.f, 0.f};
#pragma unroll
            for (int kk = 0; kk < 4; ++kk) { acc0 = mfma16(kf0[kk], qf[kk], acc0); acc1 = mfma16(kf1[kk], qf[kk], acc1); }
            float d = 0.f;
#pragma unroll
            for (int x = 0; x < 16; ++x) d += qn_q[x] * nl[part * 16 + x];
            d += __shfl_xor(d, 1); d += __shfl_xor(d, 2); d += __shfl_xor(d, 4);
            if (part == 0) ((LAS float*)(lds + OFF_QN))[tq] = d;
#pragma unroll
            for (int u = 0; u < 2; ++u) { const int sblk = 2 * (wave & 1) + u; const f32x4 acc = u ? acc1 : acc0; f32x4 p;
#pragma unroll
                for (int r = 0; r < 4; ++r) { const int s = 16 * sblk + 4 * g + r; const float wv = __expf(sa[64 * c + s] - Mt); p[r] = (s <= t) ? acc[r] * wv : 0.f; rs += p[r]; }
                *(LAS u32x2*)(lds + OFF_P + t * PP + (16 * sblk + 4 * g) * 2) = pack4(p); }
            rs += __shfl_xor(rs, 16); rs += __shfl_xor(rs, 32);
            if (g == 0) ((LAS float*)(lds + OFF_DP))[(wave & 1) * 64 + t] = rs;
        }
        __syncthreads();
        {
            const LAS unsigned char* vtr = lds + OFF_V + (8 * g + (i >> 2)) * PQ + (v0 + 4 * (i & 3)) * 2;
            const LAS unsigned char* ctr = lds + OFF_CB + (8 * g + (i >> 2)) * PQ + (v0 + 4 * (i & 3)) * 2;
            bf16x8 vfr[2], pf[2][4], cf[4];
            f32x4 w8[2][2];
#pragma unroll
            for (int kk = 0; kk < 2; ++kk) { const s16x4 lo = tr16(vtr + 32 * kk * PQ), hi_ = tr16(vtr + (32 * kk + 4) * PQ); vfr[kk] = MK8(lo, hi_);
                w8[kk][0] = *(const LAS f32x4*)(lds + OFF_W + (32 * kk + 8 * g) * 4); w8[kk][1] = *(const LAS f32x4*)(lds + OFF_W + (32 * kk + 8 * g + 4) * 4);
#pragma unroll
                for (int tb = 0; tb < 4; ++tb) pf[kk][tb] = *(const LAS bf16x8*)(lds + OFF_P + (16 * tb + i) * PP + (32 * kk + 8 * g) * 2); }
#pragma unroll
            for (int kk = 0; kk < 4; ++kk) { const s16x4 lo = tr16(ctr + 32 * kk * PQ), hi_ = tr16(ctr + (32 * kk + 4) * PQ); cf[kk] = MK8(lo, hi_); }
            f32x4 intra[4], inter[4];
#pragma unroll
            for (int tb = 0; tb < 4; ++tb) { intra[tb] = (f32x4){0.f, 0.f, 0.f, 0.f}; inter[tb] = (f32x4){0.f, 0.f, 0.f, 0.f}; }
#pragma unroll
            for (int kk = 0; kk < 2; ++kk)
#pragma unroll
                for (int tb = 0; tb < 4; ++tb) intra[tb] = mfma16(vfr[kk], pf[kk][tb], intra[tb]);
#pragma unroll
            for (int kk = 0; kk < 4; ++kk) { bf16x8 qf[4];
#pragma unroll
                for (int tb = 0; tb < 4; ++tb) qf[tb] = *(const LAS bf16x8*)(lds + OFF_Q + (16 * tb + i) * PQ + (32 * kk + 8 * g) * 2);
#pragma unroll
                for (int tb = 0; tb < 4; ++tb) inter[tb] = mfma16(cf[kk], qf[tb], inter[tb]); }
            bf16x8 vfw[2], onw[2];
#pragma unroll
            for (int kk = 0; kk < 2; ++kk) { float vf[8]; unpack8(__builtin_bit_cast(u32x4, vfr[kk]), vf); float wv[8];
#pragma unroll
                for (int x = 0; x < 4; ++x) { wv[x] = w8[kk][0][x]; wv[4 + x] = w8[kk][1][x]; }
#pragma unroll
                for (int x = 0; x < 8; ++x) vf[x] *= wv[x];
                vfw[kk] = __builtin_bit_cast(bf16x8, pack8(vf));
                u32x4 ow = pack8(wv); if (i != 0) ow = (u32x4){0u, 0u, 0u, 0u}; onw[kk] = __builtin_bit_cast(bf16x8, ow); }
#pragma unroll
            for (int kb = 0; kb < 8; ++kb) { accC[kb] = accC[kb] * decay; bf16x8 kfr[2];
#pragma unroll
                for (int kk = 0; kk < 2; ++kk) { const LAS unsigned char* kp = lds + OFF_K + (32 * kk + 8 * g + (i >> 2)) * PQ + (16 * kb + 4 * (i & 3)) * 2;
                    const s16x4 lo = tr16(kp), hi_ = tr16(kp + 4 * PQ); kfr[kk] = MK8(lo, hi_); }
                accC[kb] = mfma16(vfw[0], kfr[0], accC[kb]); accC[kb] = mfma16(vfw[1], kfr[1], accC[kb]);
                if (kb == wave) { accN = accN * decay; accN = mfma16(onw[0], kfr[0], accN); accN = mfma16(onw[1], kfr[1], accN); } }
            const LAS float* dp = (const LAS float*)(lds + OFF_DP); const LAS float* qn = (const LAS float*)(lds + OFF_QN);
#pragma unroll
            for (int tb = 0; tb < 4; ++tb) { const int t = 16 * tb + i; const float Mt = fmaxf(m_c, sA[64 * c + t]); const float wi = __expf(m_c - Mt);
                const float den = dp[t] + dp[64 + t] + wi * qn[t]; const float inv = 1.0f / fmaxf(fabsf(den), __expf(-(sbb[64 * c + t] + Mt)));
                const f32x4 hv = (intra[tb] + inter[tb] * wi) * inv;
                *(u32x2*)(Hout + (size_t)ROWP(64 * c + t) * 512 + h * 128 + v0 + 4 * g) = pack4(hv); }
        }
        __syncthreads();
#pragma unroll
        for (int kb = 0; kb < 8; ++kb) *(LAS u32x2*)(lds + OFF_CB + (16 * kb + i) * PQ + (v0 + 4 * g) * 2) = pack4(accC[kb]);
        if (g == 0) nl[16 * wave + i] = accN[0];
    }
    if (kind == 0) {
        float* oC = a.out + O_C + sidx * 16384;
#pragma unroll
        for (int kb = 0; kb < 8; ++kb) *(f32x4*)(oC + (size_t)(16 * kb + i) * 128 + v0 + 4 * g) = accC[kb];
        if (g == 0) a.out[O_N + sidx * 128 + 16 * wave + i] = accN[0];
        if (tid == 0) a.out[O_M + sidx] = smc[nc];
    }
    __syncthreads();
#undef ROWP
#undef LOADCH
}
}

constexpr int NPH = 10;
#ifndef LAUNCH_LIST
#define LAUNCH_LIST {0, 10}
#endif
constexpr int Q_NITEMS = 800;

__global__ void __launch_bounds__(NTHREADS, 2) fwd_megakernel(Args args) {
    extern __shared__ __attribute__((aligned(16))) unsigned char lds_raw[];
    LAS unsigned char* lds = (LAS unsigned char*)lds_raw;
    volatile LAS unsigned* MISC = (volatile LAS unsigned*)(lds + MISC_OFF);
    const int wave = __builtin_amdgcn_readfirstlane(threadIdx.x >> 6);
#define tid (wave * 64 + lane)
    const int G = gridDim.x, bx = blockIdx.x;
    unsigned char* ws = args.ws;
    unsigned* ctl = (unsigned*)(ws + WS_CTL);
    { const int lane = fresh_lane();
    for (int u = tid; u < (LDS_BYTES - LDSCTL_OFF) / 4; u += NTHREADS) ((LAS unsigned*)(lds + LDSCTL_OFF))[u] = 0u; }
    __syncthreads();
    XcdBarrier bar = xcd_barrier_post(ctl + CW_BAR + args.li * XCD_BAR_WORDS, MISC + 8, (unsigned)wave);
    const int lo = args.ph_lo, hi = args.ph_hi;
#define IN(k) (lo <= (k) && (k) < hi)
#define SEAM(k) do { if (IN(k) && IN((k) + 1)) xcd_barrier(bar); } while (0)
    const int gw = bx * NWAVES + wave, NGW = G * NWAVES;
    bf16_t* const HBUF = (bf16_t*)(ws + WS_H);
    float* const MOD = (float*)(ws + WS_MOD);
    float* const X1 = (float*)(ws + WS_X1);

    if (IN(0)) { const int lane = fresh_lane(); p0_prologue(args, lds, tid, lane, wave, G); SEAM(0); }
    if (IN(1)) { const int lane = fresh_lane(); norm_rows(args.in[I_XP], args.in[I_XS], args.in[I_N1G], MOD, 0, 1024, HBUF, gw, NGW, lane); SEAM(1); }
    if (IN(2)) {
        pg8::Gemm g{HBUF, (const bf16_t*)(ws + WS_WIN), M, NINP, DM}; pg8::StaticOrder S; S.init(M, NINP, G, bx);
        pg8::EpiProj E{(bf16_t*)(ws + WS_PROJ), (float*)(ws + WS_GATES)};
        pg8::gemm_phase<pg8::EpiProj, pg8::StaticOrder, true, true>(lds, g, S, E, wave);
        for (int it = (G == 256) ? (bx >= 192 ? bx - 192 : 64) : bx; it < 64; it += G) { const int lane = fresh_lane(); gemv5_item<1>(MOD, nullptr, args.in[I_WUP], nullptr, (float*)(ws + WS_BIAS2), lds, it, tid, lane, wave); }
        SEAM(2);
    }
    if (IN(3)) { const int lane = fresh_lane(); p3_rows(args, gw, NGW, lane, bx * NTHREADS + tid, G * NTHREADS); SEAM(3); }
    if (IN(4)) {
        pg8::PG8_LAS_float_ptr Xl = (pg8::PG8_LAS_float_ptr)(lds + RING_BYTES);
        int kq = QLORA, kkv = KVLORA; asm volatile("" : "+s"(kq), "+s"(kkv));
        { pg8::Gemm g{(const bf16_t*)(ws + WS_QN), (const bf16_t*)(ws + WS_WQ), M, NQP, kq}; pg8::StaticOrder S; S.init(M, NQP, G, bx);
          pg8::EpiHead<0> E{(bf16_t*)(ws + WS_Q), nullptr, args.in[I_QHG], (const float*)(ws + WS_ROPE), nullptr, nullptr, Xl};
          pg8::gemm_phase<pg8::EpiHead<0>, pg8::StaticOrder, true, true>(lds, g, S, E, wave); }
        { pg8::Gemm g{(const bf16_t*)(ws + WS_CKVN), (const bf16_t*)(ws + WS_WKV), MKV, NKV, kkv}; pg8::StaticOrder S; S.init(MKV, NKV, G, G == 256 ? ((bx + 64) & 255) : bx);
          pg8::EpiHead<1> E{(bf16_t*)(ws + WS_K), (bf16_t*)(ws + WS_KVRAW), args.in[I_KHG], (const float*)(ws + WS_ROPE), (const bf16_t*)(ws + WS_PROJ), (const bf16_t*)(ws + WS_KRC), Xl};
          pg8::gemm_phase<pg8::EpiHead<1>, pg8::StaticOrder, true, true>(lds, g, S, E, wave); }
        SEAM(4);
    }
    if (IN(5)) {
        volatile LAS int* qslot = (volatile LAS int*)(lds + MISC_OFF + 64);
        for (;;) {
            __syncthreads();
            if (wave == 0 && fresh_lane() == 0) *qslot = (int)__hip_atomic_fetch_add(ctl + CW_QUEUE + 64 * args.li, 1u, __ATOMIC_RELAXED, __HIP_MEMORY_SCOPE_AGENT);
            __syncthreads();
            const int idx = __builtin_amdgcn_readfirstlane(*qslot);
            if (idx >= Q_NITEMS) break;
#ifdef PROBE_QLO
            if (args.li == 1 && (idx < PROBE_QLO || idx >= PROBE_QHI)) continue;
#endif
            if (idx < 32) ml::mlstm_seq(args, lds, 1, idx >> 3, (idx >> 1) & 3, idx & 1, wave);
            else if (idx < 288) { const int j = idx - 32, b = j >> 6, h = (j >> 3) & 7, qb = j & 7;
                att::attn_unit((const bf16_t*)(ws + WS_Q), (const bf16_t*)(ws + WS_K), (const bf16_t*)(ws + WS_KVRAW), HBUF, MC + b * TL + qb * 256, h, MC + b * TL, 32, M + b * 256, 36, (char*)lds_raw, wave); }
            else if (idx < 544) { const int j = idx - 288; ml::mlstm_seq(args, lds, 0, j >> 3, (j >> 1) & 3, j & 1, wave); }
            else { const int j = idx - 544, b = j >> 3, h = j & 7;
                att::attn_unit((const bf16_t*)(ws + WS_Q), (const bf16_t*)(ws + WS_K), (const bf16_t*)(ws + WS_KVRAW), HBUF, b * TC, h, b * TC, 4, 0, 4, (char*)lds_raw, wave); }
        }
        SEAM(5);
    }
    if (IN(6)) { const int lane = fresh_lane(); p6b_hm(args, gw, NGW, lane); SEAM(6); }
    if (IN(7)) {
        pg8::Gemm g{HBUF, (const bf16_t*)(ws + WS_WO), M, DM, DM}; pg8::StaticOrder S; S.init(M, DM, G, bx);
        pg8::EpiMix E{args.in[I_XP], args.in[I_XS], X1, (bf16_t*)(ws + WS_XG), MOD, args.in[I_N2G], (float*)(ctl + CW_ROWSQ)};
        pg8::gemm_phase<pg8::EpiMix, pg8::StaticOrder, true, true>(lds, g, S, E, wave);
        SEAM(7);
    }
    if (IN(8)) {
        pg8::Gemm g{(const bf16_t*)(ws + WS_XG), (const bf16_t*)(ws + WS_WUP), M, FF, DM}; pg8::StaticOrder S; S.init(M, FF, G, bx);
        pg8::EpiUp E{(bf16_t*)(ws + WS_U), (const float*)(ctl + CW_ROWSQ), (const float*)(ws + WS_BIAS2)};
        pg8::gemm_phase<pg8::EpiUp, pg8::StaticOrder, true, true>(lds, g, S, E, wave);
        SEAM(8);
    }
    if (IN(9)) {
        pg8::Gemm g{(const bf16_t*)(ws + WS_U), (const bf16_t*)(ws + WS_WDN), M, DM, FF}; pg8::StaticOrder S; S.init(M, DM, G, bx);
        pg8::EpiResGate E{X1, X1 + (size_t)MC * DM, args.out, MOD, 5120};
        pg8::gemm_phase<pg8::EpiResGate, pg8::StaticOrder, true, true>(lds, g, S, E, wave);
    }
static_assert(ml::LDS_ML <= LDSCTL_OFF && att::LDS_ATT <= LDSCTL_OFF, "phase scratch below the LDS control words");
#undef IN
#undef SEAM
#undef tid
}

extern "C" void kernel_launch(void* const* d_in, const int* in_sizes, int n_in, void* d_out, int out_size, void* d_ws, size_t ws_size, hipStream_t stream) {
    static int grid = 0;
    if (grid == 0) {
        if (n_in != 25 || in_sizes[0] != MC * DM || in_sizes[1] != ML * DM || out_size != (int)O_END || ws_size < WS_END) {
            fprintf(stderr, "kernel_launch: unexpected shapes: n_in %d in0 %d in1 %d out %d ws %zu (need >= %zu); nothing launched\n", n_in, n_in > 0 ? in_sizes[0] : -1, n_in > 1 ? in_sizes[1] : -1, out_size, ws_size, (size_t)WS_END); grid = -1; return; }
        int dev = 0, cus = 0, per_cu = 0;
        if (hipGetDevice(&dev) != hipSuccess || hipDeviceGetAttribute(&cus, hipDeviceAttributeMultiprocessorCount, dev) != hipSuccess) { fprintf(stderr, "kernel_launch: device query failed\n"); grid = -1; return; }
        if (hipFuncSetAttribute((const void*)fwd_megakernel, hipFuncAttributeMaxDynamicSharedMemorySize, LDS_BYTES) != hipSuccess) { fprintf(stderr, "kernel_launch: hipFuncSetAttribute failed\n"); grid = -1; return; }
        if (hipOccupancyMaxActiveBlocksPerMultiprocessor(&per_cu, (const void*)fwd_megakernel, NTHREADS, LDS_BYTES) != hipSuccess || per_cu < 1) {
            fprintf(stderr, "kernel_launch: occupancy query reports %d workgroups per CU; nothing launched\n", per_cu); (void)hipGetLastError(); grid = -1; return; }
        grid = cus;
    }
    if (grid < 0) return;
    if (hipMemsetAsync((char*)d_ws + WS_CTL, 0, CTL_ZERO_BYTES, stream) != hipSuccess) { fprintf(stderr, "kernel_launch: memset failed\n"); return; }
    Args a{};
    for (int i = 0; i < 25; ++i) a.in[i] = (const float*)d_in[i];
    a.out = (float*)d_out; a.ws = (unsigned char*)d_ws;
    static const int plist[] = LAUNCH_LIST;
    for (int li = 0; li < (int)(sizeof(plist) / sizeof(int)) / 2; ++li) {
        a.ph_lo = plist[2 * li]; a.ph_hi = plist[2 * li + 1]; a.li = li;
        hipLaunchKernelGGL(fwd_megakernel, dim3(grid), dim3(NTHREADS), LDS_BYTES, stream, a);
        const hipError_t le = hipPeekAtLastError();
        if (le != hipSuccess) { fprintf(stderr, "kernel_launch: launch %d failed: %s\n", li, hipGetErrorName(le)); break; }
    }
}
```

```cpp
#include <hip/hip_runtime.h>
#include <hip/hip_bf16.h>
#include <cstdio>
#include <cstdint>


#define LAS __attribute__((address_space(3)))
#define GAS __attribute__((address_space(1)))
typedef unsigned short bf16_t;
typedef short bf16x8 __attribute__((ext_vector_type(8)));
typedef short s16x4 __attribute__((ext_vector_type(4)));
typedef float f32x4 __attribute__((ext_vector_type(4)));
typedef float f32x2 __attribute__((ext_vector_type(2)));
typedef float f32x16 __attribute__((ext_vector_type(16)));
typedef unsigned u32x4 __attribute__((ext_vector_type(4)));
typedef unsigned u32x2 __attribute__((ext_vector_type(2)));

constexpr int DM = 1024, MC = 8192, ML = 8192, M = 16384, TC = 256, TL = 2048, NBC = 32, NBL = 4;
constexpr int NIN = 2736, NINP = 2816;
constexpr int C_MQ = 0, C_MK = 512, C_MV = 1024, C_MO = 1536, C_QLAT = 2048, C_KVLAT = 2432, C_KROPE = 2688, C_GATE = 2720;
constexpr int QLORA = 384, KVLORA = 256, NQ = 768, NQP = 1024  , NKV = 1024, FF = 4096;
constexpr int MKV = M + NBL * 256;
constexpr float EPS = 1e-6f;

constexpr size_t O_Y = 0, O_Z = 8388608, O_CKV = 16777216, O_KROPE = 18874368, O_C = 19136512, O_N = 23330816, O_M = 23363584, O_END = 23363840;

constexpr size_t MiB = 1u << 20;
constexpr size_t WS_CTL = 0, CTL_ZERO_BYTES = 1 * MiB;
constexpr size_t WS_MOD = 1 * MiB, WS_ROPE = 1 * MiB + 131072;
constexpr size_t WS_WIN = 2 * MiB, WS_WQ = 8 * MiB, WS_WKV = 9 * MiB, WS_WO = 10 * MiB, WS_WUP = 12 * MiB, WS_WDN = 20 * MiB, WS_GATES = 28 * MiB, WS_KRC = 29 * MiB;
constexpr size_t WS_H = 32 * MiB;
constexpr size_t WS_QN = 32 * MiB, WS_CKVN = 44 * MiB;
constexpr size_t WS_PROJ = 64 * MiB, WS_Q = 152 * MiB, WS_KVRAW = 176 * MiB, WS_K = 210 * MiB;
constexpr size_t WS_X1 = 192 * MiB, WS_END = 256 * MiB;
constexpr size_t WS_U = 32 * MiB;
constexpr size_t WS_XG = 160 * MiB;
constexpr size_t WS_BIAS2 = 30 * MiB;
constexpr int CW_TMO = 0, CW_QUEUE = 64, CW_BAR = 4096, CW_ROWSQ = 131072;

__device__ __forceinline__ unsigned cvt_pk_bf16(float lo, float hi) { unsigned r; asm volatile("v_cvt_pk_bf16_f32 %0, %1, %2" : "=v"(r) : "v"(lo), "v"(hi)); return r; }
__device__ __forceinline__ float bf2f(unsigned short x) { return __uint_as_float(((unsigned)x) << 16); }
__device__ __forceinline__ float bflo(unsigned w) { return __uint_as_float(w << 16); }
__device__ __forceinline__ float bfhi(unsigned w) { return __uint_as_float(w & 0xffff0000u); }
__device__ __forceinline__ void unpack8(u32x4 w, float* f) { f[0] = bflo(w.x); f[1] = bfhi(w.x); f[2] = bflo(w.y); f[3] = bfhi(w.y); f[4] = bflo(w.z); f[5] = bfhi(w.z); f[6] = bflo(w.w); f[7] = bfhi(w.w); }
__device__ __forceinline__ u32x4 pack8(const float* f) { u32x4 w; w.x = cvt_pk_bf16(f[0], f[1]); w.y = cvt_pk_bf16(f[2], f[3]); w.z = cvt_pk_bf16(f[4], f[5]); w.w = cvt_pk_bf16(f[6], f[7]); return w; }
__device__ __forceinline__ float wave_sum(float v) {
#pragma unroll
    for (int o = 1; o < 64; o <<= 1) v += __shfl_xor(v, o);
    return v;
}
__device__ __forceinline__ int fresh_lane() { int l; asm volatile("v_mbcnt_lo_u32_b32 %0, -1, 0\n\tv_mbcnt_hi_u32_b32 %0, -1, %0" : "=v"(l)); return l; }
#define LDS_WAIT() asm volatile("s_waitcnt lgkmcnt(0)" ::: "memory")
#define VM_WAIT() asm volatile("s_waitcnt vmcnt(0)" ::: "memory")
#define SBAR() __builtin_amdgcn_sched_barrier(0)
typedef short v4i16_t __attribute__((ext_vector_type(4)));
__device__ __forceinline__ s16x4 tr16(const LAS unsigned char* p) { return __builtin_bit_cast(s16x4, __builtin_amdgcn_ds_read_tr16_b64_v4i16((LAS v4i16_t*)p)); }
#define MK8(L, H) (bf16x8){L[0], L[1], L[2], L[3], H[0], H[1], H[2], H[3]}

namespace pg8 {
#define PG8_LAS __attribute__((address_space(3)))
typedef PG8_LAS float* PG8_LAS_float_ptr;
constexpr int BM = 256, BK = 64, HALF = 128, HTB = HALF * BK * 2  , STAGE_BYTES = 8 * HTB, NXCD = 8, WGM = 8;

__host__ __device__ __forceinline__ int lds_byte(int r, int c) { const int st = (r >> 4) * 2 + (c >> 5), rr = r & 15, cc = c & 31, ob = rr * 64 + cc * 2; return st * 1024 + (ob ^ (((ob >> 9) & 1) << 5)); }
__host__ __device__ __forceinline__ void stage_rc(int b, int& R, int& C) { const int st = b / 1024, sb = b % 1024, swz = sb ^ (((sb >> 9) & 1) << 5); R = (st >> 1) * 16 + swz / 64; C = (st & 1) * 32 + (swz % 64) / 2; }
__host__ __device__ __forceinline__ int perm32(int rho) { const int n = rho >> 4, i = rho & 15; return 8 * (i >> 2) + 4 * n + (i & 3); }

struct Unit { int pm, pn; };
struct Gemm { const bf16_t* A; const bf16_t* Bt; int M, N, K; };

struct StaticOrder {
    int nM, nN, nwg, G, c;
    __host__ __device__ void init(int M, int N, int G_, int c_) { nM = M / BM; nN = N / BM; nwg = nM * nN; G = G_; c = c_; }
    __host__ __device__ bool next(int i, Unit& u) const {
        const long L = (long)i * G + c; if (L >= nwg) return false;
        int wgid = (int)L; { const int q = nwg / NXCD, r = nwg % NXCD, xcd = wgid % NXCD, off = wgid / NXCD; wgid = (xcd < r ? xcd * (q + 1) : r * (q + 1) + (xcd - r) * q) + off; }
        const int nig = WGM * nN, gid = wgid / nig, fm = gid * WGM, gsz = (nM - fm) < WGM ? (nM - fm) : WGM;
        u.pm = fm + ((wgid % nig) % gsz); u.pn = (wgid % nig) / gsz; return true;
    }
    __device__ __forceinline__ void a_ready(const Unit&) const {}
    __device__ __forceinline__ void done(const Unit&) const {}
};


template <int ACT> struct EpiBf16 {
    static constexpr bool PERM = true, AFTER_DRAIN = false;
    bf16_t* O; int ldc;
    __device__ __forceinline__ void operator()(const f32x4 (&acc)[2][2][4][2], const Unit& u, int wr, int wc, int fr, int fq) const {
        const int row0 = u.pm * BM + wr * 64 + fr, col0 = u.pn * BM + wc * 32 + 8 * fq;
#pragma unroll
        for (int ai = 0; ai < 2; ++ai)
#pragma unroll
            for (int m = 0; m < 4; ++m) { bf16_t* rowp = O + (size_t)(row0 + ai * HALF + m * 16) * ldc + col0;
#pragma unroll
                for (int bj = 0; bj < 2; ++bj) { f32x4 v0 = acc[ai][bj][m][0], v1 = acc[ai][bj][m][1];
                    if (ACT == 2) {
#pragma unroll
                        for (int e = 0; e < 4; ++e) { const float a = fmaxf(v0[e], 0.f), b = fmaxf(v1[e], 0.f); v0[e] = a * a; v1[e] = b * b; } }
                    u32x4 w; w.x = cvt_pk_bf16(v0[0], v0[1]); w.y = cvt_pk_bf16(v0[2], v0[3]); w.z = cvt_pk_bf16(v1[0], v1[1]); w.w = cvt_pk_bf16(v1[2], v1[3]);
                    *(u32x4*)(rowp + bj * HALF) = w; } }
    }
};
struct EpiProj {
    static constexpr bool PERM = true, AFTER_DRAIN = false;
    bf16_t* O; float* gates;
    __device__ __forceinline__ void operator()(const f32x4 (&acc)[2][2][4][2], const Unit& u, int wr, int wc, int fr, int fq) const {
        const int row0 = u.pm * BM + wr * 64 + fr, col0 = u.pn * BM + wc * 32 + 8 * fq;
        const float ksc = (u.pn == 2 || u.pn == 3) ? 0.08838834764831845f : 1.0f;
#pragma unroll
        for (int ai = 0; ai < 2; ++ai)
#pragma unroll
            for (int m = 0; m < 4; ++m) { const int row = row0 + ai * HALF + m * 16; bf16_t* rowp = O + (size_t)row * NINP + col0;
#pragma unroll
                for (int bj = 0; bj < 2; ++bj) { const f32x4 v0 = acc[ai][bj][m][0] * ksc, v1 = acc[ai][bj][m][1] * ksc; const int c = col0 + bj * HALF;
                    if (c >= C_GATE && c < C_GATE + 16) { float* gp = gates + (size_t)row * 16 + (c - C_GATE); *(f32x4*)gp = v0; *(f32x4*)(gp + 4) = v1; }
                    u32x4 w; w.x = cvt_pk_bf16(v0[0], v0[1]); w.y = cvt_pk_bf16(v0[2], v0[3]); w.z = cvt_pk_bf16(v1[0], v1[1]); w.w = cvt_pk_bf16(v1[2], v1[3]);
                    *(u32x4*)(rowp + bj * HALF) = w; } }
    }
};
__device__ __forceinline__ float sum_x16_x32(float v) {
    auto a = __builtin_amdgcn_permlane16_swap(__float_as_uint(v), __float_as_uint(v), false, false); v = __uint_as_float(a[0]) + __uint_as_float(a[1]);
    auto b = __builtin_amdgcn_permlane32_swap(__float_as_uint(v), __float_as_uint(v), false, false); return __uint_as_float(b[0]) + __uint_as_float(b[1]);
}
__device__ __forceinline__ float partner_x32(float v, bool upper) {
    auto b = __builtin_amdgcn_permlane32_swap(__float_as_uint(v), __float_as_uint(v), false, false); return __uint_as_float(upper ? b[0] : b[1]);
}
template <int IS_KV> struct EpiHead {
    static constexpr bool PERM = true, AFTER_DRAIN = false;
    bf16_t* O; bf16_t* V; const float* gain; const bf16_t* proj; const bf16_t* krc; PG8_LAS float* X;
    __device__ __forceinline__ void operator()(const f32x4 (&acc)[2][2][4][2], const Unit& u, int wr, int wc, int fr, int fq) const {
        { const int l_ = fresh_lane(); fr = l_ & 15; fq = l_ >> 4; }
        const bool lat = u.pm >= MC / BM && u.pm < M / BM;
        PG8_LAS float* Xr = X + 2048;
        const int c8 = 32 * wc + 8 * fq;
        u32x4 krw[2][4];
        if (IS_KV && wc == 2) {
#pragma unroll
            for (int ai = 0; ai < 2; ++ai)
#pragma unroll
                for (int m = 0; m < 4; ++m) { const int row = u.pm * BM + ai * HALF + wr * 64 + m * 16 + fr;
                    krw[ai][m] = *(const u32x4*)(row < M ? proj + (size_t)row * NINP + C_KROPE + 8 * fq : krc + (size_t)(row - M) * 32 + 8 * fq); } }
#pragma unroll
        for (int ai = 0; ai < 2; ++ai)
#pragma unroll
            for (int m = 0; m < 4; ++m) { const int rl = ai * HALF + wr * 64 + m * 16 + fr;
#pragma unroll
                for (int bj = 0; bj < 2; ++bj) { const f32x4 v0 = acc[ai][bj][m][0], v1 = acc[ai][bj][m][1];
                    float ss = ((v0.x * v0.x + v0.y * v0.y) + (v0.z * v0.z + v0.w * v0.w)) + ((v1.x * v1.x + v1.y * v1.y) + (v1.z * v1.z + v1.w * v1.w));
                    ss = sum_x16_x32(ss);
                    if (fq == 0) X[(rl * 2 + bj) * 4 + wc] = ss; }
                if (IS_KV && wc == 2) { float kr[8]; unpack8(krw[ai][m], kr); float ss = 0.f;
#pragma unroll
                    for (int e = 0; e < 8; ++e) ss += kr[e] * kr[e];
                    ss = sum_x16_x32(ss);
                    if (fq == 0) Xr[rl] = ss; } }
        asm volatile("s_waitcnt lgkmcnt(0)" ::: "memory"); __builtin_amdgcn_s_barrier(); asm volatile("" ::: "memory");
        f32x4 g0 = (f32x4){0.f, 0.f, 0.f, 0.f}, g1 = g0;
        if (IS_KV ? wc <= 2 : wc < 3) { g0 = *(const f32x4*)(gain + c8); g1 = *(const f32x4*)(gain + c8 + 4); }
#pragma unroll
        for (int ai = 0; ai < 2; ++ai)
#pragma unroll
            for (int m = 0; m < 4; ++m) { const int rl = ai * HALF + wr * 64 + m * 16 + fr, row = u.pm * BM + rl;
                const int tpos = (row - MC) & (TL - 1); const float pos = (float)((fq & 1) ? (tpos & 63) : (tpos >> 6));
#pragma unroll
                for (int bj = 0; bj < 2; ++bj) { const int hd = 2 * u.pn + bj;
                    const f32x4 xp = *(const PG8_LAS f32x4*)(X + (rl * 2 + bj) * 4);
                    const float tot = IS_KV ? (xp.x + xp.y) + Xr[rl] : (xp.x + xp.y) + (xp.z + xp.w);
                    const float rstd = 1.0f / sqrtf(tot * (1.0f / 96.0f) + EPS);
                    if (IS_KV && wc >= 2) {
                        const f32x4 v0 = acc[ai][bj][m][0], v1 = acc[ai][bj][m][1];
                        u32x4 w; w.x = cvt_pk_bf16(v0[0], v0[1]); w.y = cvt_pk_bf16(v0[2], v0[3]); w.z = cvt_pk_bf16(v1[0], v1[1]); w.w = cvt_pk_bf16(v1[2], v1[3]);
                        *(u32x4*)(V + (size_t)row * NKV + hd * 128 + 64 + (c8 - 64)) = w; }
                    if (IS_KV ? wc <= 2 : wc < 3) {
                        float v[8];
                        if (IS_KV && wc == 2) unpack8(krw[ai][m], v);
                        else {
#pragma unroll
                            for (int e = 0; e < 4; ++e) { v[e] = acc[ai][bj][m][0][e]; v[4 + e] = acc[ai][bj][m][1][e]; } }
#pragma unroll
                        for (int e = 0; e < 4; ++e) { v[e] *= rstd * g0[e]; v[4 + e] *= rstd * g1[e]; }
                        if (wc == 2) {
#pragma unroll
                            for (int e = 0; e < 8; ++e) { const float p = partner_x32(v[e], fq >= 2);
                                if (lat) { constexpr float LOG2B8 = 0.125f * 13.287712379549449f;
                                    float rev = pos * (exp2f(-(float)e * LOG2B8) * 0.15915494309189535f); rev -= floorf(rev);
                                    const float cq = __builtin_amdgcn_cosf(rev), sq = __builtin_amdgcn_sinf(rev);
                                    v[e] = fq < 2 ? v[e] * cq - p * sq : p * sq + v[e] * cq; } } }
                        u32x4 w; w.x = cvt_pk_bf16(v[0], v[1]); w.y = cvt_pk_bf16(v[2], v[3]); w.z = cvt_pk_bf16(v[4], v[5]); w.w = cvt_pk_bf16(v[6], v[7]);
                        *(u32x4*)(O + (size_t)row * NQ + hd * 96 + c8) = w; } } }
        asm volatile("s_waitcnt lgkmcnt(0)" ::: "memory"); __builtin_amdgcn_s_barrier(); asm volatile("" ::: "memory");
    }
};
struct EpiUp {
    static constexpr bool PERM = true, AFTER_DRAIN = false;
    bf16_t* O; const float* rowsq; const float* bias;
    __device__ __forceinline__ void operator()(const f32x4 (&acc)[2][2][4][2], const Unit& u, int wr, int wc, int fr, int fq) const {
        const int row0 = u.pm * BM + wr * 64 + fr, col0 = u.pn * BM + wc * 32 + 8 * fq;
        const int cond = u.pm < (MC / BM) ? 0 : 1 + (u.pm - MC / BM) / (TL / BM);
        const float* bp = bias + cond * FF + col0;
        f32x4 bv[2][2];
#pragma unroll
        for (int bj = 0; bj < 2; ++bj) { bv[bj][0] = *(const f32x4*)(bp + bj * HALF); bv[bj][1] = *(const f32x4*)(bp + bj * HALF + 4); }
#pragma unroll
        for (int ai = 0; ai < 2; ++ai)
#pragma unroll
            for (int m = 0; m < 4; ++m) { const int row = row0 + ai * HALF + m * 16; bf16_t* rowp = O + (size_t)row * FF + col0;
                const float rstd = 1.0f / sqrtf(__hip_atomic_load(rowsq + row, __ATOMIC_RELAXED, __HIP_MEMORY_SCOPE_AGENT) * (1.0f / DM) + EPS);
#pragma unroll
                for (int bj = 0; bj < 2; ++bj) { f32x4 v0 = acc[ai][bj][m][0] * rstd + bv[bj][0], v1 = acc[ai][bj][m][1] * rstd + bv[bj][1];
#pragma unroll
                    for (int e = 0; e < 4; ++e) { const float a = fmaxf(v0[e], 0.f), b = fmaxf(v1[e], 0.f); v0[e] = a * a; v1[e] = b * b; }
                    u32x4 w; w.x = cvt_pk_bf16(v0[0], v0[1]); w.y = cvt_pk_bf16(v0[2], v0[3]); w.z = cvt_pk_bf16(v1[0], v1[1]); w.w = cvt_pk_bf16(v1[2], v1[3]);
                    *(u32x4*)(rowp + bj * HALF) = w; } }
    }
};
struct EpiMix {
    static constexpr bool PERM = false, AFTER_DRAIN = false;
    const float* xa; const float* xb; float* x1; bf16_t* xg; const float* mod; const float* n2g; float* rowsq;
    __device__ __forceinline__ void operator()(const f32x4 (&acc)[2][2][4][2], const Unit& u, int wr, int wc, int fr, int fq) const {
        const int col0 = u.pn * BM + wc * 32 + 4 * fq;
        const int cond = u.pm < (MC / BM) ? 0 : 1 + (u.pm - MC / BM) / (TL / BM);
        const float* g = mod + cond * 6144 + 2048 + col0; const float* sc = mod + cond * 6144 + 4096 + col0; const float* ng = n2g + col0;
        f32x4 gv[2][2], gm[2][2];
#pragma unroll
        for (int bj = 0; bj < 2; ++bj)
#pragma unroll
            for (int n = 0; n < 2; ++n) { gv[bj][n] = *(const f32x4*)(g + bj * HALF + n * 16); gm[bj][n] = *(const f32x4*)(ng + bj * HALF + n * 16) * (*(const f32x4*)(sc + bj * HALF + n * 16) + 1.0f); }
#pragma unroll
        for (int ai = 0; ai < 2; ++ai)
#pragma unroll
            for (int m = 0; m < 4; ++m) { const int row = u.pm * BM + ai * HALF + wr * 64 + m * 16 + fr;
                const float* xr = (row < MC ? xa + (size_t)row * DM : xb + (size_t)(row - MC) * DM) + col0; float* orow = x1 + (size_t)row * DM + col0; bf16_t* grow = xg + (size_t)row * DM + col0;
                float ss = 0.f;
#pragma unroll
                for (int bj = 0; bj < 2; ++bj)
#pragma unroll
                    for (int n = 0; n < 2; ++n) { const f32x4 xv = *(const f32x4*)(xr + bj * HALF + n * 16); const f32x4 o = xv + gv[bj][n] * acc[ai][bj][m][n];
                        *(f32x4*)(orow + bj * HALF + n * 16) = o; ss += (o.x * o.x + o.y * o.y) + (o.z * o.z + o.w * o.w);
                        const f32x4 og = o * gm[bj][n]; u32x2 w; w.x = cvt_pk_bf16(og.x, og.y); w.y = cvt_pk_bf16(og.z, og.w); *(u32x2*)(grow + bj * HALF + n * 16) = w; }
                ss += __shfl_xor(ss, 16); ss += __shfl_xor(ss, 32);
                if (fq == 0) __hip_atomic_fetch_add(rowsq + row, ss, __ATOMIC_RELAXED, __HIP_MEMORY_SCOPE_AGENT); }
    }
};
struct EpiResGate {
    static constexpr bool PERM = false, AFTER_DRAIN = false;
    const float* xa; const float* xb; float* out; const float* mod; int goff;
    __device__ __forceinline__ void operator()(const f32x4 (&acc)[2][2][4][2], const Unit& u, int wr, int wc, int fr, int fq) const {
        const int col0 = u.pn * BM + wc * 32 + 4 * fq;
        const int cond = u.pm < (MC / BM) ? 0 : 1 + (u.pm - MC / BM) / (TL / BM);
        const float* g = mod + cond * 6144 + goff + col0;
        f32x4 gv[2][2];
#pragma unroll
        for (int bj = 0; bj < 2; ++bj)
#pragma unroll
            for (int n = 0; n < 2; ++n) gv[bj][n] = *(const f32x4*)(g + bj * HALF + n * 16);
#pragma unroll
        for (int ai = 0; ai < 2; ++ai)
#pragma unroll
            for (int m = 0; m < 4; ++m) { const int row = u.pm * BM + ai * HALF + wr * 64 + m * 16 + fr;
                const float* xr = (row < MC ? xa + (size_t)row * DM : xb + (size_t)(row - MC) * DM) + col0; float* orow = out + (size_t)row * DM + col0;
#pragma unroll
                for (int bj = 0; bj < 2; ++bj)
#pragma unroll
                    for (int n = 0; n < 2; ++n) { const f32x4 xv = *(const f32x4*)(xr + bj * HALF + n * 16); *(f32x4*)(orow + bj * HALF + n * 16) = xv + gv[bj][n] * acc[ai][bj][m][n]; } }
    }
};

template <class Epi, class Sched, bool ALIGN_EPI = false, bool SP2 = false>
__device__ __forceinline__ void gemm_phase(PG8_LAS unsigned char* lds, const Gemm g, const Sched& S, const Epi& E, const int wid  ) {
    const int lane = fresh_lane(), tid = wid * 64 + lane;
    const int wr = wid >> 2, wc = wid & 3, fr = lane & 15, fq = lane >> 4;
    const int K = g.K, nt = K / BK;
    unsigned voffA[2], voffB[2];
#pragma unroll
    for (int i = 0; i < 2; ++i) { int R, C; stage_rc(tid * 16 + i * 8192, R, C); const int Rb = Epi::PERM ? ((R & ~31) + perm32(R & 31)) : R;
        voffA[i] = (unsigned)(R * K + C) * 2u; voffB[i] = (unsigned)(Rb * K + C) * 2u; }
    const size_t kstep = (size_t)(BK * 2);
    const size_t hstep = (size_t)HALF * K * 2;
    const size_t tstep = 2 * hstep;
    const unsigned ldsw = (unsigned)wid * 1024u;
    const int aoff = lds_byte(wr * 64 + fr, fq * 8), boff = lds_byte(wc * 32 + fr, fq * 8);
#define PG8_SA(b, h) (((b) * 2 + (h)) * HTB)
#define PG8_SB(b, h) ((4 + (b) * 2 + (h)) * HTB)
#define PG8_STAGE(bufoff, gbase, voff) do { _Pragma("unroll") for (int _i = 0; _i < 2; ++_i) \
        __builtin_amdgcn_global_load_lds((const unsigned*)((const char*)(gbase) + (voff)[_i]), (PG8_LAS unsigned*)(lds + (bufoff) + ldsw + _i * 8192), 16, 0, 0); } while (0)
#define PG8_LDA(dst, b, h) do { _Pragma("unroll") for (int m = 0; m < 4; ++m) _Pragma("unroll") for (int k = 0; k < 2; ++k) dst[m][k] = *(const PG8_LAS bf16x8*)(lds + PG8_SA(b, h) + aoff + m * 2048 + k * 1024); } while (0)
#define PG8_LDB(dst, b, h) do { _Pragma("unroll") for (int n = 0; n < 2; ++n) _Pragma("unroll") for (int k = 0; k < 2; ++k) dst[n][k] = *(const PG8_LAS bf16x8*)(lds + PG8_SB(b, h) + boff + n * 2048 + k * 1024); } while (0)
#define PG8_MMA(ai, bj, At, Bt) do { __builtin_amdgcn_s_setprio(1); _Pragma("unroll") for (int m = 0; m < 4; ++m) _Pragma("unroll") for (int n = 0; n < 2; ++n) _Pragma("unroll") for (int k = 0; k < 2; ++k) \
        acc[ai][bj][m][n] = __builtin_amdgcn_mfma_f32_16x16x32_bf16(Bt[n][k], At[m][k], acc[ai][bj][m][n], 0, 0, 0); __builtin_amdgcn_s_setprio(0); } while (0)
#define PG8_WAIT_V(n) asm volatile("s_waitcnt vmcnt(" #n ")" ::: "memory")
#define PG8_WAIT_L(n) asm volatile("s_waitcnt lgkmcnt(" #n ")" ::: "memory")
#define PG8_BAR __builtin_amdgcn_s_barrier()
#define PG8_SCHED __builtin_amdgcn_sched_barrier(0)
    Unit cur, nxt; int ui = 0;
    if (!S.next(0, cur)) return;
    f32x4 acc[2][2][4][2];
#pragma unroll
    for (int a = 0; a < 2; ++a)
#pragma unroll
        for (int b = 0; b < 2; ++b)
#pragma unroll
            for (int m = 0; m < 4; ++m)
#pragma unroll
                for (int n = 0; n < 2; ++n) acc[a][b][m][n] = (f32x4){0.f, 0.f, 0.f, 0.f};
    bf16x8 At[4][2], B0[2][2], B1[2][2];
    const char* cA = (const char*)g.A + (size_t)cur.pm * tstep; const char* cB = (const char*)g.Bt + (size_t)cur.pn * tstep;
    S.a_ready(cur);
    if constexpr (SP2) {
        PG8_STAGE(PG8_SB(0, 0), cB, voffB); PG8_STAGE(PG8_SB(0, 1), cB + hstep, voffB); PG8_STAGE(PG8_SA(0, 0), cA, voffA); PG8_STAGE(PG8_SA(0, 1), cA + hstep, voffA);
        if (wr == 1) PG8_BAR;
        PG8_WAIT_V(2); PG8_BAR;
        PG8_STAGE(PG8_SB(1, 0), cB + kstep, voffB); PG8_STAGE(PG8_SA(1, 0), cA + kstep, voffA); PG8_STAGE(PG8_SB(1, 1), cB + hstep + kstep, voffB);
        PG8_WAIT_V(6); PG8_BAR;
    } else {
        PG8_STAGE(PG8_SB(0, 0), cB, voffB); PG8_STAGE(PG8_SA(0, 0), cA, voffA); PG8_STAGE(PG8_SB(0, 1), cB + hstep, voffB); PG8_STAGE(PG8_SA(0, 1), cA + hstep, voffA);
        if (wr == 1) PG8_BAR;
        PG8_WAIT_V(4); PG8_BAR;
        PG8_STAGE(PG8_SB(1, 0), cB + kstep, voffB); PG8_STAGE(PG8_SA(1, 0), cA + kstep, voffA); PG8_STAGE(PG8_SB(1, 1), cB + hstep + kstep, voffB);
        PG8_WAIT_V(6); PG8_BAR;
    }
    for (;;) {
        const bool has_next = S.next(ui + 1, nxt);
        const char* nA = has_next ? (const char*)g.A + (size_t)nxt.pm * tstep : cA; const char* nB = has_next ? (const char*)g.Bt + (size_t)nxt.pn * tstep : cB;
        for (int t = 0; t < nt; t += 2) {
            const bool last = (t == nt - 2);
            const char* a1 = cA + (size_t)(t + 1) * kstep;
            const char* a2 = last ? nA : cA + (size_t)(t + 2) * kstep; const char* b2 = last ? nB : cB + (size_t)(t + 2) * kstep;
            const char* a3 = a2 + kstep; const char* b3 = b2 + kstep;
            if (last && has_next) S.a_ready(nxt);
            if constexpr (SP2) {
            PG8_LDB(B0, 0, 0); PG8_LDB(B1, 0, 1); PG8_SCHED; PG8_LDA(At, 0, 0); PG8_STAGE(PG8_SA(1, 1), a1 + hstep, voffA);
            PG8_WAIT_V(8); PG8_WAIT_L(0); PG8_BAR; PG8_MMA(0, 0, At, B0); PG8_MMA(0, 1, At, B1); PG8_BAR; PG8_SCHED;
            PG8_LDA(At, 0, 1); PG8_STAGE(PG8_SB(0, 0), b2, voffB); PG8_STAGE(PG8_SB(0, 1), b2 + hstep, voffB); PG8_STAGE(PG8_SA(0, 0), a2, voffA);
            PG8_WAIT_V(8); PG8_WAIT_L(0); PG8_BAR; PG8_MMA(1, 0, At, B0); PG8_MMA(1, 1, At, B1); PG8_BAR; PG8_SCHED;
            PG8_LDB(B0, 1, 0); PG8_LDB(B1, 1, 1); PG8_SCHED; PG8_LDA(At, 1, 0); PG8_STAGE(PG8_SA(0, 1), a2 + hstep, voffA);
            PG8_WAIT_V(8); PG8_WAIT_L(0); PG8_BAR; PG8_MMA(0, 0, At, B0); PG8_MMA(0, 1, At, B1); PG8_BAR; PG8_SCHED;
            PG8_LDA(At, 1, 1); PG8_STAGE(PG8_SB(1, 0), b3, voffB); PG8_STAGE(PG8_SB(1, 1), b3 + hstep, voffB); PG8_STAGE(PG8_SA(1, 0), a3, voffA);
            PG8_WAIT_V(8); PG8_WAIT_L(0); PG8_BAR; PG8_MMA(1, 0, At, B0); PG8_MMA(1, 1, At, B1); PG8_BAR; PG8_SCHED;
            } else {
            PG8_LDB(B0, 0, 0); PG8_SCHED; PG8_LDA(At, 0, 0); PG8_STAGE(PG8_SA(1, 1), a1 + hstep, voffA);
            PG8_WAIT_L(8); PG8_BAR; PG8_WAIT_L(0); PG8_MMA(0, 0, At, B0); PG8_BAR; PG8_SCHED;
            PG8_LDB(B1, 0, 1); PG8_STAGE(PG8_SB(0, 0), b2, voffB);
            PG8_BAR; PG8_WAIT_L(0); PG8_MMA(0, 1, At, B1); PG8_BAR;
            PG8_LDA(At, 0, 1); PG8_STAGE(PG8_SA(0, 0), a2, voffA);
            PG8_BAR; PG8_WAIT_L(0); PG8_MMA(1, 0, At, B0); PG8_BAR; PG8_SCHED;
            PG8_STAGE(PG8_SB(0, 1), b2 + hstep, voffB);
            PG8_WAIT_V(6); PG8_BAR; PG8_MMA(1, 1, At, B1); PG8_BAR;
            PG8_LDB(B0, 1, 0); PG8_SCHED; PG8_LDA(At, 1, 0); PG8_STAGE(PG8_SA(0, 1), a2 + hstep, voffA);
            PG8_WAIT_L(8); PG8_BAR; PG8_WAIT_L(0); PG8_MMA(0, 0, At, B0); PG8_BAR; PG8_SCHED;
            PG8_LDB(B1, 1, 1); PG8_STAGE(PG8_SB(1, 0), b3, voffB);
            PG8_BAR; PG8_WAIT_L(0); PG8_MMA(0, 1, At, B1); PG8_BAR;
            PG8_LDA(At, 1, 1); PG8_STAGE(PG8_SA(1, 0), a3, voffA);
            PG8_BAR; PG8_WAIT_L(0); PG8_MMA(1, 0, At, B0); PG8_BAR; PG8_SCHED;
            PG8_STAGE(PG8_SB(1, 1), b3 + hstep, voffB);
            PG8_WAIT_V(6); PG8_BAR; PG8_MMA(1, 1, At, B1); PG8_BAR;
            }
        }
        if constexpr (ALIGN_EPI) { if (wr == 0) PG8_BAR; }
        if constexpr (!Epi::AFTER_DRAIN) { E(acc, cur, wr, wc, fr, fq); S.done(cur); }
        if (!has_next) break;
#pragma unroll
        for (int a = 0; a < 2; ++a)
#pragma unroll
            for (int b = 0; b < 2; ++b)
#pragma unroll
                for (int m = 0; m < 4; ++m)
#pragma unroll
                    for (int n = 0; n < 2; ++n) acc[a][b][m][n] = (f32x4){0.f, 0.f, 0.f, 0.f};
        cur = nxt; cA = nA; cB = nB; ++ui;
        if constexpr (ALIGN_EPI) { if (wr == 1) PG8_BAR; }
    }
    PG8_WAIT_V(0);
    if constexpr (!ALIGN_EPI) { if (wr == 0) PG8_BAR; }
    PG8_BAR;
    if constexpr (Epi::AFTER_DRAIN) { E.fused(acc, cur, wr, wc, fr, fq, lds, wid, lane); S.done(cur); }
#undef PG8_SA
#undef PG8_SB
#undef PG8_STAGE
#undef PG8_LDA
#undef PG8_LDB
#undef PG8_MMA
#undef PG8_WAIT_V
#undef PG8_WAIT_L
#undef PG8_BAR
#undef PG8_SCHED
}
}
#define XB_TMO      128
#define XB_XCNT(j)  (256  + 64 * (j))
#define XB_XSUB(j)  (1280 + 64 * (j))
#define XB_XGEN(j)  (2304 + 64 * (j))
#define XB_TOP      3328
#define XB_TOPGEN   3392
#define XCD_BAR_WORDS 3456
#define XB_SPIN_CAP (1u << 18)

__device__ __forceinline__ unsigned xb_ld(unsigned* p)              { return __hip_atomic_load(p, __ATOMIC_RELAXED, __HIP_MEMORY_SCOPE_AGENT); }
__device__ __forceinline__ unsigned xb_add(unsigned* p, unsigned v) { return __hip_atomic_fetch_add(p, v, __ATOMIC_RELAXED, __HIP_MEMORY_SCOPE_AGENT); }
__device__ __forceinline__ unsigned xb_xcc_id() { return (unsigned)__builtin_amdgcn_s_getreg((3 << 11) | 20) & 0xFu; }
#define XB_SPIN(cond, bar) do { unsigned _sp = 0; while (cond) { __builtin_amdgcn_s_sleep(1); \
    if ((++_sp & 255u) == 0u) { if (xb_ld(&(bar)[XB_TMO])) break; if (_sp > XB_SPIN_CAP) { atomicAdd(&(bar)[XB_TMO], 1u); break; } } } } while (0)

struct XcdBarrier {
    unsigned* bar; unsigned x; unsigned w;
    volatile LAS unsigned* st;
};

__device__ __forceinline__ XcdBarrier xcd_barrier_post(unsigned* bar, volatile LAS unsigned* st, unsigned wave) {
    XcdBarrier b; b.bar = bar; b.x = xb_xcc_id(); b.st = st; b.w = wave;
    if (wave == 0u && fresh_lane() == 0) (void)xb_add(&bar[XB_XCNT(b.x)], 1u);
    return b;
}
__device__ __forceinline__ void xcd_barrier_complete(unsigned* bar, unsigned x, unsigned& nloc, unsigned& nx) {
    const unsigned G = gridDim.x * gridDim.y * gridDim.z;
    unsigned sum, cnt, mine, sp = 0u;
    for (;;) {
        sum = 0u; cnt = 0u; mine = 0u;
#pragma unroll
        for (unsigned j = 0; j < 16; ++j) { const unsigned c = xb_ld(&bar[XB_XCNT(j)]); sum += c; cnt += (c > 0u) ? 1u : 0u; mine = (j == x) ? c : mine; }
        if (sum == G) break;
        __builtin_amdgcn_s_sleep(1);
        if ((++sp & 255u) == 0u) { if (xb_ld(&bar[XB_TMO])) break; if (sp > XB_SPIN_CAP) { atomicAdd(&bar[XB_TMO], 1u); break; } }
    }
    nloc = mine > 0u ? mine : 1u; nx = cnt > 0u ? cnt : 1u;
}

__device__ __forceinline__ void xcd_barrier(const XcdBarrier& b) {
    asm volatile("s_waitcnt vmcnt(0)" ::: "memory");
    __syncthreads();
    if (b.w == 0u && fresh_lane() == 0) {
        unsigned* bar = b.bar;
        __builtin_amdgcn_s_waitcnt(0);
        unsigned nloc = b.st[0], nx = b.st[1];
        if (nloc == 0u) { xcd_barrier_complete(bar, b.x, nloc, nx); b.st[0] = nloc; b.st[1] = nx; }
        const unsigned old = xb_add(&bar[XB_XSUB(b.x)], 1u);
        const unsigned gen = old / nloc;
        if (old + 1u == (gen + 1u) * nloc) {
            __builtin_amdgcn_fence(__ATOMIC_RELEASE, "agent");
            asm volatile("s_waitcnt vmcnt(0)" ::: "memory");
            const unsigned og = xb_add(&bar[XB_TOP], 1u);
            const unsigned tg = og / nx;
            if (og + 1u == (tg + 1u) * nx) xb_add(&bar[XB_TOPGEN], 1u);
            else XB_SPIN(xb_ld(&bar[XB_TOPGEN]) == tg, bar);
            __builtin_amdgcn_fence(__ATOMIC_ACQUIRE, "agent");
            xb_add(&bar[XB_XGEN(b.x)], 1u);
            asm volatile("s_waitcnt vmcnt(0)" ::: "memory");
        } else {
            XB_SPIN(xb_ld(&bar[XB_XGEN(b.x)]) == gen, bar);
            __builtin_amdgcn_fence(__ATOMIC_ACQUIRE, "agent");
            asm volatile("s_waitcnt vmcnt(0)" ::: "memory");
        }
    }
    __syncthreads();
}

constexpr int NWAVES = 8, NTHREADS = 512;
constexpr int RING_BYTES = 131072, LDS_BYTES = 163840, LDSCTL_OFF = LDS_BYTES - 1024, MISC_OFF = LDSCTL_OFF + 320;
static_assert(pg8::STAGE_BYTES <= RING_BYTES, "GEMM stage buffers fit the ring");
struct Args { const float* in[25]; float* out; unsigned char* ws; int ph_lo, ph_hi, li, pad; };
enum { I_XP = 0, I_XS, I_CCKV, I_CKROPE, I_SC, I_SN, I_SM, I_C, I_CCTX, I_N1G, I_N2G, I_WADA, I_BADA, I_WIN, I_GATEB, I_MNG, I_QLG, I_KVLG, I_WQ, I_WKV, I_QHG, I_KHG, I_WOUT, I_WUP, I_WDN };

template <int MODE> __device__ __forceinline__ int src_col(int n) {
    if (MODE == 0) return n;
    if (MODE == 2) return (n & 127) < 96 ? (n >> 7) * 96 + (n & 127) : -1;
    if (n < 2048) return n;
    if (n < C_GATE) return n + 16;
    if (n < NIN) return n - 672;
    return -1;
}
template <int MODE>
__device__ __forceinline__ void transpose_item(const float* W, int K, int Nsrc, int Ndst, bf16_t* WT, LAS float* scr, int item, int lane) {
    const int nblk = Ndst / 32, kb = item / nblk, nb = item % nblk, k0 = 64 * kb, n0 = 32 * nb;
    const int sc = src_col<MODE>(n0 + (lane & 31));
#pragma unroll 8
    for (int i = 0; i < 32; ++i) { const int kk = 2 * i + (lane >> 5); scr[kk * 33 + (lane & 31)] = sc >= 0 ? W[(size_t)(k0 + kk) * Nsrc + sc] : 0.f; }
    LDS_WAIT(); asm volatile("" ::: "memory");
    const int c = lane & 7;
#pragma unroll
    for (int j = 0; j < 4; ++j) { const int n = (lane >> 3) + 8 * j; const LAS float* s = scr + (8 * c) * 33 + n;
        u32x4 o; o.x = cvt_pk_bf16(s[0 * 33], s[1 * 33]); o.y = cvt_pk_bf16(s[2 * 33], s[3 * 33]); o.z = cvt_pk_bf16(s[4 * 33], s[5 * 33]); o.w = cvt_pk_bf16(s[6 * 33], s[7 * 33]);
        *(u32x4*)(WT + (size_t)(n0 + n) * K + k0 + 8 * c) = o; }
    LDS_WAIT(); asm volatile("" ::: "memory");
}
template <int MODE>
__device__ __forceinline__ void gemv5_item(const float* c_in, const float* c_ctx, const float* W, const float* b_ada, float* OUT, LAS unsigned char* lds, int item, int tid, int lane, int wave) {
    constexpr int NW_ = MODE == 0 ? 6144 : FF;
    LAS float* s_l = (LAS float*)lds;
    LAS float* red = (LAS float*)(lds + 20480);
    for (int idx = tid; idx < 5120; idx += NTHREADS) { const int c = idx >> 10, k = idx & 1023; if (MODE == 0) { const float v = c == 0 ? c_ctx[k] : c_in[(c - 1) * 1024 + k]; s_l[idx] = v / (1.f + __expf(-v)); } else s_l[idx] = c_in[c * 6144 + 3072 + k]; }
    __syncthreads();
    const int n0 = item * 64, kq = lane >> 4, cq = lane & 15, kbase = wave * 128;
    f32x4 acc[5];
#pragma unroll
    for (int c = 0; c < 5; ++c) acc[c] = (f32x4){0.f, 0.f, 0.f, 0.f};
    const float* wp = W + (size_t)(kbase + kq) * NW_ + n0 + cq * 4;
#pragma unroll 8
    for (int it = 0; it < 32; ++it) { const f32x4 w = *(const f32x4*)(wp + (size_t)it * 4 * NW_); const int k = kbase + it * 4 + kq;
#pragma unroll
        for (int c = 0; c < 5; ++c) acc[c] += s_l[c * 1024 + k] * w; }
#pragma unroll
    for (int c = 0; c < 5; ++c)
#pragma unroll
        for (int e = 0; e < 4; ++e) { float v = acc[c][e]; v += __shfl_xor(v, 16); v += __shfl_xor(v, 32); acc[c][e] = v; }
    if (kq == 0) {
#pragma unroll
        for (int c = 0; c < 5; ++c) *(LAS f32x4*)(red + (wave * 5 + c) * 64 + cq * 4) = acc[c]; }
    __syncthreads();
    if (tid < 320) { const int c = tid >> 6, n = tid & 63; float s = MODE == 0 ? b_ada[n0 + n] : 0.f;
#pragma unroll
        for (int w = 0; w < 8; ++w) s += red[(w * 5 + c) * 64 + n];
        OUT[c * NW_ + n0 + n] = s; }
    __syncthreads();
}
__device__ __forceinline__ void p0_prologue(const Args& a, LAS unsigned char* lds, int tid, int lane, int wave, int G) {
    unsigned char* ws = a.ws;
    const int bx = blockIdx.x;
    if (bx < 96) gemv5_item<0>(a.in[I_C], a.in[I_CCTX], a.in[I_WADA], a.in[I_BADA], (float*)(ws + WS_MOD), lds, bx, tid, lane, wave);
    LAS float* scr = (LAS float*)(lds + wave * 16384);
    const int gw = bx * NWAVES + wave, NGW = G * NWAVES;
    constexpr int I_1 = (DM / 64) * (NINP / 32), I_2 = (QLORA / 64) * (NQP / 32), I_3 = (KVLORA / 64) * (NKV / 32), I_4 = (DM / 64) * (DM / 32), I_5 = (DM / 64) * (FF / 32), I_6 = (FF / 64) * (DM / 32);
    constexpr int NITEMS = I_1 + I_2 + I_3 + I_4 + I_5 + I_6;
    for (int it = gw; it < NITEMS; it += NGW) {
        int r = it;
        if (r < I_1) { transpose_item<1>(a.in[I_WIN], DM, NIN, NINP, (bf16_t*)(ws + WS_WIN), scr, r, lane); continue; } r -= I_1;
        if (r < I_2) { transpose_item<2>(a.in[I_WQ], QLORA, NQ, NQP, (bf16_t*)(ws + WS_WQ), scr, r, lane); continue; } r -= I_2;
        if (r < I_3) { transpose_item<0>(a.in[I_WKV], KVLORA, NKV, NKV, (bf16_t*)(ws + WS_WKV), scr, r, lane); continue; } r -= I_3;
        if (r < I_4) { transpose_item<0>(a.in[I_WOUT], DM, DM, DM, (bf16_t*)(ws + WS_WO), scr, r, lane); continue; } r -= I_4;
        if (r < I_5) { transpose_item<0>(a.in[I_WUP], DM, FF, FF, (bf16_t*)(ws + WS_WUP), scr, r, lane); continue; } r -= I_5;
        transpose_item<0>(a.in[I_WDN], FF, DM, DM, (bf16_t*)(ws + WS_WDN), scr, r, lane);
    }
    float* rope = (float*)(ws + WS_ROPE);
    for (int idx = bx * NTHREADS + tid; idx < TL * 16; idx += G * NTHREADS) { const int t = idx >> 4, j = idx & 15;
        const float pos = (float)(j < 8 ? (t >> 6) : (t & 63)); const float inv = exp2f(-(float)(j & 7) * 0.125f * 13.287712379549449f);
        float rev = pos * inv * 0.15915494309189535f; rev -= floorf(rev);
        rope[t * 32 + j] = __builtin_amdgcn_cosf(rev); rope[t * 32 + 16 + j] = __builtin_amdgcn_sinf(rev); }
}

__device__ __forceinline__ int cond_of_row(int row) { return row < MC ? 0 : 1 + ((row - MC) >> 11); }
__device__ __forceinline__ void norm_rows(const float* xa, const float* xb, const float* g, const float* MOD, int sh_off, int sc_off, bf16_t* out, int gw, int NGW, int lane) {
    for (int rb = gw * 8; rb < M; rb += NGW * 8) {
        const int cond = cond_of_row(rb);
        const f32x4* g4 = (const f32x4*)g + lane; const f32x4* sc4 = (const f32x4*)(MOD + cond * 6144 + sc_off) + lane; const f32x4* sh4 = (const f32x4*)(MOD + cond * 6144 + sh_off) + lane;
        f32x4 gm[4], sv[4];
#pragma unroll
        for (int j = 0; j < 4; ++j) { gm[j] = g4[64 * j] * (sc4[64 * j] + 1.0f); sv[j] = sh4[64 * j]; }
        for (int r = 0; r < 8; r += 2) {
            f32x4 v[2][4];
#pragma unroll
            for (int q = 0; q < 2; ++q) { const int row = rb + r + q; const f32x4* xr = (const f32x4*)(row < MC ? xa + (size_t)row * DM : xb + (size_t)(row - MC) * DM) + lane;
#pragma unroll
                for (int j = 0; j < 4; ++j) v[q][j] = xr[64 * j]; }
#pragma unroll
            for (int q = 0; q < 2; ++q) { const int row = rb + r + q; float s = 0.f;
#pragma unroll
                for (int j = 0; j < 4; ++j) s += (v[q][j].x * v[q][j].x + v[q][j].y * v[q][j].y) + (v[q][j].z * v[q][j].z + v[q][j].w * v[q][j].w);
                const float rstd = 1.0f / sqrtf(wave_sum(s) * (1.0f / DM) + EPS);
                u32x2* o8 = (u32x2*)(out + (size_t)row * DM) + lane;
#pragma unroll
                for (int j = 0; j < 4; ++j) { const f32x4 o = v[q][j] * rstd * gm[j] + sv[j]; u32x2 w; w.x = cvt_pk_bf16(o.x, o.y); w.y = cvt_pk_bf16(o.z, o.w); o8[64 * j] = w; } } }
    }
}
__device__ __forceinline__ void p3_rows(const Args& a, int gw, int NGW, int lane, int gtid, int NGT) {
    unsigned char* ws = a.ws; const bf16_t* PROJ = (const bf16_t*)(ws + WS_PROJ); bf16_t* QN = (bf16_t*)(ws + WS_QN); bf16_t* CKVN = (bf16_t*)(ws + WS_CKVN);
    float qg[8]; f32x4 kg;
    { const int l8 = lane < 48 ? lane * 8 : 0;
#pragma unroll
      for (int e = 0; e < 8; ++e) qg[e] = a.in[I_QLG][l8 + e];
      kg = *(const f32x4*)(a.in[I_KVLG] + lane * 4); }
    for (int rb = gw * 8; rb < M; rb += NGW * 8)
        for (int r4 = 0; r4 < 8; r4 += 4) {
            u32x4 qw[4]; u32x2 kw4[4]; unsigned short krw[4];
#pragma unroll
            for (int q = 0; q < 4; ++q) { const bf16_t* pr = PROJ + (size_t)(rb + r4 + q) * NINP;
                qw[q] = (u32x4){0u, 0u, 0u, 0u}; if (lane < 48) qw[q] = *(const u32x4*)(pr + C_QLAT + lane * 8);
                kw4[q] = *(const u32x2*)(pr + C_KVLAT + lane * 4); krw[q] = pr[C_KROPE + (lane & 31)]; }
#pragma unroll
            for (int q = 0; q < 4; ++q) { const int row = rb + r4 + q;
                float qv[8]; unpack8(qw[q], qv);
                float s = 0.f;
#pragma unroll
                for (int e = 0; e < 8; ++e) s += qv[e] * qv[e];
                const float rq = 1.0f / sqrtf(wave_sum(s) * (1.0f / QLORA) + EPS);
                if (lane < 48) {
#pragma unroll
                    for (int e = 0; e < 8; ++e) qv[e] *= rq * qg[e];
                    *(u32x4*)(QN + (size_t)row * QLORA + lane * 8) = pack8(qv); }
                const u32x2 kw = kw4[q];
                f32x4 kv = (f32x4){bflo(kw.x), bfhi(kw.x), bflo(kw.y), bfhi(kw.y)};
                const float rk = 1.0f / sqrtf(wave_sum((kv.x * kv.x + kv.y * kv.y) + (kv.z * kv.z + kv.w * kv.w)) * (1.0f / KVLORA) + EPS);
                kv = kv * rk * kg;
                u32x2 ow; ow.x = cvt_pk_bf16(kv.x, kv.y); ow.y = cvt_pk_bf16(kv.z, kv.w);
                *(u32x2*)(CKVN + (size_t)row * KVLORA + lane * 4) = ow;
                if (row < MC) { *(f32x4*)(a.out + O_CKV + (size_t)row * KVLORA + lane * 4) = kv;
                    if (lane < 32) a.out[O_KROPE + (size_t)row * 32 + lane] = bf2f(krw[q]); } } }
    for (int i = gtid; i < NBL * 256 * KVLORA / 8; i += NGT) { const float* s = a.in[I_CCKV] + (size_t)i * 8; float f[8];
#pragma unroll
        for (int e = 0; e < 8; ++e) f[e] = s[e];
        *(u32x4*)(CKVN + (size_t)M * KVLORA + (size_t)i * 8) = pack8(f); }
    for (int i = gtid; i < NBL * 256 * 32 / 8; i += NGT) { const float* s = a.in[I_CKROPE] + (size_t)i * 8; float f[8];
#pragma unroll
        for (int e = 0; e < 8; ++e) f[e] = s[e];
        *(u32x4*)((bf16_t*)(ws + WS_KRC) + (size_t)i * 8) = pack8(f); }
}
__device__ __forceinline__ void p5_headnorm(const Args& a, int gw, int NGW, int lane) {
    unsigned char* ws = a.ws; bf16_t* QB = (bf16_t*)(ws + WS_Q); const bf16_t* KVR = (const bf16_t*)(ws + WS_KVRAW); bf16_t* KB = (bf16_t*)(ws + WS_K);
    const bf16_t* PROJ = (const bf16_t*)(ws + WS_PROJ); const float* rope = (const float*)(ws + WS_ROPE);
    const int half = lane >> 5, hh = (lane >> 2) & 7, q4 = lane & 3;
    const bf16_t* KRC = (const bf16_t*)(ws + WS_KRC);
    constexpr int NP5 = (M + MKV) / 2;
    for (int p0 = gw; p0 < NP5; p0 += 2 * NGW) {
        u32x4 raw[2][3];
#pragma unroll
        for (int q = 0; q < 2; ++q) { const int p = p0 + q * NGW; if (p < NP5) {
            const int idx = 2 * p + half; const bool isq = idx < M; const int kr = isq ? idx : idx - M;
            if (isq) { const bf16_t* src = QB + (size_t)kr * NQ + hh * 96 + q4 * 24;
#pragma unroll
                for (int i = 0; i < 3; ++i) raw[q][i] = *(const u32x4*)(src + 8 * i);
            } else {
#pragma unroll
                for (int i = 0; i < 3; ++i) { const int ci = 3 * q4 + i;
                    const bf16_t* src = ci < 8 ? KVR + (size_t)kr * NKV + hh * 128 + 8 * ci : (kr < M ? PROJ + (size_t)kr * NINP + C_KROPE + 8 * (ci - 8) : KRC + (size_t)(kr - M) * 32 + 8 * (ci - 8));
                    raw[q][i] = *(const u32x4*)src; } } } }
#pragma unroll
        for (int q = 0; q < 2; ++q) { const int p = p0 + q * NGW; if (p < NP5) {
            const int idx = 2 * p + half; const bool isq = idx < M; const int kr = isq ? idx : idx - M;
            float v[24];
#pragma unroll
            for (int i = 0; i < 3; ++i) unpack8(raw[q][i], v + 8 * i);
            const float* g = isq ? a.in[I_QHG] : a.in[I_KHG];
            bf16_t* dst = isq ? QB + (size_t)kr * NQ + hh * 96 + q4 * 24 : KB + (size_t)kr * NQ + hh * 96 + q4 * 24;
            const bool dorope = kr >= MC && kr < M;
            float s = 0.f;
#pragma unroll
            for (int i = 0; i < 24; ++i) s += v[i] * v[i];
            s += __shfl_xor(s, 1); s += __shfl_xor(s, 2);
            const float rstd = 1.0f / sqrtf(s * (1.0f / 96.0f) + EPS);
#pragma unroll
            for (int i = 0; i < 24; ++i) v[i] *= rstd * g[q4 * 24 + i];
            float snd[8], rcv[8];
#pragma unroll
            for (int j = 0; j < 8; ++j) { snd[j] = (q4 == 2) ? v[16 + j] : v[8 + j]; rcv[j] = __shfl_xor(snd[j], 1); }
            if (dorope && q4 >= 2) { const float* cs = rope + (size_t)((kr - MC) & (TL - 1)) * 32;
                if (q4 == 2) {
#pragma unroll
                    for (int j = 0; j < 8; ++j) v[16 + j] = v[16 + j] * cs[j] - rcv[j] * cs[16 + j];
                } else {
#pragma unroll
                    for (int j = 0; j < 8; ++j) { const float x1 = v[j], x2 = v[16 + j], c = cs[8 + j], sn = cs[24 + j]; v[j] = x1 * c - x2 * sn; v[16 + j] = x1 * sn + x2 * c;
                        v[8 + j] = rcv[j] * cs[16 + j] + v[8 + j] * cs[j]; }
                } }
#pragma unroll
            for (int i = 0; i < 3; ++i) *(u32x4*)(dst + 8 * i) = pack8(v + 8 * i);
        } }
    }
}
__device__ __forceinline__ void p6b_hm(const Args& a, int gw, int NGW, int lane) {
    unsigned char* ws = a.ws; const bf16_t* HF = (const bf16_t*)a.out; const bf16_t* HB = HF + (size_t)M * 512; const bf16_t* PROJ = (const bf16_t*)(ws + WS_PROJ); bf16_t* A2 = (bf16_t*)(ws + WS_H);
    float mg[8];
#pragma unroll
    for (int e = 0; e < 8; ++e) mg[e] = a.in[I_MNG][lane * 8 + e];
    for (int row0 = gw; row0 < M; row0 += 2 * NGW) {
        u32x4 rf[2], rb_[2], ro[2];
#pragma unroll
        for (int q = 0; q < 2; ++q) { const int row = row0 + q * NGW; if (row < M) {
            rf[q] = *(const u32x4*)(HF + (size_t)row * 512 + lane * 8); rb_[q] = *(const u32x4*)(HB + (size_t)row * 512 + lane * 8);
            ro[q] = *(const u32x4*)(PROJ + (size_t)row * NINP + C_MO + lane * 8); } }
#pragma unroll
        for (int q = 0; q < 2; ++q) { const int row = row0 + q * NGW; if (row < M) {
            float f[8], b[8], o[8]; unpack8(rf[q], f); unpack8(rb_[q], b); unpack8(ro[q], o);
            float s = 0.f;
#pragma unroll
            for (int e = 0; e < 8; ++e) { f[e] += b[e]; s += f[e] * f[e]; }
            s += __shfl_xor(s, 1); s += __shfl_xor(s, 2); s += __shfl_xor(s, 4); s += __shfl_xor(s, 8);
            const float rstd = 1.0f / sqrtf(s * (1.0f / 128.0f) + EPS);
#pragma unroll
            for (int e = 0; e < 8; ++e) f[e] = f[e] * rstd * mg[e] / (1.0f + __expf(-o[e]));
            *(u32x4*)(A2 + (size_t)row * DM + lane * 8) = pack8(f); } }
    }
}

namespace att {
constexpr int QBLK = 32, KVBLK = 64;
constexpr float SCALE = 0.10206207261596577f;
constexpr float THR = 8.f;
constexpr int SHM_V = 64 * 128 * 2, SHM_K = 64 * 256;
constexpr int LDS_ATT = 2 * SHM_V + 2 * SHM_K + 8 * 64 * 4;
#define KSWZ(row, colB) ((row) * 256 + ((colB) ^ (((row) & 7) << 4)))
__device__ __forceinline__ int crow(int r, int hi) { return (r & 3) + 8 * (r >> 2) + 4 * hi; }
__device__ __forceinline__ void partialSM(f32x16& p0, f32x16& p1, float& m_reg, float& mn, float& alpha) {
  constexpr float C = SCALE * 1.4426950408889634f;
  float pmax = p0[0];
#pragma unroll
  for (int r = 1; r < 16; ++r) pmax = fmaxf(pmax, p0[r]);
#pragma unroll
  for (int r = 0; r < 16; ++r) pmax = fmaxf(pmax, p1[r]);
  { auto rr = __builtin_amdgcn_permlane32_swap(__float_as_uint(pmax), __float_as_uint(pmax), false, false);
    pmax = fmaxf(__uint_as_float(rr[0]), __uint_as_float(rr[1])); }
  if (__builtin_expect(__all(pmax - m_reg <= THR / SCALE), 1)) { mn = m_reg; alpha = 1.f; }
  else { mn = fmaxf(m_reg, pmax); alpha = __builtin_amdgcn_exp2f((m_reg - mn) * C); m_reg = mn; }
  float mnC = -mn * C;
#pragma unroll
  for (int r = 0; r < 16; ++r) p0[r] = fmaf(p0[r], C, mnC);
#pragma unroll
  for (int r = 0; r < 16; ++r) p1[r] = fmaf(p1[r], C, mnC);
#pragma unroll
  for (int r = 0; r < 16; ++r) p0[r] = __builtin_amdgcn_exp2f(p0[r]);
}
__device__ __forceinline__ void finishSM(f32x16& p0, f32x16& p1, float alpha, float& l_reg, bf16x8& pa0, bf16x8& pa1, bf16x8& pa2, bf16x8& pa3) {
#pragma unroll
  for (int r = 0; r < 16; ++r) p1[r] = __builtin_amdgcn_exp2f(p1[r]);
  float ps = 0;
#pragma unroll
  for (int r = 0; r < 16; ++r) ps += p0[r];
#pragma unroll
  for (int r = 0; r < 16; ++r) ps += p1[r];
  { auto rr = __builtin_amdgcn_permlane32_swap(__float_as_uint(ps), __float_as_uint(ps), false, false);
    ps = __uint_as_float(rr[0]) + __uint_as_float(rr[1]); }
  l_reg = l_reg * alpha + ps;
#define PK4(P, BASE, OUT) do { unsigned a0 = cvt_pk_bf16(P[BASE + 0], P[BASE + 1]), a1 = cvt_pk_bf16(P[BASE + 2], P[BASE + 3]);   \
    unsigned b0 = cvt_pk_bf16(P[BASE + 4], P[BASE + 5]), b1 = cvt_pk_bf16(P[BASE + 6], P[BASE + 7]);                              \
    auto r0 = __builtin_amdgcn_permlane32_swap(a0, b0, false, false); auto r1 = __builtin_amdgcn_permlane32_swap(a1, b1, false, false); \
    u32x4 w = {r0[0], r1[0], r0[1], r1[1]}; OUT = *reinterpret_cast<bf16x8*>(&w); } while (0)
  PK4(p0, 0, pa0); PK4(p0, 8, pa1); PK4(p1, 0, pa2); PK4(p1, 8, pa3);
#undef PK4
}
__device__ __forceinline__ void qkt(f32x16& p0, f32x16& p1, const char* Ks, const bf16x8* qr, int r32, int hi) {
  p0 = f32x16{}; p1 = f32x16{};
#pragma unroll
  for (int d0 = 0; d0 < 6; ++d0) { int cb = (d0 * 16 + hi * 8) * 2;
    bf16x8 b0 = *reinterpret_cast<const bf16x8*>(Ks + KSWZ(r32, cb));
    bf16x8 b1 = *reinterpret_cast<const bf16x8*>(Ks + KSWZ(32 + r32, cb));
    p0 = __builtin_amdgcn_mfma_f32_32x32x16_bf16(b0, qr[d0], p0, 0, 0, 0);
    p1 = __builtin_amdgcn_mfma_f32_32x32x16_bf16(b1, qr[d0], p1, 0, 0, 0); }
}
__device__ __forceinline__ int v_st(int k, int c) { const int kk = (k & ~0xC) | ((k & 4) << 1) | ((k & 8) >> 1); return ((kk >> 3) * 4 + (c >> 5)) * 512 + ((kk & 7) * 32 + (c & 31)) * 2; }
__device__ __forceinline__ int v_rd_base(int lane) { return ((lane & 3) << 3) | (((lane >> 2) & 3) << 6) | (((lane >> 4) & 1) << 5) | (((lane >> 5) & 1) << 8); }
constexpr int v_rd_off(int d0, int ks, int half) { return d0 * 512 + ks * 4096 + half * 2048; }
template <int OFF> __device__ __forceinline__ s16x4 tr_read(int vb) {
  s16x4 r; asm volatile("ds_read_b64_tr_b16 %0, %1 offset:%2" : "=&v"(r) : "v"(vb), "i"(OFF) : "memory"); return r;
}
template <int D0> __device__ __forceinline__ void pv_one(f32x16& od, int vb, bf16x8 pa0, bf16x8 pa1, bf16x8 pa2, bf16x8 pa3) {
  const s16x4 l0 = tr_read<v_rd_off(D0, 0, 0)>(vb), h0 = tr_read<v_rd_off(D0, 0, 1)>(vb), l1 = tr_read<v_rd_off(D0, 1, 0)>(vb), h1 = tr_read<v_rd_off(D0, 1, 1)>(vb);
  const s16x4 l2 = tr_read<v_rd_off(D0, 2, 0)>(vb), h2 = tr_read<v_rd_off(D0, 2, 1)>(vb), l3 = tr_read<v_rd_off(D0, 3, 0)>(vb), h3 = tr_read<v_rd_off(D0, 3, 1)>(vb);
  asm volatile("s_waitcnt lgkmcnt(0)" ::: "memory"); SBAR();
  od = __builtin_amdgcn_mfma_f32_32x32x16_bf16(pa0, MK8(l0, h0), od, 0, 0, 0);
  od = __builtin_amdgcn_mfma_f32_32x32x16_bf16(pa1, MK8(l1, h1), od, 0, 0, 0);
  od = __builtin_amdgcn_mfma_f32_32x32x16_bf16(pa2, MK8(l2, h2), od, 0, 0, 0);
  od = __builtin_amdgcn_mfma_f32_32x32x16_bf16(pa3, MK8(l3, h3), od, 0, 0, 0);
}
__device__ __forceinline__ void pv_d0(f32x16* o, int vb, bf16x8 pa0, bf16x8 pa1, bf16x8 pa2, bf16x8 pa3) {
  pv_one<0>(o[0], vb, pa0, pa1, pa2, pa3); pv_one<1>(o[1], vb, pa0, pa1, pa2, pa3);
}
__device__ __forceinline__ void attn_unit(const bf16_t* __restrict__ Qg, const bf16_t* __restrict__ Kg, const bf16_t* __restrict__ Vg, bf16_t* __restrict__ Og,
                                          int qrow0, int h, int rowA, int ntA, int rowB, int NT, char* lds, const int wid) {
  const int lane = fresh_lane(), tid = wid * 64 + lane, r32 = lane & 31, hi = lane >> 5;
  char* V_lds = lds; char* K_lds = lds + 2 * SHM_V;
  float* ws = (float*)(lds + 2 * SHM_V + 2 * SHM_K) + wid * 64; float* li_l = ws; float* al_l = ws + 32;
  float m_reg = -1e30f, l_reg = 0; f32x16 o[2] = {}; bf16x8 qr[6];
  const bf16_t* Qw = Qg + (size_t)(qrow0 + wid * QBLK + r32) * NQ + h * 96 + hi * 8;
#pragma unroll
  for (int d0 = 0; d0 < 6; ++d0) qr[d0] = *reinterpret_cast<const bf16x8*>(Qw + d0 * 16);
  const int sr = tid >> 4, sc = (tid & 15) * 8, vst0 = v_st(sr, sc), vst1 = v_st(32 + sr, sc);
  const int vb0 = (int)(uintptr_t)V_lds + v_rd_base(lane);
  const bf16_t* Kh = Kg + h * 96 + sc; const bf16_t* Vh = Vg + h * 128 + 64 + sc;
  struct { bf16x8 vs0, vs1, ks0, ks1; } sr_[2];
#define TROW(j) ((j) < ntA ? rowA + (j) * KVBLK : rowB + ((j) - ntA) * KVBLK)
#define SLOAD(i, j) do { const size_t r0_ = (size_t)(TROW(j) + sr); \
    sr_[i].vs0 = *reinterpret_cast<const bf16x8*>(Vh + r0_ * NKV); sr_[i].vs1 = *reinterpret_cast<const bf16x8*>(Vh + (r0_ + 32) * NKV); \
    sr_[i].ks0 = *reinterpret_cast<const bf16x8*>(Kh + r0_ * NQ); sr_[i].ks1 = *reinterpret_cast<const bf16x8*>(Kh + (r0_ + 32) * NQ); } while (0)
#define SWRITE(b, i) do { *(bf16x8*)(V_lds + (b) * SHM_V + vst0) = sr_[i].vs0;          \
    *(bf16x8*)(V_lds + (b) * SHM_V + vst1) = sr_[i].vs1; int kc = sc * 2;               \
    *(bf16x8*)(K_lds + (b) * SHM_K + KSWZ(sr, kc)) = sr_[i].ks0;                       \
    *(bf16x8*)(K_lds + (b) * SHM_K + KSWZ(32 + sr, kc)) = sr_[i].ks1; } while (0)
#define SWAIT() asm volatile("s_waitcnt vmcnt(4)" ::: "memory")
#define RESC(a) do { if (__any((a) < 1.f)) { if (hi == 0) al_l[r32] = (a); asm volatile("s_waitcnt lgkmcnt(0)" ::: "memory"); \
    _Pragma("unroll") for (int d = 0; d < 2; ++d) _Pragma("unroll") for (int r = 0; r < 16; ++r) o[d][r] *= al_l[crow(r, hi)]; } } while (0)
  f32x16 pA0, pA1, pB0, pB1; float mnA, mnB, alA, alB; bf16x8 pa0, pa1, pa2, pa3;
  constexpr int SE = 0, SO = 1;
  SLOAD(SE, 0); asm volatile("s_waitcnt vmcnt(0)" ::: "memory"); SWRITE(0, SE); __syncthreads();
  qkt(pA0, pA1, K_lds, qr, r32, hi); partialSM(pA0, pA1, m_reg, mnA, alA);
  SLOAD(SO, 1); if (2 < NT) SLOAD(SE, 2);
  SWAIT(); SWRITE(1, SO); __syncthreads();
  for (int j = 1; j + 1 < NT; j += 2) {
    SBAR(); qkt(pB0, pB1, K_lds + SHM_K, qr, r32, hi);
    finishSM(pA0, pA1, alA, l_reg, pa0, pa1, pa2, pa3); SBAR();
    SLOAD(SO, j + 2); SBAR();
    pv_d0(o, vb0, pa0, pa1, pa2, pa3); partialSM(pB0, pB1, m_reg, mnB, alB);
    __syncthreads(); SWAIT(); SWRITE(0, SE);
    RESC(alB); __syncthreads();
    SBAR(); qkt(pA0, pA1, K_lds, qr, r32, hi);
    finishSM(pB0, pB1, alB, l_reg, pa0, pa1, pa2, pa3); SBAR();
    if (j + 3 < NT) SLOAD(SE, j + 3); SBAR();
    pv_d0(o, vb0 + SHM_V, pa0, pa1, pa2, pa3); partialSM(pA0, pA1, m_reg, mnA, alA);
    __syncthreads(); SWAIT(); SWRITE(1, SO);
    RESC(alA); __syncthreads();
  }
  SBAR(); qkt(pB0, pB1, K_lds + SHM_K, qr, r32, hi);
  finishSM(pA0, pA1, alA, l_reg, pa0, pa1, pa2, pa3); SBAR();
  pv_d0(o, vb0, pa0, pa1, pa2, pa3); partialSM(pB0, pB1, m_reg, mnB, alB);
  __syncthreads(); RESC(alB);
  finishSM(pB0, pB1, alB, l_reg, pa0, pa1, pa2, pa3); SBAR();
  pv_d0(o, vb0 + SHM_V, pa0, pa1, pa2, pa3);
  if (hi == 0) li_l[r32] = l_reg; asm volatile("s_waitcnt lgkmcnt(0)" ::: "memory");
  float rli[16];
#pragma unroll
  for (int r = 0; r < 16; ++r) rli[r] = __builtin_amdgcn_rcpf(li_l[crow(r, hi)]);
  bf16_t* Ow = Og + (size_t)(qrow0 + wid * QBLK) * DM + 512 + h * 64;
#pragma unroll
  for (int r = 0; r < 16; ++r) { const int orow = crow(r, hi);
#pragma unroll
    for (int d0 = 0; d0 < 2; ++d0) Ow[(size_t)orow * DM + d0 * 32 + r32] = (bf16_t)(cvt_pk_bf16(o[d0][r] * rli[r], 0.f) & 0xffffu); }
  __syncthreads();
#undef TROW
#undef SLOAD
#undef SWRITE
#undef SWAIT
#undef RESC
}
}

namespace ml {
constexpr int PQ = 272, PP = 144;
constexpr int OFF_Q = 0, OFF_K = 17408, OFF_V = 34816, OFF_W = 52224  , OFF_P = 69632, OFF_CB = 78848, OFF_N = 113664, OFF_QN = 114176, OFF_DP = 114432, OFF_NP = 114944,
              OFF_AA = 116992  , OFF_AC = 125184  , OFF_AB = 133376  , OFF_MC = 141568  , LDS_ML = 141824;
__device__ __forceinline__ f32x4 mfma16(bf16x8 a, bf16x8 b, f32x4 c) { return __builtin_amdgcn_mfma_f32_16x16x32_bf16(a, b, c, 0, 0, 0); }
__device__ __forceinline__ u32x2 pack4(f32x4 v) { u32x2 w; w.x = cvt_pk_bf16(v.x, v.y); w.y = cvt_pk_bf16(v.z, v.w); return w; }

__device__ __forceinline__ void mlstm_seq(const Args& a, LAS unsigned char* lds, int kind, int b, int h, int dir, const int wave) {
    const int lane = fresh_lane(), tid = wave * 64 + lane, g = lane >> 4, i = lane & 15;
    const int T = kind ? TL : TC, nc = T / 64, rowbase = kind ? MC + b * TL : b * TC;
    const bf16_t* PROJ = (const bf16_t*)(a.ws + WS_PROJ); const float* gates = (const float*)(a.ws + WS_GATES);
    bf16_t* Hout = (bf16_t*)a.out + (dir ? (size_t)M * 512 : 0);
#define ROWP(p) (rowbase + (dir ? T - 1 - (p) : (p)))
    LAS float* const sa = (LAS float*)(lds + OFF_AA); LAS float* const sA = (LAS float*)(lds + OFF_AC); LAS float* const sbb = (LAS float*)(lds + OFF_AB); LAS float* const smc = (LAS float*)(lds + OFF_MC);
    const int s0 = tid >> 4, c8 = tid & 15;
    u32x4 pq[2], pk[2], pv[2];
#define LOADCH(c) do { _Pragma("unroll") for (int e = 0; e < 2; ++e) { const bf16_t* rp = PROJ + (size_t)ROWP(64 * (c) + s0 + 32 * e) * NINP + h * 128 + c8 * 8; \
        pq[e] = *(const u32x4*)(rp + C_MQ); pk[e] = *(const u32x4*)(rp + C_MK); pv[e] = *(const u32x4*)(rp + C_MV); } } while (0)
    LOADCH(0);
    { const float gb_i = a.in[I_GATEB][dir * 8 + h], gb_f = a.in[I_GATEB][dir * 8 + 4 + h];
      for (int c = wave; c < nc; c += 8) { const float* gp = gates + (size_t)ROWP(64 * c + lane) * 16 + dir * 8 + h;
        const float gi = gp[0] + gb_i, gf = gp[4] + gb_f;
        const float lf = fminf(gf, 0.f) - log1pf(__expf(-fabsf(gf))); float bs = lf;
#pragma unroll
        for (int o = 1; o < 64; o <<= 1) { const float t = __shfl_up(bs, o); if (lane >= o) bs += t; }
        const float av = gi - bs; float A = av;
#pragma unroll
        for (int o = 1; o < 64; o <<= 1) { const float t = __shfl_up(A, o); if (lane >= o) A = fmaxf(A, t); }
        sa[64 * c + lane] = av; sA[64 * c + lane] = A; sbb[64 * c + lane] = bs; } }
    const int v0 = wave * 16;
    f32x4 accC[8];
    const size_t sidx = (size_t)((b * 2 + dir) * 4 + h);
    LAS float* nl = (LAS float*)(lds + OFF_N);
    if (kind) { const float* C0 = a.in[I_SC] + sidx * 16384;
#pragma unroll
        for (int kb = 0; kb < 8; ++kb) accC[kb] = *(const f32x4*)(C0 + (size_t)(16 * kb + i) * 128 + v0 + 4 * g);
        if (tid < 128) nl[tid] = a.in[I_SN][sidx * 128 + tid];
    } else {
#pragma unroll
        for (int kb = 0; kb < 8; ++kb) accC[kb] = (f32x4){0.f, 0.f, 0.f, 0.f};
        if (tid < 128) nl[tid] = 0.f;
    }
#pragma unroll
    for (int kb = 0; kb < 8; ++kb) *(LAS u32x2*)(lds + OFF_CB + (16 * kb + i) * PQ + (v0 + 4 * g) * 2) = pack4(accC[kb]);
    __syncthreads();
    f32x4 accN = (f32x4){0.f, 0.f, 0.f, 0.f}; if (g == 0) accN[0] = nl[16 * wave + i];
    if (wave == 0) { const int cc = lane < nc ? lane : 0; const float b63 = sbb[64 * cc + 63], A63 = sA[64 * cc + 63]; float m = kind ? a.in[I_SM][sidx] : 0.f;
        for (int c = 0; c < nc; ++c) { if (lane == c) smc[c] = m; m = __shfl(b63, c) + fmaxf(m, __shfl(A63, c)); }
        if (lane == 0) smc[nc] = m; }
    __syncthreads();
    for (int c = 0; c < nc; ++c) {
        const float m_c = smc[c]; const float M63 = fmaxf(m_c, sA[64 * c + 63]); const float decay = __expf(m_c - M63);
#pragma unroll
        for (int e = 0; e < 2; ++e) { const int off = (s0 + 32 * e) * PQ + c8 * 16;
            *(LAS u32x4*)(lds + OFF_Q + off) = pq[e]; *(LAS u32x4*)(lds + OFF_K + off) = pk[e]; *(LAS u32x4*)(lds + OFF_V + off) = pv[e]; }
        if (tid < 64) ((LAS float*)(lds + OFF_W))[tid] = __expf(sa[64 * c + tid] - M63);
        __syncthreads();
        if (c + 1 < nc) LOADCH(c + 1);
        {
            const int tb = wave >> 1, t = 16 * tb + i; const float Mt = fmaxf(m_c, sA[64 * c + t]); float rs = 0.f;
            bf16x8 qf[4], kf0[4], kf1[4];
#pragma unroll
            for (int kk = 0; kk < 4; ++kk) { qf[kk] = *(const LAS bf16x8*)(lds + OFF_Q + t * PQ + (32 * kk + 8 * g) * 2);
                kf0[kk] = *(const LAS bf16x8*)(lds + OFF_K + (32 * (wave & 1) + i) * PQ + (32 * kk + 8 * g) * 2);
                kf1[kk] = *(const LAS bf16x8*)(lds + OFF_K + (32 * (wave & 1) + 16 + i) * PQ + (32 * kk + 8 * g) * 2); }
            const int tq = tid >> 3, part = tid & 7; float qn_q[16];
            unpack8(*(const LAS u32x4*)(lds + OFF_Q + tq * PQ + part * 32), qn_q); unpack8(*(const LAS u32x4*)(lds + OFF_Q + tq * PQ + part * 32 + 16), qn_q + 8);
            f32x4 acc0 = (f32x4){0.f, 0.f, 0.f, 0.f}, acc1 = (f32x4){0.f, 0.f, 0.f, 0.f};
#pragma unroll
            for (int kk = 0; kk < 4; ++kk) { acc0 = mfma16(kf0[kk], qf[kk], acc0); acc1 = mfma16(kf1[kk], qf[kk], acc1); }
            float d = 0.f;
#pragma unroll
            for (int x = 0; x < 16; ++x) d += qn_q[x] * nl[part * 16 + x];
            d += __shfl_xor(d, 1); d += __shfl_xor(d, 2); d += __shfl_xor(d, 4);
            if (part == 0) ((LAS float*)(lds + OFF_QN))[tq] = d;
#pragma unroll
            for (int u = 0; u < 2; ++u) { const int sblk = 2 * (wave & 1) + u; const f32x4 acc = u ? acc1 : acc0; f32x4 p;
#pragma unroll
                for (int r = 0; r < 4; ++r) { const int s = 16 * sblk + 4 * g + r; const float wv = __expf(sa[64 * c + s] - Mt); p[r] = (s <= t) ? acc[r] * wv : 0.f; rs += p[r]; }
                *(LAS u32x2*)(lds + OFF_P + t * PP + (16 * sblk + 4 * g) * 2) = pack4(p); }
            rs += __shfl_xor(rs, 16); rs += __shfl_xor(rs, 32);
            if (g == 0) ((LAS float*)(lds + OFF_DP))[(wave & 1) * 64 + t] = rs;
        }
        __syncthreads();
        {
            const LAS unsigned char* vtr = lds + OFF_V + (8 * g + (i >> 2)) * PQ + (v0 + 4 * (i & 3)) * 2;
            const LAS unsigned char* ctr = lds + OFF_CB + (8 * g + (i >> 2)) * PQ + (v0 + 4 * (i & 3)) * 2;
            bf16x8 vfr[2], pf[2][4], cf[4];
            f32x4 w8[2][2];
#pragma unroll
            for (int kk = 0; kk < 2; ++kk) { const s16x4 lo = tr16(vtr + 32 * kk * PQ), hi_ = tr16(vtr + (32 * kk + 4) * PQ); vfr[kk] = MK8(lo, hi_);
                w8[kk][0] = *(const LAS f32x4*)(lds + OFF_W + (32 * kk + 8 * g) * 4); w8[kk][1] = *(const LAS f32x4*)(lds + OFF_W + (32 * kk + 8 * g + 4) * 4);
#pragma unroll
                for (int tb = 0; tb < 4; ++tb) pf[kk][tb] = *(const LAS bf16x8*)(lds + OFF_P + (16 * tb + i) * PP + (32 * kk + 8 * g) * 2); }
#pragma unroll
            for (int kk = 0; kk < 4; ++kk) { const s16x4 lo = tr16(ctr + 32 * kk * PQ), hi_ = tr16(ctr + (32 * kk + 4) * PQ); cf[kk] = MK8(lo, hi_); }
            f32x4 intra[4], inter[4];
#pragma unroll
            for (int tb = 0; tb < 4; ++tb) { intra[tb] = (f32x4){0.f, 0.f, 0.f, 0.f}; inter[tb] = (f32x4){0.f, 0.f, 0.f, 0.f}; }
#pragma unroll
            for (int kk = 0; kk < 2; ++kk)
#pragma unroll
                for (int tb = 0; tb < 4; ++tb) intra[tb] = mfma16(vfr[kk], pf[kk][tb], intra[tb]);
#pragma unroll
            for (int kk = 0; kk < 4; ++kk) { bf16x8 qf[4];
#pragma unroll
                for (int tb = 0; tb < 4; ++tb) qf[tb] = *(const LAS bf16x8*)(lds + OFF_Q + (16 * tb + i) * PQ + (32 * kk + 8 * g) * 2);
#pragma unroll
                for (int tb = 0; tb < 4; ++tb) inter[tb] = mfma16(cf[kk], qf[tb], inter[tb]); }
            bf16x8 vfw[2], onw[2];
#pragma unroll
            for (int kk = 0; kk < 2; ++kk) { float vf[8]; unpack8(__builtin_bit_cast(u32x4, vfr[kk]), vf); float wv[8];
#pragma unroll
                for (int x = 0; x < 4; ++x) { wv[x] = w8[kk][0][x]; wv[4 + x] = w8[kk][1][x]; }
#pragma unroll
                for (int x = 0; x < 8; ++x) vf[x] *= wv[x];
                vfw[kk] = __builtin_bit_cast(bf16x8, pack8(vf));
                u32x4 ow = pack8(wv); if (i != 0) ow = (u32x4){0u, 0u, 0u, 0u}; onw[kk] = __builtin_bit_cast(bf16x8, ow); }
#pragma unroll
            for (int kb = 0; kb < 8; ++kb) { accC[kb] = accC[kb] * decay; bf16x8 kfr[2];
#pragma unroll
                for (int kk = 0; kk < 2; ++kk) { const LAS unsigned char* kp = lds + OFF_K + (32 * kk + 8 * g + (i >> 2)) * PQ + (16 * kb + 4 * (i & 3)) * 2;
                    const s16x4 lo = tr16(kp), hi_ = tr16(kp + 4 * PQ); kfr[kk] = MK8(lo, hi_); }
                accC[kb] = mfma16(vfw[0], kfr[0], accC[kb]); accC[kb] = mfma16(vfw[1], kfr[1], accC[kb]);
                if (kb == wave) { accN = accN * decay; accN = mfma16(onw[0], kfr[0], accN); accN = mfma16(onw[1], kfr[1], accN); } }
            const LAS float* dp = (const LAS float*)(lds + OFF_DP); const LAS float* qn = (const LAS float*)(lds + OFF_QN);
#pragma unroll
            for (int tb = 0; tb < 4; ++tb) { const int t = 16 * tb + i; const float Mt = fmaxf(m_c, sA[64 * c + t]); const float wi = __expf(m_c - Mt);
                const float den = dp[t] + dp[64 + t] + wi * qn[t]; const float inv = 1.0f / fmaxf(fabsf(den), __expf(-(sbb[64 * c + t] + Mt)));
                const f32x4 hv = (intra[tb] + inter[tb] * wi) * inv;
                *(u32x2*)(Hout + (size_t)ROWP(64 * c + t) * 512 + h * 128 + v0 + 4 * g) = pack4(hv); }
        }
        __syncthreads();
#pragma unroll
        for (int kb = 0; kb < 8; ++kb) *(LAS u32x2*)(lds + OFF_CB + (16 * kb + i) * PQ + (v0 + 4 * g) * 2) = pack4(accC[kb]);
        if (g == 0) nl[16 * wave + i] = accN[0];
    }
    if (kind == 0) {
        float* oC = a.out + O_C + sidx * 16384;
#pragma unroll
        for (int kb = 0; kb < 8; ++kb) *(f32x4*)(oC + (size_t)(16 * kb + i) * 128 + v0 + 4 * g) = accC[kb];
        if (g == 0) a.out[O_N + sidx * 128 + 16 * wave + i] = accN[0];
        if (tid == 0) a.out[O_M + sidx] = smc[nc];
    }
    __syncthreads();
#undef ROWP
#undef LOADCH
}
}

constexpr int NPH = 10;
#ifndef LAUNCH_LIST
#define LAUNCH_LIST {0, 10}
#endif
constexpr int Q_NITEMS = 800;

__global__ void __launch_bounds__(NTHREADS, 2) fwd_megakernel(Args args) {
    extern __shared__ __attribute__((aligned(16))) unsigned char lds_raw[];
    LAS unsigned char* lds = (LAS unsigned char*)lds_raw;
    volatile LAS unsigned* MISC = (volatile LAS unsigned*)(lds + MISC_OFF);
    const int wave = __builtin_amdgcn_readfirstlane(threadIdx.x >> 6);
#define tid (wave * 64 + lane)
    const int G = gridDim.x, bx = blockIdx.x;
    unsigned char* ws = args.ws;
    unsigned* ctl = (unsigned*)(ws + WS_CTL);
    { const int lane = fresh_lane();
    for (int u = tid; u < (LDS_BYTES - LDSCTL_OFF) / 4; u += NTHREADS) ((LAS unsigned*)(lds + LDSCTL_OFF))[u] = 0u; }
    __syncthreads();
    XcdBarrier bar = xcd_barrier_post(ctl + CW_BAR + args.li * XCD_BAR_WORDS, MISC + 8, (unsigned)wave);
    const int lo = args.ph_lo, hi = args.ph_hi;
#define IN(k) (lo <= (k) && (k) < hi)
#define SEAM(k) do { if (IN(k) && IN((k) + 1)) xcd_barrier(bar); } while (0)
    const int gw = bx * NWAVES + wave, NGW = G * NWAVES;
    bf16_t* const HBUF = (bf16_t*)(ws + WS_H);
    float* const MOD = (float*)(ws + WS_MOD);
    float* const X1 = (float*)(ws + WS_X1);

    if (IN(0)) { const int lane = fresh_lane(); p0_prologue(args, lds, tid, lane, wave, G); SEAM(0); }
    if (IN(1)) { const int lane = fresh_lane(); norm_rows(args.in[I_XP], args.in[I_XS], args.in[I_N1G], MOD, 0, 1024, HBUF, gw, NGW, lane); SEAM(1); }
    if (IN(2)) {
        pg8::Gemm g{HBUF, (const bf16_t*)(ws + WS_WIN), M, NINP, DM}; pg8::StaticOrder S; S.init(M, NINP, G, bx);
        pg8::EpiProj E{(bf16_t*)(ws + WS_PROJ), (float*)(ws + WS_GATES)};
        pg8::gemm_phase<pg8::EpiProj, pg8::StaticOrder, true, true>(lds, g, S, E, wave);
        for (int it = (G == 256) ? (bx >= 192 ? bx - 192 : 64) : bx; it < 64; it += G) { const int lane = fresh_lane(); gemv5_item<1>(MOD, nullptr, args.in[I_WUP], nullptr, (float*)(ws + WS_BIAS2), lds, it, tid, lane, wave); }
        SEAM(2);
    }
    if (IN(3)) { const int lane = fresh_lane(); p3_rows(args, gw, NGW, lane, bx * NTHREADS + tid, G * NTHREADS); SEAM(3); }
    if (IN(4)) {
        pg8::PG8_LAS_float_ptr Xl = (pg8::PG8_LAS_float_ptr)(lds + RING_BYTES);
        int kq = QLORA, kkv = KVLORA; asm volatile("" : "+s"(kq), "+s"(kkv));
        { pg8::Gemm g{(const bf16_t*)(ws + WS_QN), (const bf16_t*)(ws + WS_WQ), M, NQP, kq}; pg8::StaticOrder S; S.init(M, NQP, G, bx);
          pg8::EpiHead<0> E{(bf16_t*)(ws + WS_Q), nullptr, args.in[I_QHG], nullptr, nullptr, Xl};
          pg8::gemm_phase<pg8::EpiHead<0>, pg8::StaticOrder, true, true>(lds, g, S, E, wave); }
        { pg8::Gemm g{(const bf16_t*)(ws + WS_CKVN), (const bf16_t*)(ws + WS_WKV), MKV, NKV, kkv}; pg8::StaticOrder S; S.init(MKV, NKV, G, G == 256 ? ((bx + 64) & 255) : bx);
          pg8::EpiHead<1> E{(bf16_t*)(ws + WS_K), (bf16_t*)(ws + WS_KVRAW), args.in[I_KHG], (const bf16_t*)(ws + WS_PROJ), (const bf16_t*)(ws + WS_KRC), Xl};
          pg8::gemm_phase<pg8::EpiHead<1>, pg8::StaticOrder, true, true>(lds, g, S, E, wave); }
        SEAM(4);
    }
    if (IN(5)) {
        volatile LAS int* qslot = (volatile LAS int*)(lds + MISC_OFF + 64);
        for (;;) {
            __syncthreads();
            if (wave == 0 && fresh_lane() == 0) *qslot = (int)__hip_atomic_fetch_add(ctl + CW_QUEUE + 64 * args.li, 1u, __ATOMIC_RELAXED, __HIP_MEMORY_SCOPE_AGENT);
            __syncthreads();
            const int idx = __builtin_amdgcn_readfirstlane(*qslot);
            if (idx >= Q_NITEMS) break;
#ifdef PROBE_QLO
            if (args.li == 1 && (idx < PROBE_QLO || idx >= PROBE_QHI)) continue;
#endif
            if (idx < 32) ml::mlstm_seq(args, lds, 1, idx >> 3, (idx >> 1) & 3, idx & 1, wave);
            else if (idx < 288) { const int j = idx - 32, b = j >> 6, h = (j >> 3) & 7, qb = j & 7;
                att::attn_unit((const bf16_t*)(ws + WS_Q), (const bf16_t*)(ws + WS_K), (const bf16_t*)(ws + WS_KVRAW), HBUF, MC + b * TL + qb * 256, h, MC + b * TL, 32, M + b * 256, 36, (char*)lds_raw, wave); }
            else if (idx < 544) { const int j = idx - 288; ml::mlstm_seq(args, lds, 0, j >> 3, (j >> 1) & 3, j & 1, wave); }
            else { const int j = idx - 544, b = j >> 3, h = j & 7;
                att::attn_unit((const bf16_t*)(ws + WS_Q), (const bf16_t*)(ws + WS_K), (const bf16_t*)(ws + WS_KVRAW), HBUF, b * TC, h, b * TC, 4, 0, 4, (char*)lds_raw, wave); }
        }
        SEAM(5);
    }
    if (IN(6)) { const int lane = fresh_lane(); p6b_hm(args, gw, NGW, lane); SEAM(6); }
    if (IN(7)) {
        pg8::Gemm g{HBUF, (const bf16_t*)(ws + WS_WO), M, DM, DM}; pg8::StaticOrder S; S.init(M, DM, G, bx);
        pg8::EpiMix E{args.in[I_XP], args.in[I_XS], X1, (bf16_t*)(ws + WS_XG), MOD, args.in[I_N2G], (float*)(ctl + CW_ROWSQ)};
        pg8::gemm_phase<pg8::EpiMix, pg8::StaticOrder, true, true>(lds, g, S, E, wave);
        SEAM(7);
    }
    if (IN(8)) {
        pg8::Gemm g{(const bf16_t*)(ws + WS_XG), (const bf16_t*)(ws + WS_WUP), M, FF, DM}; pg8::StaticOrder S; S.init(M, FF, G, bx);
        pg8::EpiUp E{(bf16_t*)(ws + WS_U), (const float*)(ctl + CW_ROWSQ), (const float*)(ws + WS_BIAS2)};
        pg8::gemm_phase<pg8::EpiUp, pg8::StaticOrder, true, true>(lds, g, S, E, wave);
        SEAM(8);
    }
    if (IN(9)) {
        pg8::Gemm g{(const bf16_t*)(ws + WS_U), (const bf16_t*)(ws + WS_WDN), M, DM, FF}; pg8::StaticOrder S; S.init(M, DM, G, bx);
        pg8::EpiResGate E{X1, X1 + (size_t)MC * DM, args.out, MOD, 5120};
        pg8::gemm_phase<pg8::EpiResGate, pg8::StaticOrder, true, true>(lds, g, S, E, wave);
    }
static_assert(ml::LDS_ML <= LDSCTL_OFF && att::LDS_ATT <= LDSCTL_OFF, "phase scratch below the LDS control words");
#undef IN
#undef SEAM
#undef tid
}

extern "C" void kernel_launch(void* const* d_in, const int* in_sizes, int n_in, void* d_out, int out_size, void* d_ws, size_t ws_size, hipStream_t stream) {
    static int grid = 0;
    if (grid == 0) {
        if (n_in != 25 || in_sizes[0] != MC * DM || in_sizes[1] != ML * DM || out_size != (int)O_END || ws_size < WS_END) {
            fprintf(stderr, "kernel_launch: unexpected shapes: n_in %d in0 %d in1 %d out %d ws %zu (need >= %zu); nothing launched\n", n_in, n_in > 0 ? in_sizes[0] : -1, n_in > 1 ? in_sizes[1] : -1, out_size, ws_size, (size_t)WS_END); grid = -1; return; }
        int dev = 0, cus = 0, per_cu = 0;
        if (hipGetDevice(&dev) != hipSuccess || hipDeviceGetAttribute(&cus, hipDeviceAttributeMultiprocessorCount, dev) != hipSuccess) { fprintf(stderr, "kernel_launch: device query failed\n"); grid = -1; return; }
        if (hipFuncSetAttribute((const void*)fwd_megakernel, hipFuncAttributeMaxDynamicSharedMemorySize, LDS_BYTES) != hipSuccess) { fprintf(stderr, "kernel_launch: hipFuncSetAttribute failed\n"); grid = -1; return; }
        if (hipOccupancyMaxActiveBlocksPerMultiprocessor(&per_cu, (const void*)fwd_megakernel, NTHREADS, LDS_BYTES) != hipSuccess || per_cu < 1) {
            fprintf(stderr, "kernel_launch: occupancy query reports %d workgroups per CU; nothing launched\n", per_cu); (void)hipGetLastError(); grid = -1; return; }
        grid = cus;
    }
    if (grid < 0) return;
    if (hipMemsetAsync((char*)d_ws + WS_CTL, 0, CTL_ZERO_BYTES, stream) != hipSuccess) { fprintf(stderr, "kernel_launch: memset failed\n"); return; }
    Args a{};
    for (int i = 0; i < 25; ++i) a.in[i] = (const float*)d_in[i];
    a.out = (float*)d_out; a.ws = (unsigned char*)d_ws;
    static const int plist[] = LAUNCH_LIST;
    for (int li = 0; li < (int)(sizeof(plist) / sizeof(int)) / 2; ++li) {
        a.ph_lo = plist[2 * li]; a.ph_hi = plist[2 * li + 1]; a.li = li;
        hipLaunchKernelGGL(fwd_megakernel, dim3(grid), dim3(NTHREADS), LDS_BYTES, stream, a);
        const hipError_t le = hipPeekAtLastError();
        if (le != hipSuccess) { fprintf(stderr, "kernel_launch: launch %d failed: %s\n", li, hipGetErrorName(le)); break; }
    }
}
```

```cpp
#include <hip/hip_runtime.h>
#include <hip/hip_bf16.h>
#include <cstdio>
#include <cstdint>


#define LAS __attribute__((address_space(3)))
#define GAS __attribute__((address_space(1)))
typedef unsigned short bf16_t;
typedef short bf16x8 __attribute__((ext_vector_type(8)));
typedef short s16x4 __attribute__((ext_vector_type(4)));
typedef float f32x4 __attribute__((ext_vector_type(4)));
typedef float f32x2 __attribute__((ext_vector_type(2)));
typedef float f32x16 __attribute__((ext_vector_type(16)));
typedef unsigned u32x4 __attribute__((ext_vector_type(4)));
typedef unsigned u32x2 __attribute__((ext_vector_type(2)));

constexpr int DM = 1024, MC = 8192, ML = 8192, M = 16384, TC = 256, TL = 2048, NBC = 32, NBL = 4;
constexpr int NIN = 2736, NINP = 2816;
constexpr int C_MQ = 0, C_MK = 512, C_MV = 1024, C_MO = 1536, C_QLAT = 2048, C_KVLAT = 2432, C_KROPE = 2688, C_GATE = 2720;
constexpr int QLORA = 384, KVLORA = 256, NQ = 768, NQP = 1024  , NKV = 1024, FF = 4096;
constexpr int MKV = M + NBL * 256;
constexpr float EPS = 1e-6f;

constexpr size_t O_Y = 0, O_Z = 8388608, O_CKV = 16777216, O_KROPE = 18874368, O_C = 19136512, O_N = 23330816, O_M = 23363584, O_END = 23363840;

constexpr size_t MiB = 1u << 20;
constexpr size_t WS_CTL = 0, CTL_ZERO_BYTES = 1 * MiB;
constexpr size_t WS_MOD = 1 * MiB, WS_ROPE = 1 * MiB + 131072;
constexpr size_t WS_WIN = 2 * MiB, WS_WQ = 8 * MiB, WS_WKV = 9 * MiB, WS_WO = 10 * MiB, WS_WUP = 12 * MiB, WS_WDN = 20 * MiB, WS_GATES = 28 * MiB, WS_KRC = 29 * MiB;
constexpr size_t WS_H = 32 * MiB;
constexpr size_t WS_QN = 32 * MiB, WS_CKVN = 44 * MiB;
constexpr size_t WS_PROJ = 64 * MiB, WS_Q = 152 * MiB, WS_KVRAW = 176 * MiB, WS_K = 210 * MiB;
constexpr size_t WS_X1 = 192 * MiB, WS_END = 256 * MiB;
constexpr size_t WS_U = 32 * MiB;
constexpr size_t WS_XG = 160 * MiB;
constexpr size_t WS_BIAS2 = 30 * MiB;
constexpr int CW_TMO = 0, CW_QUEUE = 64, CW_BAR = 4096, CW_ROWSQ = 131072;

__device__ __forceinline__ unsigned cvt_pk_bf16(float lo, float hi) { unsigned r; asm volatile("v_cvt_pk_bf16_f32 %0, %1, %2" : "=v"(r) : "v"(lo), "v"(hi)); return r; }
__device__ __forceinline__ float bf2f(unsigned short x) { return __uint_as_float(((unsigned)x) << 16); }
__device__ __forceinline__ float bflo(unsigned w) { return __uint_as_float(w << 16); }
__device__ __forceinline__ float bfhi(unsigned w) { return __uint_as_float(w & 0xffff0000u); }
__device__ __forceinline__ void unpack8(u32x4 w, float* f) { f[0] = bflo(w.x); f[1] = bfhi(w.x); f[2] = bflo(w.y); f[3] = bfhi(w.y); f[4] = bflo(w.z); f[5] = bfhi(w.z); f[6] = bflo(w.w); f[7] = bfhi(w.w); }
__device__ __forceinline__ u32x4 pack8(const float* f) { u32x4 w; w.x = cvt_pk_bf16(f[0], f[1]); w.y = cvt_pk_bf16(f[2], f[3]); w.z = cvt_pk_bf16(f[4], f[5]); w.w = cvt_pk_bf16(f[6], f[7]); return w; }
__device__ __forceinline__ float wave_sum(float v) {
#pragma unroll
    for (int o = 1; o < 64; o <<= 1) v += __shfl_xor(v, o);
    return v;
}
__device__ __forceinline__ int fresh_lane() { int l; asm volatile("v_mbcnt_lo_u32_b32 %0, -1, 0\n\tv_mbcnt_hi_u32_b32 %0, -1, %0" : "=v"(l)); return l; }
#define LDS_WAIT() asm volatile("s_waitcnt lgkmcnt(0)" ::: "memory")
#define VM_WAIT() asm volatile("s_waitcnt vmcnt(0)" ::: "memory")
#define SBAR() __builtin_amdgcn_sched_barrier(0)
typedef short v4i16_t __attribute__((ext_vector_type(4)));
__device__ __forceinline__ s16x4 tr16(const LAS unsigned char* p) { return __builtin_bit_cast(s16x4, __builtin_amdgcn_ds_read_tr16_b64_v4i16((LAS v4i16_t*)p)); }
#define MK8(L, H) (bf16x8){L[0], L[1], L[2], L[3], H[0], H[1], H[2], H[3]}

namespace pg8 {
#define PG8_LAS __attribute__((address_space(3)))
typedef PG8_LAS float* PG8_LAS_float_ptr;
constexpr int BM = 256, BK = 64, HALF = 128, HTB = HALF * BK * 2  , STAGE_BYTES = 8 * HTB, NXCD = 8, WGM = 8;

__host__ __device__ __forceinline__ int lds_byte(int r, int c) { const int st = (r >> 4) * 2 + (c >> 5), rr = r & 15, cc = c & 31, ob = rr * 64 + cc * 2; return st * 1024 + (ob ^ (((ob >> 9) & 1) << 5)); }
__host__ __device__ __forceinline__ void stage_rc(int b, int& R, int& C) { const int st = b / 1024, sb = b % 1024, swz = sb ^ (((sb >> 9) & 1) << 5); R = (st >> 1) * 16 + swz / 64; C = (st & 1) * 32 + (swz % 64) / 2; }
__host__ __device__ __forceinline__ int perm32(int rho) { const int n = rho >> 4, i = rho & 15; return 8 * (i >> 2) + 4 * n + (i & 3); }

struct Unit { int pm, pn; };
struct Gemm { const bf16_t* A; const bf16_t* Bt; int M, N, K; };

struct StaticOrder {
    int nM, nN, nwg, G, c;
    __host__ __device__ void init(int M, int N, int G_, int c_) { nM = M / BM; nN = N / BM; nwg = nM * nN; G = G_; c = c_; }
    __host__ __device__ bool next(int i, Unit& u) const {
        const long L = (long)i * G + c; if (L >= nwg) return false;
        int wgid = (int)L; { const int q = nwg / NXCD, r = nwg % NXCD, xcd = wgid % NXCD, off = wgid / NXCD; wgid = (xcd < r ? xcd * (q + 1) : r * (q + 1) + (xcd - r) * q) + off; }
        const int nig = WGM * nN, gid = wgid / nig, fm = gid * WGM, gsz = (nM - fm) < WGM ? (nM - fm) : WGM;
        u.pm = fm + ((wgid % nig) % gsz); u.pn = (wgid % nig) / gsz; return true;
    }
    __device__ __forceinline__ void a_ready(const Unit&) const {}
    __device__ __forceinline__ void done(const Unit&) const {}
};


template <int ACT> struct EpiBf16 {
    static constexpr bool PERM = true, AFTER_DRAIN = false;
    bf16_t* O; int ldc;
    __device__ __forceinline__ void operator()(const f32x4 (&acc)[2][2][4][2], const Unit& u, int wr, int wc, int fr, int fq) const {
        const int row0 = u.pm * BM + wr * 64 + fr, col0 = u.pn * BM + wc * 32 + 8 * fq;
#pragma unroll
        for (int ai = 0; ai < 2; ++ai)
#pragma unroll
            for (int m = 0; m < 4; ++m) { bf16_t* rowp = O + (size_t)(row0 + ai * HALF + m * 16) * ldc + col0;
#pragma unroll
                for (int bj = 0; bj < 2; ++bj) { f32x4 v0 = acc[ai][bj][m][0], v1 = acc[ai][bj][m][1];
                    if (ACT == 2) {
#pragma unroll
                        for (int e = 0; e < 4; ++e) { const float a = fmaxf(v0[e], 0.f), b = fmaxf(v1[e], 0.f); v0[e] = a * a; v1[e] = b * b; } }
                    u32x4 w; w.x = cvt_pk_bf16(v0[0], v0[1]); w.y = cvt_pk_bf16(v0[2], v0[3]); w.z = cvt_pk_bf16(v1[0], v1[1]); w.w = cvt_pk_bf16(v1[2], v1[3]);
                    *(u32x4*)(rowp + bj * HALF) = w; } }
    }
};
struct EpiProj {
    static constexpr bool PERM = true, AFTER_DRAIN = false;
    bf16_t* O; float* gates;
    __device__ __forceinline__ void operator()(const f32x4 (&acc)[2][2][4][2], const Unit& u, int wr, int wc, int fr, int fq) const {
        const int row0 = u.pm * BM + wr * 64 + fr, col0 = u.pn * BM + wc * 32 + 8 * fq;
        const float ksc = (u.pn == 2 || u.pn == 3) ? 0.08838834764831845f : 1.0f;
#pragma unroll
        for (int ai = 0; ai < 2; ++ai)
#pragma unroll
            for (int m = 0; m < 4; ++m) { const int row = row0 + ai * HALF + m * 16; bf16_t* rowp = O + (size_t)row * NINP + col0;
#pragma unroll
                for (int bj = 0; bj < 2; ++bj) { const f32x4 v0 = acc[ai][bj][m][0] * ksc, v1 = acc[ai][bj][m][1] * ksc; const int c = col0 + bj * HALF;
                    if (c >= C_GATE && c < C_GATE + 16) { float* gp = gates + (size_t)row * 16 + (c - C_GATE); *(f32x4*)gp = v0; *(f32x4*)(gp + 4) = v1; }
                    u32x4 w; w.x = cvt_pk_bf16(v0[0], v0[1]); w.y = cvt_pk_bf16(v0[2], v0[3]); w.z = cvt_pk_bf16(v1[0], v1[1]); w.w = cvt_pk_bf16(v1[2], v1[3]);
                    *(u32x4*)(rowp + bj * HALF) = w; } }
    }
};
__device__ __forceinline__ float sum_x16_x32(float v) {
    auto a = __builtin_amdgcn_permlane16_swap(__float_as_uint(v), __float_as_uint(v), false, false); v = __uint_as_float(a[0]) + __uint_as_float(a[1]);
    auto b = __builtin_amdgcn_permlane32_swap(__float_as_uint(v), __float_as_uint(v), false, false); return __uint_as_float(b[0]) + __uint_as_float(b[1]);
}
__device__ __forceinline__ float partner_x32(float v, bool upper) {
    auto b = __builtin_amdgcn_permlane32_swap(__float_as_uint(v), __float_as_uint(v), false, false); return __uint_as_float(upper ? b[0] : b[1]);
}
template <int IS_KV> struct EpiHead {
    static constexpr bool PERM = true, AFTER_DRAIN = false;
    bf16_t* O; bf16_t* V; const float* gain; const bf16_t* proj; const bf16_t* krc; PG8_LAS float* X;
    __device__ __forceinline__ void operator()(const f32x4 (&acc)[2][2][4][2], const Unit& u, int wr, int wc, int fr, int fq) const {
        { const int l_ = fresh_lane(); fr = l_ & 15; fq = l_ >> 4; }
        const bool lat = u.pm >= MC / BM && u.pm < M / BM;
        PG8_LAS float* Xr = X + 2048;
        const int c8 = 32 * wc + 8 * fq;
        u32x4 krw[2][4];
        if (IS_KV && wc == 2) {
#pragma unroll
            for (int ai = 0; ai < 2; ++ai)
#pragma unroll
                for (int m = 0; m < 4; ++m) { const int row = u.pm * BM + ai * HALF + wr * 64 + m * 16 + fr;
                    krw[ai][m] = *(const u32x4*)(row < M ? proj + (size_t)row * NINP + C_KROPE + 8 * fq : krc + (size_t)(row - M) * 32 + 8 * fq); } }
#pragma unroll
        for (int ai = 0; ai < 2; ++ai)
#pragma unroll
            for (int m = 0; m < 4; ++m) { const int rl = ai * HALF + wr * 64 + m * 16 + fr;
#pragma unroll
                for (int bj = 0; bj < 2; ++bj) { const f32x4 v0 = acc[ai][bj][m][0], v1 = acc[ai][bj][m][1];
                    float ss = ((v0.x * v0.x + v0.y * v0.y) + (v0.z * v0.z + v0.w * v0.w)) + ((v1.x * v1.x + v1.y * v1.y) + (v1.z * v1.z + v1.w * v1.w));
                    ss = sum_x16_x32(ss);
                    if (fq == 0) X[(rl * 2 + bj) * 4 + wc] = ss; }
                if (IS_KV && wc == 2) { float kr[8]; unpack8(krw[ai][m], kr); float ss = 0.f;
#pragma unroll
                    for (int e = 0; e < 8; ++e) ss += kr[e] * kr[e];
                    ss = sum_x16_x32(ss);
                    if (fq == 0) Xr[rl] = ss; } }
        asm volatile("s_waitcnt lgkmcnt(0)" ::: "memory"); __builtin_amdgcn_s_barrier(); asm volatile("" ::: "memory");
        f32x4 g0 = (f32x4){0.f, 0.f, 0.f, 0.f}, g1 = g0;
        if (IS_KV ? wc <= 2 : wc < 3) { g0 = *(const f32x4*)(gain + c8); g1 = *(const f32x4*)(gain + c8 + 4); }
#pragma unroll
        for (int ai = 0; ai < 2; ++ai)
#pragma unroll
            for (int m = 0; m < 4; ++m) { const int rl = ai * HALF + wr * 64 + m * 16 + fr, row = u.pm * BM + rl;
                float cq[8], sq[8];
                if (wc == 2 && lat) { const int tpos = (row - MC) & (TL - 1); const float pos = (float)((fq & 1) ? (tpos & 63) : (tpos >> 6));
                    constexpr float RINV[8] = {0.15915494309189535f, 0.050329212104487035f, 0.015915494309189534f, 0.0050329212104487035f, 0.0015915494309189534f, 0.00050329212104487035f, 0.00015915494309189535f, 0.000050329212104487035f};
#pragma unroll
                    for (int e = 0; e < 8; ++e) { const float rev = __builtin_amdgcn_fractf(pos * RINV[e]); cq[e] = __builtin_amdgcn_cosf(rev); sq[e] = __builtin_amdgcn_sinf(rev); } }
#pragma unroll
                for (int bj = 0; bj < 2; ++bj) { const int hd = 2 * u.pn + bj;
                    const f32x4 xp = *(const PG8_LAS f32x4*)(X + (rl * 2 + bj) * 4);
                    const float tot = IS_KV ? (xp.x + xp.y) + Xr[rl] : (xp.x + xp.y) + (xp.z + xp.w);
                    const float rstd = __builtin_amdgcn_rsqf(tot * (1.0f / 96.0f) + EPS);
                    if (IS_KV && wc >= 2) {
                        const f32x4 v0 = acc[ai][bj][m][0], v1 = acc[ai][bj][m][1];
                        u32x4 w; w.x = cvt_pk_bf16(v0[0], v0[1]); w.y = cvt_pk_bf16(v0[2], v0[3]); w.z = cvt_pk_bf16(v1[0], v1[1]); w.w = cvt_pk_bf16(v1[2], v1[3]);
                        *(u32x4*)(V + (size_t)row * NKV + hd * 128 + 64 + (c8 - 64)) = w; }
                    if (IS_KV ? wc <= 2 : wc < 3) {
                        float v[8];
                        if (IS_KV && wc == 2) unpack8(krw[ai][m], v);
                        else {
#pragma unroll
                            for (int e = 0; e < 4; ++e) { v[e] = acc[ai][bj][m][0][e]; v[4 + e] = acc[ai][bj][m][1][e]; } }
#pragma unroll
                        for (int e = 0; e < 4; ++e) { v[e] *= rstd * g0[e]; v[4 + e] *= rstd * g1[e]; }
                        if (wc == 2) {
#pragma unroll
                            for (int e = 0; e < 8; ++e) { const float p = partner_x32(v[e], fq >= 2);
                                if (lat) v[e] = fq < 2 ? v[e] * cq[e] - p * sq[e] : p * sq[e] + v[e] * cq[e]; } }
                        u32x4 w; w.x = cvt_pk_bf16(v[0], v[1]); w.y = cvt_pk_bf16(v[2], v[3]); w.z = cvt_pk_bf16(v[4], v[5]); w.w = cvt_pk_bf16(v[6], v[7]);
                        *(u32x4*)(O + (size_t)row * NQ + hd * 96 + c8) = w; } } }
        asm volatile("s_waitcnt lgkmcnt(0)" ::: "memory"); __builtin_amdgcn_s_barrier(); asm volatile("" ::: "memory");
    }
};
struct EpiUp {
    static constexpr bool PERM = true, AFTER_DRAIN = false;
    bf16_t* O; const float* rowsq; const float* bias;
    __device__ __forceinline__ void operator()(const f32x4 (&acc)[2][2][4][2], const Unit& u, int wr, int wc, int fr, int fq) const {
        const int row0 = u.pm * BM + wr * 64 + fr, col0 = u.pn * BM + wc * 32 + 8 * fq;
        const int cond = u.pm < (MC / BM) ? 0 : 1 + (u.pm - MC / BM) / (TL / BM);
        const float* bp = bias + cond * FF + col0;
        f32x4 bv[2][2];
#pragma unroll
        for (int bj = 0; bj < 2; ++bj) { bv[bj][0] = *(const f32x4*)(bp + bj * HALF); bv[bj][1] = *(const f32x4*)(bp + bj * HALF + 4); }
#pragma unroll
        for (int ai = 0; ai < 2; ++ai)
#pragma unroll
            for (int m = 0; m < 4; ++m) { const int row = row0 + ai * HALF + m * 16; bf16_t* rowp = O + (size_t)row * FF + col0;
                const float rstd = 1.0f / sqrtf(__hip_atomic_load(rowsq + row, __ATOMIC_RELAXED, __HIP_MEMORY_SCOPE_AGENT) * (1.0f / DM) + EPS);
#pragma unroll
                for (int bj = 0; bj < 2; ++bj) { f32x4 v0 = acc[ai][bj][m][0] * rstd + bv[bj][0], v1 = acc[ai][bj][m][1] * rstd + bv[bj][1];
#pragma unroll
                    for (int e = 0; e < 4; ++e) { const float a = fmaxf(v0[e], 0.f), b = fmaxf(v1[e], 0.f); v0[e] = a * a; v1[e] = b * b; }
                    u32x4 w; w.x = cvt_pk_bf16(v0[0], v0[1]); w.y = cvt_pk_bf16(v0[2], v0[3]); w.z = cvt_pk_bf16(v1[0], v1[1]); w.w = cvt_pk_bf16(v1[2], v1[3]);
                    *(u32x4*)(rowp + bj * HALF) = w; } }
    }
};
struct EpiMix {
    static constexpr bool PERM = false, AFTER_DRAIN = false;
    const float* xa; const float* xb; float* x1; bf16_t* xg; const float* mod; const float* n2g; float* rowsq;
    __device__ __forceinline__ void operator()(const f32x4 (&acc)[2][2][4][2], const Unit& u, int wr, int wc, int fr, int fq) const {
        const int col0 = u.pn * BM + wc * 32 + 4 * fq;
        const int cond = u.pm < (MC / BM) ? 0 : 1 + (u.pm - MC / BM) / (TL / BM);
        const float* g = mod + cond * 6144 + 2048 + col0; const float* sc = mod + cond * 6144 + 4096 + col0; const float* ng = n2g + col0;
        f32x4 gv[2][2], gm[2][2];
#pragma unroll
        for (int bj = 0; bj < 2; ++bj)
#pragma unroll
            for (int n = 0; n < 2; ++n) { gv[bj][n] = *(const f32x4*)(g + bj * HALF + n * 16); gm[bj][n] = *(const f32x4*)(ng + bj * HALF + n * 16) * (*(const f32x4*)(sc + bj * HALF + n * 16) + 1.0f); }
#pragma unroll
        for (int ai = 0; ai < 2; ++ai)
#pragma unroll
            for (int m = 0; m < 4; ++m) { const int row = u.pm * BM + ai * HALF + wr * 64 + m * 16 + fr;
                const float* xr = (row < MC ? xa + (size_t)row * DM : xb + (size_t)(row - MC) * DM) + col0; float* orow = x1 + (size_t)row * DM + col0; bf16_t* grow = xg + (size_t)row * DM + col0;
                float ss = 0.f;
#pragma unroll
                for (int bj = 0; bj < 2; ++bj)
#pragma unroll
                    for (int n = 0; n < 2; ++n) { const f32x4 xv = *(const f32x4*)(xr + bj * HALF + n * 16); const f32x4 o = xv + gv[bj][n] * acc[ai][bj][m][n];
                        *(f32x4*)(orow + bj * HALF + n * 16) = o; ss += (o.x * o.x + o.y * o.y) + (o.z * o.z + o.w * o.w);
                        const f32x4 og = o * gm[bj][n]; u32x2 w; w.x = cvt_pk_bf16(og.x, og.y); w.y = cvt_pk_bf16(og.z, og.w); *(u32x2*)(grow + bj * HALF + n * 16) = w; }
                ss += __shfl_xor(ss, 16); ss += __shfl_xor(ss, 32);
                if (fq == 0) __hip_atomic_fetch_add(rowsq + row, ss, __ATOMIC_RELAXED, __HIP_MEMORY_SCOPE_AGENT); }
    }
};
struct EpiResGate {
    static constexpr bool PERM = false, AFTER_DRAIN = false;
    const float* xa; const float* xb; float* out; const float* mod; int goff;
    __device__ __forceinline__ void operator()(const f32x4 (&acc)[2][2][4][2], const Unit& u, int wr, int wc, int fr, int fq) const {
        const int col0 = u.pn * BM + wc * 32 + 4 * fq;
        const int cond = u.pm < (MC / BM) ? 0 : 1 + (u.pm - MC / BM) / (TL / BM);
        const float* g = mod + cond * 6144 + goff + col0;
        f32x4 gv[2][2];
#pragma unroll
        for (int bj = 0; bj < 2; ++bj)
#pragma unroll
            for (int n = 0; n < 2; ++n) gv[bj][n] = *(const f32x4*)(g + bj * HALF + n * 16);
#pragma unroll
        for (int ai = 0; ai < 2; ++ai)
#pragma unroll
            for (int m = 0; m < 4; ++m) { const int row = u.pm * BM + ai * HALF + wr * 64 + m * 16 + fr;
                const float* xr = (row < MC ? xa + (size_t)row * DM : xb + (size_t)(row - MC) * DM) + col0; float* orow = out + (size_t)row * DM + col0;
#pragma unroll
                for (int bj = 0; bj < 2; ++bj)
#pragma unroll
                    for (int n = 0; n < 2; ++n) { const f32x4 xv = *(const f32x4*)(xr + bj * HALF + n * 16); *(f32x4*)(orow + bj * HALF + n * 16) = xv + gv[bj][n] * acc[ai][bj][m][n]; } }
    }
};

template <class Epi, class Sched, bool ALIGN_EPI = false, bool SP2 = false>
__device__ __forceinline__ void gemm_phase(PG8_LAS unsigned char* lds, const Gemm g, const Sched& S, const Epi& E, const int wid  ) {
    const int lane = fresh_lane(), tid = wid * 64 + lane;
    const int wr = wid >> 2, wc = wid & 3, fr = lane & 15, fq = lane >> 4;
    const int K = g.K, nt = K / BK;
    unsigned voffA[2], voffB[2];
#pragma unroll
    for (int i = 0; i < 2; ++i) { int R, C; stage_rc(tid * 16 + i * 8192, R, C); const int Rb = Epi::PERM ? ((R & ~31) + perm32(R & 31)) : R;
        voffA[i] = (unsigned)(R * K + C) * 2u; voffB[i] = (unsigned)(Rb * K + C) * 2u; }
    const size_t kstep = (size_t)(BK * 2);
    const size_t hstep = (size_t)HALF * K * 2;
    const size_t tstep = 2 * hstep;
    const unsigned ldsw = (unsigned)wid * 1024u;
    const int aoff = lds_byte(wr * 64 + fr, fq * 8), boff = lds_byte(wc * 32 + fr, fq * 8);
#define PG8_SA(b, h) (((b) * 2 + (h)) * HTB)
#define PG8_SB(b, h) ((4 + (b) * 2 + (h)) * HTB)
#define PG8_STAGE(bufoff, gbase, voff) do { _Pragma("unroll") for (int _i = 0; _i < 2; ++_i) \
        __builtin_amdgcn_global_load_lds((const unsigned*)((const char*)(gbase) + (voff)[_i]), (PG8_LAS unsigned*)(lds + (bufoff) + ldsw + _i * 8192), 16, 0, 0); } while (0)
#define PG8_LDA(dst, b, h) do { _Pragma("unroll") for (int m = 0; m < 4; ++m) _Pragma("unroll") for (int k = 0; k < 2; ++k) dst[m][k] = *(const PG8_LAS bf16x8*)(lds + PG8_SA(b, h) + aoff + m * 2048 + k * 1024); } while (0)
#define PG8_LDB(dst, b, h) do { _Pragma("unroll") for (int n = 0; n < 2; ++n) _Pragma("unroll") for (int k = 0; k < 2; ++k) dst[n][k] = *(const PG8_LAS bf16x8*)(lds + PG8_SB(b, h) + boff + n * 2048 + k * 1024); } while (0)
#define PG8_MMA(ai, bj, At, Bt) do { __builtin_amdgcn_s_setprio(1); _Pragma("unroll") for (int m = 0; m < 4; ++m) _Pragma("unroll") for (int n = 0; n < 2; ++n) _Pragma("unroll") for (int k = 0; k < 2; ++k) \
        acc[ai][bj][m][n] = __builtin_amdgcn_mfma_f32_16x16x32_bf16(Bt[n][k], At[m][k], acc[ai][bj][m][n], 0, 0, 0); __builtin_amdgcn_s_setprio(0); } while (0)
#define PG8_WAIT_V(n) asm volatile("s_waitcnt vmcnt(" #n ")" ::: "memory")
#define PG8_WAIT_L(n) asm volatile("s_waitcnt lgkmcnt(" #n ")" ::: "memory")
#define PG8_BAR __builtin_amdgcn_s_barrier()
#define PG8_SCHED __builtin_amdgcn_sched_barrier(0)
    Unit cur, nxt; int ui = 0;
    if (!S.next(0, cur)) return;
    f32x4 acc[2][2][4][2];
#pragma unroll
    for (int a = 0; a < 2; ++a)
#pragma unroll
        for (int b = 0; b < 2; ++b)
#pragma unroll
            for (int m = 0; m < 4; ++m)
#pragma unroll
                for (int n = 0; n < 2; ++n) acc[a][b][m][n] = (f32x4){0.f, 0.f, 0.f, 0.f};
    bf16x8 At[4][2], B0[2][2], B1[2][2];
    const char* cA = (const char*)g.A + (size_t)cur.pm * tstep; const char* cB = (const char*)g.Bt + (size_t)cur.pn * tstep;
    S.a_ready(cur);
    if constexpr (SP2) {
        PG8_STAGE(PG8_SB(0, 0), cB, voffB); PG8_STAGE(PG8_SB(0, 1), cB + hstep, voffB); PG8_STAGE(PG8_SA(0, 0), cA, voffA); PG8_STAGE(PG8_SA(0, 1), cA + hstep, voffA);
        if (wr == 1) PG8_BAR;
        PG8_WAIT_V(2); PG8_BAR;
        PG8_STAGE(PG8_SB(1, 0), cB + kstep, voffB); PG8_STAGE(PG8_SA(1, 0), cA + kstep, voffA); PG8_STAGE(PG8_SB(1, 1), cB + hstep + kstep, voffB);
        PG8_WAIT_V(6); PG8_BAR;
    } else {
        PG8_STAGE(PG8_SB(0, 0), cB, voffB); PG8_STAGE(PG8_SA(0, 0), cA, voffA); PG8_STAGE(PG8_SB(0, 1), cB + hstep, voffB); PG8_STAGE(PG8_SA(0, 1), cA + hstep, voffA);
        if (wr == 1) PG8_BAR;
        PG8_WAIT_V(4); PG8_BAR;
        PG8_STAGE(PG8_SB(1, 0), cB + kstep, voffB); PG8_STAGE(PG8_SA(1, 0), cA + kstep, voffA); PG8_STAGE(PG8_SB(1, 1), cB + hstep + kstep, voffB);
        PG8_WAIT_V(6); PG8_BAR;
    }
    for (;;) {
        const bool has_next = S.next(ui + 1, nxt);
        const char* nA = has_next ? (const char*)g.A + (size_t)nxt.pm * tstep : cA; const char* nB = has_next ? (const char*)g.Bt + (size_t)nxt.pn * tstep : cB;
        for (int t = 0; t < nt; t += 2) {
            const bool last = (t == nt - 2);
            const char* a1 = cA + (size_t)(t + 1) * kstep;
            const char* a2 = last ? nA : cA + (size_t)(t + 2) * kstep; const char* b2 = last ? nB : cB + (size_t)(t + 2) * kstep;
            const char* a3 = a2 + kstep; const char* b3 = b2 + kstep;
            if (last && has_next) S.a_ready(nxt);
            if constexpr (SP2) {
            PG8_LDB(B0, 0, 0); PG8_LDB(B1, 0, 1); PG8_SCHED; PG8_LDA(At, 0, 0); PG8_STAGE(PG8_SA(1, 1), a1 + hstep, voffA);
            PG8_WAIT_V(8); PG8_WAIT_L(0); PG8_BAR; PG8_MMA(0, 0, At, B0); PG8_MMA(0, 1, At, B1); PG8_BAR; PG8_SCHED;
            PG8_LDA(At, 0, 1); PG8_STAGE(PG8_SB(0, 0), b2, voffB); PG8_STAGE(PG8_SB(0, 1), b2 + hstep, voffB); PG8_STAGE(PG8_SA(0, 0), a2, voffA);
            PG8_WAIT_V(8); PG8_WAIT_L(0); PG8_BAR; PG8_MMA(1, 0, At, B0); PG8_MMA(1, 1, At, B1); PG8_BAR; PG8_SCHED;
            PG8_LDB(B0, 1, 0); PG8_LDB(B1, 1, 1); PG8_SCHED; PG8_LDA(At, 1, 0); PG8_STAGE(PG8_SA(0, 1), a2 + hstep, voffA);
            PG8_WAIT_V(8); PG8_WAIT_L(0); PG8_BAR; PG8_MMA(0, 0, At, B0); PG8_MMA(0, 1, At, B1); PG8_BAR; PG8_SCHED;
            PG8_LDA(At, 1, 1); PG8_STAGE(PG8_SB(1, 0), b3, voffB); PG8_STAGE(PG8_SB(1, 1), b3 + hstep, voffB); PG8_STAGE(PG8_SA(1, 0), a3, voffA);
            PG8_WAIT_V(8); PG8_WAIT_L(0); PG8_BAR; PG8_MMA(1, 0, At, B0); PG8_MMA(1, 1, At, B1); PG8_BAR; PG8_SCHED;
            } else {
            PG8_LDB(B0, 0, 0); PG8_SCHED; PG8_LDA(At, 0, 0); PG8_STAGE(PG8_SA(1, 1), a1 + hstep, voffA);
            PG8_WAIT_L(8); PG8_BAR; PG8_WAIT_L(0); PG8_MMA(0, 0, At, B0); PG8_BAR; PG8_SCHED;
            PG8_LDB(B1, 0, 1); PG8_STAGE(PG8_SB(0, 0), b2, voffB);
            PG8_BAR; PG8_WAIT_L(0); PG8_MMA(0, 1, At, B1); PG8_BAR;
            PG8_LDA(At, 0, 1); PG8_STAGE(PG8_SA(0, 0), a2, voffA);
            PG8_BAR; PG8_WAIT_L(0); PG8_MMA(1, 0, At, B0); PG8_BAR; PG8_SCHED;
            PG8_STAGE(PG8_SB(0, 1), b2 + hstep, voffB);
            PG8_WAIT_V(6); PG8_BAR; PG8_MMA(1, 1, At, B1); PG8_BAR;
            PG8_LDB(B0, 1, 0); PG8_SCHED; PG8_LDA(At, 1, 0); PG8_STAGE(PG8_SA(0, 1), a2 + hstep, voffA);
            PG8_WAIT_L(8); PG8_BAR; PG8_WAIT_L(0); PG8_MMA(0, 0, At, B0); PG8_BAR; PG8_SCHED;
            PG8_LDB(B1, 1, 1); PG8_STAGE(PG8_SB(1, 0), b3, voffB);
            PG8_BAR; PG8_WAIT_L(0); PG8_MMA(0, 1, At, B1); PG8_BAR;
            PG8_LDA(At, 1, 1); PG8_STAGE(PG8_SA(1, 0), a3, voffA);
            PG8_BAR; PG8_WAIT_L(0); PG8_MMA(1, 0, At, B0); PG8_BAR; PG8_SCHED;
            PG8_STAGE(PG8_SB(1, 1), b3 + hstep, voffB);
            PG8_WAIT_V(6); PG8_BAR; PG8_MMA(1, 1, At, B1); PG8_BAR;
            }
        }
        if constexpr (ALIGN_EPI) { if (wr == 0) PG8_BAR; }
        if constexpr (!Epi::AFTER_DRAIN) { E(acc, cur, wr, wc, fr, fq); S.done(cur); }
        if (!has_next) break;
#pragma unroll
        for (int a = 0; a < 2; ++a)
#pragma unroll
            for (int b = 0; b < 2; ++b)
#pragma unroll
                for (int m = 0; m < 4; ++m)
#pragma unroll
                    for (int n = 0; n < 2; ++n) acc[a][b][m][n] = (f32x4){0.f, 0.f, 0.f, 0.f};
        cur = nxt; cA = nA; cB = nB; ++ui;
        if constexpr (ALIGN_EPI) { if (wr == 1) PG8_BAR; }
    }
    PG8_WAIT_V(0);
    if constexpr (!ALIGN_EPI) { if (wr == 0) PG8_BAR; }
    PG8_BAR;
    if constexpr (Epi::AFTER_DRAIN) { E.fused(acc, cur, wr, wc, fr, fq, lds, wid, lane); S.done(cur); }
#undef PG8_SA
#undef PG8_SB
#undef PG8_STAGE
#undef PG8_LDA
#undef PG8_LDB
#undef PG8_MMA
#undef PG8_WAIT_V
#undef PG8_WAIT_L
#undef PG8_BAR
#undef PG8_SCHED
}
}
#define XB_TMO      128
#define XB_XCNT(j)  (256  + 64 * (j))
#define XB_XSUB(j)  (1280 + 64 * (j))
#define XB_XGEN(j)  (2304 + 64 * (j))
#define XB_TOP      3328
#define XB_TOPGEN   3392
#define XCD_BAR_WORDS 3456
#define XB_SPIN_CAP (1u << 18)

__device__ __forceinline__ unsigned xb_ld(unsigned* p)              { return __hip_atomic_load(p, __ATOMIC_RELAXED, __HIP_MEMORY_SCOPE_AGENT); }
__device__ __forceinline__ unsigned xb_add(unsigned* p, unsigned v) { return __hip_atomic_fetch_add(p, v, __ATOMIC_RELAXED, __HIP_MEMORY_SCOPE_AGENT); }
__device__ __forceinline__ unsigned xb_xcc_id() { return (unsigned)__builtin_amdgcn_s_getreg((3 << 11) | 20) & 0xFu; }
#define XB_SPIN(cond, bar) do { unsigned _sp = 0; while (cond) { __builtin_amdgcn_s_sleep(1); \
    if ((++_sp & 255u) == 0u) { if (xb_ld(&(bar)[XB_TMO])) break; if (_sp > XB_SPIN_CAP) { atomicAdd(&(bar)[XB_TMO], 1u); break; } } } } while (0)

struct XcdBarrier {
    unsigned* bar; unsigned x; unsigned w;
    volatile LAS unsigned* st;
};

__device__ __forceinline__ XcdBarrier xcd_barrier_post(unsigned* bar, volatile LAS unsigned* st, unsigned wave) {
    XcdBarrier b; b.bar = bar; b.x = xb_xcc_id(); b.st = st; b.w = wave;
    if (wave == 0u && fresh_lane() == 0) (void)xb_add(&bar[XB_XCNT(b.x)], 1u);
    return b;
}
__device__ __forceinline__ void xcd_barrier_complete(unsigned* bar, unsigned x, unsigned& nloc, unsigned& nx) {
    const unsigned G = gridDim.x * gridDim.y * gridDim.z;
    unsigned sum, cnt, mine, sp = 0u;
    for (;;) {
        sum = 0u; cnt = 0u; mine = 0u;
#pragma unroll
        for (unsigned j = 0; j < 16; ++j) { const unsigned c = xb_ld(&bar[XB_XCNT(j)]); sum += c; cnt += (c > 0u) ? 1u : 0u; mine = (j == x) ? c : mine; }
        if (sum == G) break;
        __builtin_amdgcn_s_sleep(1);
        if ((++sp & 255u) == 0u) { if (xb_ld(&bar[XB_TMO])) break; if (sp > XB_SPIN_CAP) { atomicAdd(&bar[XB_TMO], 1u); break; } }
    }
    nloc = mine > 0u ? mine : 1u; nx = cnt > 0u ? cnt : 1u;
}

__device__ __forceinline__ void xcd_barrier(const XcdBarrier& b) {
    asm volatile("s_waitcnt vmcnt(0)" ::: "memory");
    __syncthreads();
    if (b.w == 0u && fresh_lane() == 0) {
        unsigned* bar = b.bar;
        __builtin_amdgcn_s_waitcnt(0);
        unsigned nloc = b.st[0], nx = b.st[1];
        if (nloc == 0u) { xcd_barrier_complete(bar, b.x, nloc, nx); b.st[0] = nloc; b.st[1] = nx; }
        const unsigned old = xb_add(&bar[XB_XSUB(b.x)], 1u);
        const unsigned gen = old / nloc;
        if (old + 1u == (gen + 1u) * nloc) {
            __builtin_amdgcn_fence(__ATOMIC_RELEASE, "agent");
            asm volatile("s_waitcnt vmcnt(0)" ::: "memory");
            const unsigned og = xb_add(&bar[XB_TOP], 1u);
            const unsigned tg = og / nx;
            if (og + 1u == (tg + 1u) * nx) xb_add(&bar[XB_TOPGEN], 1u);
            else XB_SPIN(xb_ld(&bar[XB_TOPGEN]) == tg, bar);
            __builtin_amdgcn_fence(__ATOMIC_ACQUIRE, "agent");
            xb_add(&bar[XB_XGEN(b.x)], 1u);
            asm volatile("s_waitcnt vmcnt(0)" ::: "memory");
        } else {
            XB_SPIN(xb_ld(&bar[XB_XGEN(b.x)]) == gen, bar);
            __builtin_amdgcn_fence(__ATOMIC_ACQUIRE, "agent");
            asm volatile("s_waitcnt vmcnt(0)" ::: "memory");
        }
    }
    __syncthreads();
}

constexpr int NWAVES = 8, NTHREADS = 512;
constexpr int RING_BYTES = 131072, LDS_BYTES = 163840, LDSCTL_OFF = LDS_BYTES - 1024, MISC_OFF = LDSCTL_OFF + 320;
static_assert(pg8::STAGE_BYTES <= RING_BYTES, "GEMM stage buffers fit the ring");
struct Args { const float* in[25]; float* out; unsigned char* ws; int ph_lo, ph_hi, li, pad; };
enum { I_XP = 0, I_XS, I_CCKV, I_CKROPE, I_SC, I_SN, I_SM, I_C, I_CCTX, I_N1G, I_N2G, I_WADA, I_BADA, I_WIN, I_GATEB, I_MNG, I_QLG, I_KVLG, I_WQ, I_WKV, I_QHG, I_KHG, I_WOUT, I_WUP, I_WDN };

template <int MODE> __device__ __forceinline__ int src_col(int n) {
    if (MODE == 0) return n;
    if (MODE == 2) return (n & 127) < 96 ? (n >> 7) * 96 + (n & 127) : -1;
    if (n < 2048) return n;
    if (n < C_GATE) return n + 16;
    if (n < NIN) return n - 672;
    return -1;
}
template <int MODE>
__device__ __forceinline__ void transpose_item(const float* W, int K, int Nsrc, int Ndst, bf16_t* WT, LAS float* scr, int item, int lane) {
    const int nblk = Ndst / 32, kb = item / nblk, nb = item % nblk, k0 = 64 * kb, n0 = 32 * nb;
    const int sc = src_col<MODE>(n0 + (lane & 31));
#pragma unroll 8
    for (int i = 0; i < 32; ++i) { const int kk = 2 * i + (lane >> 5); scr[kk * 33 + (lane & 31)] = sc >= 0 ? W[(size_t)(k0 + kk) * Nsrc + sc] : 0.f; }
    LDS_WAIT(); asm volatile("" ::: "memory");
    const int c = lane & 7;
#pragma unroll
    for (int j = 0; j < 4; ++j) { const int n = (lane >> 3) + 8 * j; const LAS float* s = scr + (8 * c) * 33 + n;
        u32x4 o; o.x = cvt_pk_bf16(s[0 * 33], s[1 * 33]); o.y = cvt_pk_bf16(s[2 * 33], s[3 * 33]); o.z = cvt_pk_bf16(s[4 * 33], s[5 * 33]); o.w = cvt_pk_bf16(s[6 * 33], s[7 * 33]);
        *(u32x4*)(WT + (size_t)(n0 + n) * K + k0 + 8 * c) = o; }
    LDS_WAIT(); asm volatile("" ::: "memory");
}
template <int MODE>
__device__ __forceinline__ void gemv5_item(const float* c_in, const float* c_ctx, const float* W, const float* b_ada, float* OUT, LAS unsigned char* lds, int item, int tid, int lane, int wave) {
    constexpr int NW_ = MODE == 0 ? 6144 : FF;
    LAS float* s_l = (LAS float*)lds;
    LAS float* red = (LAS float*)(lds + 20480);
    for (int idx = tid; idx < 5120; idx += NTHREADS) { const int c = idx >> 10, k = idx & 1023; if (MODE == 0) { const float v = c == 0 ? c_ctx[k] : c_in[(c - 1) * 1024 + k]; s_l[idx] = v / (1.f + __expf(-v)); } else s_l[idx] = c_in[c * 6144 + 3072 + k]; }
    __syncthreads();
    const int n0 = item * 64, kq = lane >> 4, cq = lane & 15, kbase = wave * 128;
    f32x4 acc[5];
#pragma unroll
    for (int c = 0; c < 5; ++c) acc[c] = (f32x4){0.f, 0.f, 0.f, 0.f};
    const float* wp = W + (size_t)(kbase + kq) * NW_ + n0 + cq * 4;
#pragma unroll 8
    for (int it = 0; it < 32; ++it) { const f32x4 w = *(const f32x4*)(wp + (size_t)it * 4 * NW_); const int k = kbase + it * 4 + kq;
#pragma unroll
        for (int c = 0; c < 5; ++c) acc[c] += s_l[c * 1024 + k] * w; }
#pragma unroll
    for (int c = 0; c < 5; ++c)
#pragma unroll
        for (int e = 0; e < 4; ++e) { float v = acc[c][e]; v += __shfl_xor(v, 16); v += __shfl_xor(v, 32); acc[c][e] = v; }
    if (kq == 0) {
#pragma unroll
        for (int c = 0; c < 5; ++c) *(LAS f32x4*)(red + (wave * 5 + c) * 64 + cq * 4) = acc[c]; }
    __syncthreads();
    if (tid < 320) { const int c = tid >> 6, n = tid & 63; float s = MODE == 0 ? b_ada[n0 + n] : 0.f;
#pragma unroll
        for (int w = 0; w < 8; ++w) s += red[(w * 5 + c) * 64 + n];
        OUT[c * NW_ + n0 + n] = s; }
    __syncthreads();
}
__device__ __forceinline__ void p0_prologue(const Args& a, LAS unsigned char* lds, int tid, int lane, int wave, int G) {
    unsigned char* ws = a.ws;
    const int bx = blockIdx.x;
    if (bx < 96) gemv5_item<0>(a.in[I_C], a.in[I_CCTX], a.in[I_WADA], a.in[I_BADA], (float*)(ws + WS_MOD), lds, bx, tid, lane, wave);
    LAS float* scr = (LAS float*)(lds + wave * 16384);
    const int gw = bx * NWAVES + wave, NGW = G * NWAVES;
    constexpr int I_1 = (DM / 64) * (NINP / 32), I_2 = (QLORA / 64) * (NQP / 32), I_3 = (KVLORA / 64) * (NKV / 32), I_4 = (DM / 64) * (DM / 32), I_5 = (DM / 64) * (FF / 32), I_6 = (FF / 64) * (DM / 32);
    constexpr int NITEMS = I_1 + I_2 + I_3 + I_4 + I_5 + I_6;
    for (int it = gw; it < NITEMS; it += NGW) {
        int r = it;
        if (r < I_1) { transpose_item<1>(a.in[I_WIN], DM, NIN, NINP, (bf16_t*)(ws + WS_WIN), scr, r, lane); continue; } r -= I_1;
        if (r < I_2) { transpose_item<2>(a.in[I_WQ], QLORA, NQ, NQP, (bf16_t*)(ws + WS_WQ), scr, r, lane); continue; } r -= I_2;
        if (r < I_3) { transpose_item<0>(a.in[I_WKV], KVLORA, NKV, NKV, (bf16_t*)(ws + WS_WKV), scr, r, lane); continue; } r -= I_3;
        if (r < I_4) { transpose_item<0>(a.in[I_WOUT], DM, DM, DM, (bf16_t*)(ws + WS_WO), scr, r, lane); continue; } r -= I_4;
        if (r < I_5) { transpose_item<0>(a.in[I_WUP], DM, FF, FF, (bf16_t*)(ws + WS_WUP), scr, r, lane); continue; } r -= I_5;
        transpose_item<0>(a.in[I_WDN], FF, DM, DM, (bf16_t*)(ws + WS_WDN), scr, r, lane);
    }
    float* rope = (float*)(ws + WS_ROPE);
    for (int idx = bx * NTHREADS + tid; idx < TL * 16; idx += G * NTHREADS) { const int t = idx >> 4, j = idx & 15;
        const float pos = (float)(j < 8 ? (t >> 6) : (t & 63)); const float inv = exp2f(-(float)(j & 7) * 0.125f * 13.287712379549449f);
        float rev = pos * inv * 0.15915494309189535f; rev -= floorf(rev);
        rope[t * 32 + j] = __builtin_amdgcn_cosf(rev); rope[t * 32 + 16 + j] = __builtin_amdgcn_sinf(rev); }
}

__device__ __forceinline__ int cond_of_row(int row) { return row < MC ? 0 : 1 + ((row - MC) >> 11); }
__device__ __forceinline__ void norm_rows(const float* xa, const float* xb, const float* g, const float* MOD, int sh_off, int sc_off, bf16_t* out, int gw, int NGW, int lane) {
    for (int rb = gw * 8; rb < M; rb += NGW * 8) {
        const int cond = cond_of_row(rb);
        const f32x4* g4 = (const f32x4*)g + lane; const f32x4* sc4 = (const f32x4*)(MOD + cond * 6144 + sc_off) + lane; const f32x4* sh4 = (const f32x4*)(MOD + cond * 6144 + sh_off) + lane;
        f32x4 gm[4], sv[4];
#pragma unroll
        for (int j = 0; j < 4; ++j) { gm[j] = g4[64 * j] * (sc4[64 * j] + 1.0f); sv[j] = sh4[64 * j]; }
        for (int r = 0; r < 8; r += 2) {
            f32x4 v[2][4];
#pragma unroll
            for (int q = 0; q < 2; ++q) { const int row = rb + r + q; const f32x4* xr = (const f32x4*)(row < MC ? xa + (size_t)row * DM : xb + (size_t)(row - MC) * DM) + lane;
#pragma unroll
                for (int j = 0; j < 4; ++j) v[q][j] = xr[64 * j]; }
#pragma unroll
            for (int q = 0; q < 2; ++q) { const int row = rb + r + q; float s = 0.f;
#pragma unroll
                for (int j = 0; j < 4; ++j) s += (v[q][j].x * v[q][j].x + v[q][j].y * v[q][j].y) + (v[q][j].z * v[q][j].z + v[q][j].w * v[q][j].w);
                const float rstd = 1.0f / sqrtf(wave_sum(s) * (1.0f / DM) + EPS);
                u32x2* o8 = (u32x2*)(out + (size_t)row * DM) + lane;
#pragma unroll
                for (int j = 0; j < 4; ++j) { const f32x4 o = v[q][j] * rstd * gm[j] + sv[j]; u32x2 w; w.x = cvt_pk_bf16(o.x, o.y); w.y = cvt_pk_bf16(o.z, o.w); o8[64 * j] = w; } } }
    }
}
__device__ __forceinline__ void p3_rows(const Args& a, int gw, int NGW, int lane, int gtid, int NGT) {
    unsigned char* ws = a.ws; const bf16_t* PROJ = (const bf16_t*)(ws + WS_PROJ); bf16_t* QN = (bf16_t*)(ws + WS_QN); bf16_t* CKVN = (bf16_t*)(ws + WS_CKVN);
    float qg[8]; f32x4 kg;
    { const int l8 = lane < 48 ? lane * 8 : 0;
#pragma unroll
      for (int e = 0; e < 8; ++e) qg[e] = a.in[I_QLG][l8 + e];
      kg = *(const f32x4*)(a.in[I_KVLG] + lane * 4); }
    for (int rb = gw * 8; rb < M; rb += NGW * 8)
        for (int r4 = 0; r4 < 8; r4 += 4) {
            u32x4 qw[4]; u32x2 kw4[4]; unsigned short krw[4];
#pragma unroll
            for (int q = 0; q < 4; ++q) { const bf16_t* pr = PROJ + (size_t)(rb + r4 + q) * NINP;
                qw[q] = (u32x4){0u, 0u, 0u, 0u}; if (lane < 48) qw[q] = *(const u32x4*)(pr + C_QLAT + lane * 8);
                kw4[q] = *(const u32x2*)(pr + C_KVLAT + lane * 4); krw[q] = pr[C_KROPE + (lane & 31)]; }
#pragma unroll
            for (int q = 0; q < 4; ++q) { const int row = rb + r4 + q;
                float qv[8]; unpack8(qw[q], qv);
                float s = 0.f;
#pragma unroll
                for (int e = 0; e < 8; ++e) s += qv[e] * qv[e];
                const float rq = 1.0f / sqrtf(wave_sum(s) * (1.0f / QLORA) + EPS);
                if (lane < 48) {
#pragma unroll
                    for (int e = 0; e < 8; ++e) qv[e] *= rq * qg[e];
                    *(u32x4*)(QN + (size_t)row * QLORA + lane * 8) = pack8(qv); }
                const u32x2 kw = kw4[q];
                f32x4 kv = (f32x4){bflo(kw.x), bfhi(kw.x), bflo(kw.y), bfhi(kw.y)};
                const float rk = 1.0f / sqrtf(wave_sum((kv.x * kv.x + kv.y * kv.y) + (kv.z * kv.z + kv.w * kv.w)) * (1.0f / KVLORA) + EPS);
                kv = kv * rk * kg;
                u32x2 ow; ow.x = cvt_pk_bf16(kv.x, kv.y); ow.y = cvt_pk_bf16(kv.z, kv.w);
                *(u32x2*)(CKVN + (size_t)row * KVLORA + lane * 4) = ow;
                if (row < MC) { *(f32x4*)(a.out + O_CKV + (size_t)row * KVLORA + lane * 4) = kv;
                    if (lane < 32) a.out[O_KROPE + (size_t)row * 32 + lane] = bf2f(krw[q]); } } }
    for (int i = gtid; i < NBL * 256 * KVLORA / 8; i += NGT) { const float* s = a.in[I_CCKV] + (size_t)i * 8; float f[8];
#pragma unroll
        for (int e = 0; e < 8; ++e) f[e] = s[e];
        *(u32x4*)(CKVN + (size_t)M * KVLORA + (size_t)i * 8) = pack8(f); }
    for (int i = gtid; i < NBL * 256 * 32 / 8; i += NGT) { const float* s = a.in[I_CKROPE] + (size_t)i * 8; float f[8];
#pragma unroll
        for (int e = 0; e < 8; ++e) f[e] = s[e];
        *(u32x4*)((bf16_t*)(ws + WS_KRC) + (size_t)i * 8) = pack8(f); }
}
__device__ __forceinline__ void p5_headnorm(const Args& a, int gw, int NGW, int lane) {
    unsigned char* ws = a.ws; bf16_t* QB = (bf16_t*)(ws + WS_Q); const bf16_t* KVR = (const bf16_t*)(ws + WS_KVRAW); bf16_t* KB = (bf16_t*)(ws + WS_K);
    const bf16_t* PROJ = (const bf16_t*)(ws + WS_PROJ); const float* rope = (const float*)(ws + WS_ROPE);
    const int half = lane >> 5, hh = (lane >> 2) & 7, q4 = lane & 3;
    const bf16_t* KRC = (const bf16_t*)(ws + WS_KRC);
    constexpr int NP5 = (M + MKV) / 2;
    for (int p0 = gw; p0 < NP5; p0 += 2 * NGW) {
        u32x4 raw[2][3];
#pragma unroll
        for (int q = 0; q < 2; ++q) { const int p = p0 + q * NGW; if (p < NP5) {
            const int idx = 2 * p + half; const bool isq = idx < M; const int kr = isq ? idx : idx - M;
            if (isq) { const bf16_t* src = QB + (size_t)kr * NQ + hh * 96 + q4 * 24;
#pragma unroll
                for (int i = 0; i < 3; ++i) raw[q][i] = *(const u32x4*)(src + 8 * i);
            } else {
#pragma unroll
                for (int i = 0; i < 3; ++i) { const int ci = 3 * q4 + i;
                    const bf16_t* src = ci < 8 ? KVR + (size_t)kr * NKV + hh * 128 + 8 * ci : (kr < M ? PROJ + (size_t)kr * NINP + C_KROPE + 8 * (ci - 8) : KRC + (size_t)(kr - M) * 32 + 8 * (ci - 8));
                    raw[q][i] = *(const u32x4*)src; } } } }
#pragma unroll
        for (int q = 0; q < 2; ++q) { const int p = p0 + q * NGW; if (p < NP5) {
            const int idx = 2 * p + half; const bool isq = idx < M; const int kr = isq ? idx : idx - M;
            float v[24];
#pragma unroll
            for (int i = 0; i < 3; ++i) unpack8(raw[q][i], v + 8 * i);
            const float* g = isq ? a.in[I_QHG] : a.in[I_KHG];
            bf16_t* dst = isq ? QB + (size_t)kr * NQ + hh * 96 + q4 * 24 : KB + (size_t)kr * NQ + hh * 96 + q4 * 24;
            const bool dorope = kr >= MC && kr < M;
            float s = 0.f;
#pragma unroll
            for (int i = 0; i < 24; ++i) s += v[i] * v[i];
            s += __shfl_xor(s, 1); s += __shfl_xor(s, 2);
            const float rstd = 1.0f / sqrtf(s * (1.0f / 96.0f) + EPS);
#pragma unroll
            for (int i = 0; i < 24; ++i) v[i] *= rstd * g[q4 * 24 + i];
            float snd[8], rcv[8];
#pragma unroll
            for (int j = 0; j < 8; ++j) { snd[j] = (q4 == 2) ? v[16 + j] : v[8 + j]; rcv[j] = __shfl_xor(snd[j], 1); }
            if (dorope && q4 >= 2) { const float* cs = rope + (size_t)((kr - MC) & (TL - 1)) * 32;
                if (q4 == 2) {
#pragma unroll
                    for (int j = 0; j < 8; ++j) v[16 + j] = v[16 + j] * cs[j] - rcv[j] * cs[16 + j];
                } else {
#pragma unroll
                    for (int j = 0; j < 8; ++j) { const float x1 = v[j], x2 = v[16 + j], c = cs[8 + j], sn = cs[24 + j]; v[j] = x1 * c - x2 * sn; v[16 + j] = x1 * sn + x2 * c;
                        v[8 + j] = rcv[j] * cs[16 + j] + v[8 + j] * cs[j]; }
                } }
#pragma unroll
            for (int i = 0; i < 3; ++i) *(u32x4*)(dst + 8 * i) = pack8(v + 8 * i);
        } }
    }
}
__device__ __forceinline__ void p6b_hm(const Args& a, int gw, int NGW, int lane) {
    unsigned char* ws = a.ws; const bf16_t* HF = (const bf16_t*)a.out; const bf16_t* HB = HF + (size_t)M * 512; const bf16_t* PROJ = (const bf16_t*)(ws + WS_PROJ); bf16_t* A2 = (bf16_t*)(ws + WS_H);
    float mg[8];
#pragma unroll
    for (int e = 0; e < 8; ++e) mg[e] = a.in[I_MNG][lane * 8 + e];
    for (int row0 = gw; row0 < M; row0 += 2 * NGW) {
        u32x4 rf[2], rb_[2], ro[2];
#pragma unroll
        for (int q = 0; q < 2; ++q) { const int row = row0 + q * NGW; if (row < M) {
            rf[q] = *(const u32x4*)(HF + (size_t)row * 512 + lane * 8); rb_[q] = *(const u32x4*)(HB + (size_t)row * 512 + lane * 8);
            ro[q] = *(const u32x4*)(PROJ + (size_t)row * NINP + C_MO + lane * 8); } }
#pragma unroll
        for (int q = 0; q < 2; ++q) { const int row = row0 + q * NGW; if (row < M) {
            float f[8], b[8], o[8]; unpack8(rf[q], f); unpack8(rb_[q], b); unpack8(ro[q], o);
            float s = 0.f;
#pragma unroll
            for (int e = 0; e < 8; ++e) { f[e] += b[e]; s += f[e] * f[e]; }
            s += __shfl_xor(s, 1); s += __shfl_xor(s, 2); s += __shfl_xor(s, 4); s += __shfl_xor(s, 8);
            const float rstd = 1.0f / sqrtf(s * (1.0f / 128.0f) + EPS);
#pragma unroll
            for (int e = 0; e < 8; ++e) f[e] = f[e] * rstd * mg[e] / (1.0f + __expf(-o[e]));
            *(u32x4*)(A2 + (size_t)row * DM + lane * 8) = pack8(f); } }
    }
}

namespace att {
constexpr int QBLK = 32, KVBLK = 64;
constexpr float SCALE = 0.10206207261596577f;
constexpr float THR = 8.f;
constexpr int SHM_V = 64 * 128 * 2, SHM_K = 64 * 256;
constexpr int LDS_ATT = 2 * SHM_V + 2 * SHM_K + 8 * 64 * 4;
#define KSWZ(row, colB) ((row) * 256 + ((colB) ^ (((row) & 7) << 4)))
__device__ __forceinline__ int crow(int r, int hi) { return (r & 3) + 8 * (r >> 2) + 4 * hi; }
__device__ __forceinline__ void partialSM(f32x16& p0, f32x16& p1, float& m_reg, float& mn, float& alpha) {
  constexpr float C = SCALE * 1.4426950408889634f;
  float pmax = p0[0];
#pragma unroll
  for (int r = 1; r < 16; ++r) pmax = fmaxf(pmax, p0[r]);
#pragma unroll
  for (int r = 0; r < 16; ++r) pmax = fmaxf(pmax, p1[r]);
  { auto rr = __builtin_amdgcn_permlane32_swap(__float_as_uint(pmax), __float_as_uint(pmax), false, false);
    pmax = fmaxf(__uint_as_float(rr[0]), __uint_as_float(rr[1])); }
  if (__builtin_expect(__all(pmax - m_reg <= THR / SCALE), 1)) { mn = m_reg; alpha = 1.f; }
  else { mn = fmaxf(m_reg, pmax); alpha = __builtin_amdgcn_exp2f((m_reg - mn) * C); m_reg = mn; }
  float mnC = -mn * C;
#pragma unroll
  for (int r = 0; r < 16; ++r) p0[r] = fmaf(p0[r], C, mnC);
#pragma unroll
  for (int r = 0; r < 16; ++r) p1[r] = fmaf(p1[r], C, mnC);
#pragma unroll
  for (int r = 0; r < 16; ++r) p0[r] = __builtin_amdgcn_exp2f(p0[r]);
}
__device__ __forceinline__ void finishSM(f32x16& p0, f32x16& p1, float alpha, float& l_reg, bf16x8& pa0, bf16x8& pa1, bf16x8& pa2, bf16x8& pa3) {
#pragma unroll
  for (int r = 0; r < 16; ++r) p1[r] = __builtin_amdgcn_exp2f(p1[r]);
  float ps = 0;
#pragma unroll
  for (int r = 0; r < 16; ++r) ps += p0[r];
#pragma unroll
  for (int r = 0; r < 16; ++r) ps += p1[r];
  { auto rr = __builtin_amdgcn_permlane32_swap(__float_as_uint(ps), __float_as_uint(ps), false, false);
    ps = __uint_as_float(rr[0]) + __uint_as_float(rr[1]); }
  l_reg = l_reg * alpha + ps;
#define PK4(P, BASE, OUT) do { unsigned a0 = cvt_pk_bf16(P[BASE + 0], P[BASE + 1]), a1 = cvt_pk_bf16(P[BASE + 2], P[BASE + 3]);   \
    unsigned b0 = cvt_pk_bf16(P[BASE + 4], P[BASE + 5]), b1 = cvt_pk_bf16(P[BASE + 6], P[BASE + 7]);                              \
    auto r0 = __builtin_amdgcn_permlane32_swap(a0, b0, false, false); auto r1 = __builtin_amdgcn_permlane32_swap(a1, b1, false, false); \
    u32x4 w = {r0[0], r1[0], r0[1], r1[1]}; OUT = *reinterpret_cast<bf16x8*>(&w); } while (0)
  PK4(p0, 0, pa0); PK4(p0, 8, pa1); PK4(p1, 0, pa2); PK4(p1, 8, pa3);
#undef PK4
}
__device__ __forceinline__ void qkt(f32x16& p0, f32x16& p1, const char* Ks, const bf16x8* qr, int r32, int hi) {
  p0 = f32x16{}; p1 = f32x16{};
#pragma unroll
  for (int d0 = 0; d0 < 6; ++d0) { int cb = (d0 * 16 + hi * 8) * 2;
    bf16x8 b0 = *reinterpret_cast<const bf16x8*>(Ks + KSWZ(r32, cb));
    bf16x8 b1 = *reinterpret_cast<const bf16x8*>(Ks + KSWZ(32 + r32, cb));
    p0 = __builtin_amdgcn_mfma_f32_32x32x16_bf16(b0, qr[d0], p0, 0, 0, 0);
    p1 = __builtin_amdgcn_mfma_f32_32x32x16_bf16(b1, qr[d0], p1, 0, 0, 0); }
}
__device__ __forceinline__ int v_st(int k, int c) { const int kk = (k & ~0xC) | ((k & 4) << 1) | ((k & 8) >> 1); return ((kk >> 3) * 4 + (c >> 5)) * 512 + ((kk & 7) * 32 + (c & 31)) * 2; }
__device__ __forceinline__ int v_rd_base(int lane) { return ((lane & 3) << 3) | (((lane >> 2) & 3) << 6) | (((lane >> 4) & 1) << 5) | (((lane >> 5) & 1) << 8); }
constexpr int v_rd_off(int d0, int ks, int half) { return d0 * 512 + ks * 4096 + half * 2048; }
template <int OFF> __device__ __forceinline__ s16x4 tr_read(int vb) {
  s16x4 r; asm volatile("ds_read_b64_tr_b16 %0, %1 offset:%2" : "=&v"(r) : "v"(vb), "i"(OFF) : "memory"); return r;
}
template <int D0> __device__ __forceinline__ void pv_one(f32x16& od, int vb, bf16x8 pa0, bf16x8 pa1, bf16x8 pa2, bf16x8 pa3) {
  const s16x4 l0 = tr_read<v_rd_off(D0, 0, 0)>(vb), h0 = tr_read<v_rd_off(D0, 0, 1)>(vb), l1 = tr_read<v_rd_off(D0, 1, 0)>(vb), h1 = tr_read<v_rd_off(D0, 1, 1)>(vb);
  const s16x4 l2 = tr_read<v_rd_off(D0, 2, 0)>(vb), h2 = tr_read<v_rd_off(D0, 2, 1)>(vb), l3 = tr_read<v_rd_off(D0, 3, 0)>(vb), h3 = tr_read<v_rd_off(D0, 3, 1)>(vb);
  asm volatile("s_waitcnt lgkmcnt(0)" ::: "memory"); SBAR();
  od = __builtin_amdgcn_mfma_f32_32x32x16_bf16(pa0, MK8(l0, h0), od, 0, 0, 0);
  od = __builtin_amdgcn_mfma_f32_32x32x16_bf16(pa1, MK8(l1, h1), od, 0, 0, 0);
  od = __builtin_amdgcn_mfma_f32_32x32x16_bf16(pa2, MK8(l2, h2), od, 0, 0, 0);
  od = __builtin_amdgcn_mfma_f32_32x32x16_bf16(pa3, MK8(l3, h3), od, 0, 0, 0);
}
__device__ __forceinline__ void pv_d0(f32x16* o, int vb, bf16x8 pa0, bf16x8 pa1, bf16x8 pa2, bf16x8 pa3) {
  pv_one<0>(o[0], vb, pa0, pa1, pa2, pa3); pv_one<1>(o[1], vb, pa0, pa1, pa2, pa3);
}
__device__ __forceinline__ void attn_unit(const bf16_t* __restrict__ Qg, const bf16_t* __restrict__ Kg, const bf16_t* __restrict__ Vg, bf16_t* __restrict__ Og,
                                          int qrow0, int h, int rowA, int ntA, int rowB, int NT, char* lds, const int wid) {
  const int lane = fresh_lane(), tid = wid * 64 + lane, r32 = lane & 31, hi = lane >> 5;
  char* V_lds = lds; char* K_lds = lds + 2 * SHM_V;
  float* ws = (float*)(lds + 2 * SHM_V + 2 * SHM_K) + wid * 64; float* li_l = ws; float* al_l = ws + 32;
  float m_reg = -1e30f, l_reg = 0; f32x16 o[2] = {}; bf16x8 qr[6];
  const bf16_t* Qw = Qg + (size_t)(qrow0 + wid * QBLK + r32) * NQ + h * 96 + hi * 8;
#pragma unroll
  for (int d0 = 0; d0 < 6; ++d0) qr[d0] = *reinterpret_cast<const bf16x8*>(Qw + d0 * 16);
  const int sr = tid >> 4, sc = (tid & 15) * 8, vst0 = v_st(sr, sc), vst1 = v_st(32 + sr, sc);
  const int vb0 = (int)(uintptr_t)V_lds + v_rd_base(lane);
  const bf16_t* Kh = Kg + h * 96 + sc; const bf16_t* Vh = Vg + h * 128 + 64 + sc;
  struct { bf16x8 vs0, vs1, ks0, ks1; } sr_[2];
#define TROW(j) ((j) < ntA ? rowA + (j) * KVBLK : rowB + ((j) - ntA) * KVBLK)
#define SLOAD(i, j) do { const size_t r0_ = (size_t)(TROW(j) + sr); \
    sr_[i].vs0 = *reinterpret_cast<const bf16x8*>(Vh + r0_ * NKV); sr_[i].vs1 = *reinterpret_cast<const bf16x8*>(Vh + (r0_ + 32) * NKV); \
    sr_[i].ks0 = *reinterpret_cast<const bf16x8*>(Kh + r0_ * NQ); sr_[i].ks1 = *reinterpret_cast<const bf16x8*>(Kh + (r0_ + 32) * NQ); } while (0)
#define SWRITE(b, i) do { *(bf16x8*)(V_lds + (b) * SHM_V + vst0) = sr_[i].vs0;          \
    *(bf16x8*)(V_lds + (b) * SHM_V + vst1) = sr_[i].vs1; int kc = sc * 2;               \
    *(bf16x8*)(K_lds + (b) * SHM_K + KSWZ(sr, kc)) = sr_[i].ks0;                       \
    *(bf16x8*)(K_lds + (b) * SHM_K + KSWZ(32 + sr, kc)) = sr_[i].ks1; } while (0)
#define SWAIT() asm volatile("s_waitcnt vmcnt(4)" ::: "memory")
#define RESC(a) do { if (__any((a) < 1.f)) { if (hi == 0) al_l[r32] = (a); asm volatile("s_waitcnt lgkmcnt(0)" ::: "memory"); \
    _Pragma("unroll") for (int d = 0; d < 2; ++d) _Pragma("unroll") for (int r = 0; r < 16; ++r) o[d][r] *= al_l[crow(r, hi)]; } } while (0)
  f32x16 pA0, pA1, pB0, pB1; float mnA, mnB, alA, alB; bf16x8 pa0, pa1, pa2, pa3;
  constexpr int SE = 0, SO = 1;
  SLOAD(SE, 0); asm volatile("s_waitcnt vmcnt(0)" ::: "memory"); SWRITE(0, SE); __syncthreads();
  qkt(pA0, pA1, K_lds, qr, r32, hi); partialSM(pA0, pA1, m_reg, mnA, alA);
  SLOAD(SO, 1); if (2 < NT) SLOAD(SE, 2);
  SWAIT(); SWRITE(1, SO); __syncthreads();
  for (int j = 1; j + 1 < NT; j += 2) {
    SBAR(); qkt(pB0, pB1, K_lds + SHM_K, qr, r32, hi);
    finishSM(pA0, pA1, alA, l_reg, pa0, pa1, pa2, pa3); SBAR();
    SLOAD(SO, j + 2); SBAR();
    pv_d0(o, vb0, pa0, pa1, pa2, pa3); partialSM(pB0, pB1, m_reg, mnB, alB);
    __syncthreads(); SWAIT(); SWRITE(0, SE);
    RESC(alB); __syncthreads();
    SBAR(); qkt(pA0, pA1, K_lds, qr, r32, hi);
    finishSM(pB0, pB1, alB, l_reg, pa0, pa1, pa2, pa3); SBAR();
    if (j + 3 < NT) SLOAD(SE, j + 3); SBAR();
    pv_d0(o, vb0 + SHM_V, pa0, pa1, pa2, pa3); partialSM(pA0, pA1, m_reg, mnA, alA);
    __syncthreads(); SWAIT(); SWRITE(1, SO);
    RESC(alA); __syncthreads();
  }
  SBAR(); qkt(pB0, pB1, K_lds + SHM_K, qr, r32, hi);
  finishSM(pA0, pA1, alA, l_reg, pa0, pa1, pa2, pa3); SBAR();
  pv_d0(o, vb0, pa0, pa1, pa2, pa3); partialSM(pB0, pB1, m_reg, mnB, alB);
  __syncthreads(); RESC(alB);
  finishSM(pB0, pB1, alB, l_reg, pa0, pa1, pa2, pa3); SBAR();
  pv_d0(o, vb0 + SHM_V, pa0, pa1, pa2, pa3);
  if (hi == 0) li_l[r32] = l_reg; asm volatile("s_waitcnt lgkmcnt(0)" ::: "memory");
  float rli[16];
#pragma unroll
  for (int r = 0; r < 16; ++r) rli[r] = __builtin_amdgcn_rcpf(li_l[crow(r, hi)]);
  bf16_t* Ow = Og + (size_t)(qrow0 + wid * QBLK) * DM + 512 + h * 64;
#pragma unroll
  for (int r = 0; r < 16; ++r) { const int orow = crow(r, hi);
#pragma unroll
    for (int d0 = 0; d0 < 2; ++d0) Ow[(size_t)orow * DM + d0 * 32 + r32] = (bf16_t)(cvt_pk_bf16(o[d0][r] * rli[r], 0.f) & 0xffffu); }
  __syncthreads();
#undef TROW
#undef SLOAD
#undef SWRITE
#undef SWAIT
#undef RESC
}
}

namespace ml {
constexpr int PQ = 272, PP = 144;
constexpr int OFF_Q = 0, OFF_K = 17408, OFF_V = 34816, OFF_W = 52224  , OFF_P = 69632, OFF_CB = 78848, OFF_N = 113664, OFF_QN = 114176, OFF_DP = 114432, OFF_NP = 114944,
              OFF_AA = 116992  , OFF_AC = 125184  , OFF_AB = 133376  , OFF_MC = 141568  , LDS_ML = 141824;
__device__ __forceinline__ f32x4 mfma16(bf16x8 a, bf16x8 b, f32x4 c) { return __builtin_amdgcn_mfma_f32_16x16x32_bf16(a, b, c, 0, 0, 0); }
__device__ __forceinline__ u32x2 pack4(f32x4 v) { u32x2 w; w.x = cvt_pk_bf16(v.x, v.y); w.y = cvt_pk_bf16(v.z, v.w); return w; }

__device__ __forceinline__ void mlstm_seq(const Args& a, LAS unsigned char* lds, int kind, int b, int h, int dir, const int wave) {
    const int lane = fresh_lane(), tid = wave * 64 + lane, g = lane >> 4, i = lane & 15;
    const int T = kind ? TL : TC, nc = T / 64, rowbase = kind ? MC + b * TL : b * TC;
    const bf16_t* PROJ = (const bf16_t*)(a.ws + WS_PROJ); const float* gates = (const float*)(a.ws + WS_GATES);
    bf16_t* Hout = (bf16_t*)a.out + (dir ? (size_t)M * 512 : 0);
#define ROWP(p) (rowbase + (dir ? T - 1 - (p) : (p)))
    LAS float* const sa = (LAS float*)(lds + OFF_AA); LAS float* const sA = (LAS float*)(lds + OFF_AC); LAS float* const sbb = (LAS float*)(lds + OFF_AB); LAS float* const smc = (LAS float*)(lds + OFF_MC);
    const int s0 = tid >> 4, c8 = tid & 15;
    u32x4 pq[2], pk[2], pv[2];
#define LOADCH(c) do { _Pragma("unroll") for (int e = 0; e < 2; ++e) { const bf16_t* rp = PROJ + (size_t)ROWP(64 * (c) + s0 + 32 * e) * NINP + h * 128 + c8 * 8; \
        pq[e] = *(const u32x4*)(rp + C_MQ); pk[e] = *(const u32x4*)(rp + C_MK); pv[e] = *(const u32x4*)(rp + C_MV); } } while (0)
    LOADCH(0);
    { const float gb_i = a.in[I_GATEB][dir * 8 + h], gb_f = a.in[I_GATEB][dir * 8 + 4 + h];
      for (int c = wave; c < nc; c += 8) { const float* gp = gates + (size_t)ROWP(64 * c + lane) * 16 + dir * 8 + h;
        const float gi = gp[0] + gb_i, gf = gp[4] + gb_f;
        const float lf = fminf(gf, 0.f) - log1pf(__expf(-fabsf(gf))); float bs = lf;
#pragma unroll
        for (int o = 1; o < 64; o <<= 1) { const float t = __shfl_up(bs, o); if (lane >= o) bs += t; }
        const float av = gi - bs; float A = av;
#pragma unroll
        for (int o = 1; o < 64; o <<= 1) { const float t = __shfl_up(A, o); if (lane >= o) A = fmaxf(A, t); }
        sa[64 * c + lane] = av; sA[64 * c + lane] = A; sbb[64 * c + lane] = bs; } }
    const int v0 = wave * 16;
    f32x4 accC[8];
    const size_t sidx = (size_t)((b * 2 + dir) * 4 + h);
    LAS float* nl = (LAS float*)(lds + OFF_N);
    if (kind) { const float* C0 = a.in[I_SC] + sidx * 16384;
#pragma unroll
        for (int kb = 0; kb < 8; ++kb) accC[kb] = *(const f32x4*)(C0 + (size_t)(16 * kb + i) * 128 + v0 + 4 * g);
        if (tid < 128) nl[tid] = a.in[I_SN][sidx * 128 + tid];
    } else {
#pragma unroll
        for (int kb = 0; kb < 8; ++kb) accC[kb] = (f32x4){0.f, 0.f, 0.f, 0.f};
        if (tid < 128) nl[tid] = 0.f;
    }
#pragma unroll
    for (int kb = 0; kb < 8; ++kb) *(LAS u32x2*)(lds + OFF_CB + (16 * kb + i) * PQ + (v0 + 4 * g) * 2) = pack4(accC[kb]);
    __syncthreads();
    f32x4 accN = (f32x4){0.f, 0.f, 0.f, 0.f}; if (g == 0) accN[0] = nl[16 * wave + i];
    if (wave == 0) { const int cc = lane < nc ? lane : 0; const float b63 = sbb[64 * cc + 63], A63 = sA[64 * cc + 63]; float m = kind ? a.in[I_SM][sidx] : 0.f;
        for (int c = 0; c < nc; ++c) { if (lane == c) smc[c] = m; m = __shfl(b63, c) + fmaxf(m, __shfl(A63, c)); }
        if (lane == 0) smc[nc] = m; }
    __syncthreads();
    for (int c = 0; c < nc; ++c) {
        const float m_c = smc[c]; const float M63 = fmaxf(m_c, sA[64 * c + 63]); const float decay = __expf(m_c - M63);
#pragma unroll
        for (int e = 0; e < 2; ++e) { const int off = (s0 + 32 * e) * PQ + c8 * 16;
            *(LAS u32x4*)(lds + OFF_Q + off) = pq[e]; *(LAS u32x4*)(lds + OFF_K + off) = pk[e]; *(LAS u32x4*)(lds + OFF_V + off) = pv[e]; }
        if (tid < 64) ((LAS float*)(lds + OFF_W))[tid] = __expf(sa[64 * c + tid] - M63);
        __syncthreads();
        if (c + 1 < nc) LOADCH(c + 1);
        {
            const int tb = wave >> 1, t = 16 * tb + i; const float Mt = fmaxf(m_c, sA[64 * c + t]); float rs = 0.f;
            bf16x8 qf[4], kf0[4], kf1[4];
#pragma unroll
            for (int kk = 0; kk < 4; ++kk) { qf[kk] = *(const LAS bf16x8*)(lds + OFF_Q + t * PQ + (32 * kk + 8 * g) * 2);
                kf0[kk] = *(const LAS bf16x8*)(lds + OFF_K + (32 * (wave & 1) + i) * PQ + (32 * kk + 8 * g) * 2);
                kf1[kk] = *(const LAS bf16x8*)(lds + OFF_K + (32 * (wave & 1) + 16 + i) * PQ + (32 * kk + 8 * g) * 2); }
            const int tq = tid >> 3, part = tid & 7; float qn_q[16];
            unpack8(*(const LAS u32x4*)(lds + OFF_Q + tq * PQ + part * 32), qn_q); unpack8(*(const LAS u32x4*)(lds + OFF_Q + tq * PQ + part * 32 + 16), qn_q + 8);
            f32x4 acc0 = (f32x4){0.f, 0.f, 0.f, 0.f}, acc1 = (f32x4){0.f, 0.f, 0.f, 0.f};
#pragma unroll
            for (int kk = 0; kk < 4; ++kk) { acc0 = mfma16(kf0[kk], qf[kk], acc0); acc1 = mfma16(kf1[kk], qf[kk], acc1); }
            float d = 0.f;
#pragma unroll
            for (int x = 0; x < 16; ++x) d += qn_q[x] * nl[part * 16 + x];
            d += __shfl_xor(d, 1); d += __shfl_xor(d, 2); d += __shfl_xor(d, 4);
            if (part == 0) ((LAS float*)(lds + OFF_QN))[tq] = d;
#pragma unroll
            for (int u = 0; u < 2; ++u) { const int sblk = 2 * (wave & 1) + u; const f32x4 acc = u ? acc1 : acc0; f32x4 p;
#pragma unroll
                for (int r = 0; r < 4; ++r) { const int s = 16 * sblk + 4 * g + r; const float wv = __expf(sa[64 * c + s] - Mt); p[r] = (s <= t) ? acc[r] * wv : 0.f; rs += p[r]; }
                *(LAS u32x2*)(lds + OFF_P + t * PP + (16 * sblk + 4 * g) * 2) = pack4(p); }
            rs += __shfl_xor(rs, 16); rs += __shfl_xor(rs, 32);
            if (g == 0) ((LAS float*)(lds + OFF_DP))[(wave & 1) * 64 + t] = rs;
        }
        __syncthreads();
        {
            const LAS unsigned char* vtr = lds + OFF_V + (8 * g + (i >> 2)) * PQ + (v0 + 4 * (i & 3)) * 2;
            const LAS unsigned char* ctr = lds + OFF_CB + (8 * g + (i >> 2)) * PQ + (v0 + 4 * (i & 3)) * 2;
            bf16x8 vfr[2], pf[2][4], cf[4];
            f32x4 w8[2][2];
#pragma unroll
            for (int kk = 0; kk < 2; ++kk) { const s16x4 lo = tr16(vtr + 32 * kk * PQ), hi_ = tr16(vtr + (32 * kk + 4) * PQ); vfr[kk] = MK8(lo, hi_);
                w8[kk][0] = *(const LAS f32x4*)(lds + OFF_W + (32 * kk + 8 * g) * 4); w8[kk][1] = *(const LAS f32x4*)(lds + OFF_W + (32 * kk + 8 * g + 4) * 4);
#pragma unroll
                for (int tb = 0; tb < 4; ++tb) pf[kk][tb] = *(const LAS bf16x8*)(lds + OFF_P + (16 * tb + i) * PP + (32 * kk + 8 * g) * 2); }
#pragma unroll
            for (int kk = 0; kk < 4; ++kk) { const s16x4 lo = tr16(ctr + 32 * kk * PQ), hi_ = tr16(ctr + (32 * kk + 4) * PQ); cf[kk] = MK8(lo, hi_); }
            f32x4 intra[4], inter[4];
#pragma unroll
            for (int tb = 0; tb < 4; ++tb) { intra[tb] = (f32x4){0.f, 0.f, 0.f, 0.f}; inter[tb] = (f32x4){0.f, 0.f, 0.f, 0.f}; }
#pragma unroll
            for (int kk = 0; kk < 2; ++kk)
#pragma unroll
                for (int tb = 0; tb < 4; ++tb) intra[tb] = mfma16(vfr[kk], pf[kk][tb], intra[tb]);
#pragma unroll
            for (int kk = 0; kk < 4; ++kk) { bf16x8 qf[4];
#pragma unroll
                for (int tb = 0; tb < 4; ++tb) qf[tb] = *(const LAS bf16x8*)(lds + OFF_Q + (16 * tb + i) * PQ + (32 * kk + 8 * g) * 2);
#pragma unroll
                for (int tb = 0; tb < 4; ++tb) inter[tb] = mfma16(cf[kk], qf[tb], inter[tb]); }
            bf16x8 vfw[2], onw[2];
#pragma unroll
            for (int kk = 0; kk < 2; ++kk) { float vf[8]; unpack8(__builtin_bit_cast(u32x4, vfr[kk]), vf); float wv[8];
#pragma unroll
                for (int x = 0; x < 4; ++x) { wv[x] = w8[kk][0][x]; wv[4 + x] = w8[kk][1][x]; }
#pragma unroll
                for (int x = 0; x < 8; ++x) vf[x] *= wv[x];
                vfw[kk] = __builtin_bit_cast(bf16x8, pack8(vf));
                u32x4 ow = pack8(wv); if (i != 0) ow = (u32x4){0u, 0u, 0u, 0u}; onw[kk] = __builtin_bit_cast(bf16x8, ow); }
#pragma unroll
            for (int kb = 0; kb < 8; ++kb) { accC[kb] = accC[kb] * decay; bf16x8 kfr[2];
#pragma unroll
                for (int kk = 0; kk < 2; ++kk) { const LAS unsigned char* kp = lds + OFF_K + (32 * kk + 8 * g + (i >> 2)) * PQ + (16 * kb + 4 * (i & 3)) * 2;
                    const s16x4 lo = tr16(kp), hi_ = tr16(kp + 4 * PQ); kfr[kk] = MK8(lo, hi_); }
                accC[kb] = mfma16(vfw[0], kfr[0], accC[kb]); accC[kb] = mfma16(vfw[1], kfr[1], accC[kb]);
                if (kb == wave) { accN = accN * decay; accN = mfma16(onw[0], kfr[0], accN); accN = mfma16(onw[1], kfr[1], accN); } }
            const LAS float* dp = (const LAS float*)(lds + OFF_DP); const LAS float* qn = (const LAS float*)(lds + OFF_QN);
#pragma unroll
            for (int tb = 0; tb < 4; ++tb) { const int t = 16 * tb + i; const float Mt = fmaxf(m_c, sA[64 * c + t]); const float wi = __expf(m_c - Mt);
                const float den = dp[t] + dp[64 + t] + wi * qn[t]; const float inv = 1.0f / fmaxf(fabsf(den), __expf(-(sbb[64 * c + t] + Mt)));
                const f32x4 hv = (intra[tb] + inter[tb] * wi) * inv;
                *(u32x2*)(Hout + (size_t)ROWP(64 * c + t) * 512 + h * 128 + v0 + 4 * g) = pack4(hv); }
        }
        __syncthreads();
#pragma unroll
        for (int kb = 0; kb < 8; ++kb) *(LAS u32x2*)(lds + OFF_CB + (16 * kb + i) * PQ + (v0 + 4 * g) * 2) = pack4(accC[kb]);
        if (g == 0) nl[16 * wave + i] = accN[0];
    }
    if (kind == 0) {
        float* oC = a.out + O_C + sidx * 16384;
#pragma unroll
        for (int kb = 0; kb < 8; ++kb) *(f32x4*)(oC + (size_t)(16 * kb + i) * 128 + v0 + 4 * g) = accC[kb];
        if (g == 0) a.out[O_N + sidx * 128 + 16 * wave + i] = accN[0];
        if (tid == 0) a.out[O_M + sidx] = smc[nc];
    }
    __syncthreads();
#undef ROWP
#undef LOADCH
}
}

constexpr int NPH = 10;
#ifndef LAUNCH_LIST
#define LAUNCH_LIST {0, 10}
#endif
constexpr int Q_NITEMS = 800;

__global__ void __launch_bounds__(NTHREADS, 2) fwd_megakernel(Args args) {
    extern __shared__ __attribute__((aligned(16))) unsigned char lds_raw[];
    LAS unsigned char* lds = (LAS unsigned char*)lds_raw;
    volatile LAS unsigned* MISC = (volatile LAS unsigned*)(lds + MISC_OFF);
    const int wave = __builtin_amdgcn_readfirstlane(threadIdx.x >> 6);
#define tid (wave * 64 + lane)
    const int G = gridDim.x, bx = blockIdx.x;
    unsigned char* ws = args.ws;
    unsigned* ctl = (unsigned*)(ws + WS_CTL);
    { const int lane = fresh_lane();
    for (int u = tid; u < (LDS_BYTES - LDSCTL_OFF) / 4; u += NTHREADS) ((LAS unsigned*)(lds + LDSCTL_OFF))[u] = 0u; }
    __syncthreads();
    XcdBarrier bar = xcd_barrier_post(ctl + CW_BAR + args.li * XCD_BAR_WORDS, MISC + 8, (unsigned)wave);
    const int lo = args.ph_lo, hi = args.ph_hi;
#define IN(k) (lo <= (k) && (k) < hi)
#define SEAM(k) do { if (IN(k) && IN((k) + 1)) xcd_barrier(bar); } while (0)
    const int gw = bx * NWAVES + wave, NGW = G * NWAVES;
    bf16_t* const HBUF = (bf16_t*)(ws + WS_H);
    float* const MOD = (float*)(ws + WS_MOD);
    float* const X1 = (float*)(ws + WS_X1);

    if (IN(0)) { const int lane = fresh_lane(); p0_prologue(args, lds, tid, lane, wave, G); SEAM(0); }
    if (IN(1)) { const int lane = fresh_lane(); norm_rows(args.in[I_XP], args.in[I_XS], args.in[I_N1G], MOD, 0, 1024, HBUF, gw, NGW, lane); SEAM(1); }
    if (IN(2)) {
        pg8::Gemm g{HBUF, (const bf16_t*)(ws + WS_WIN), M, NINP, DM}; pg8::StaticOrder S; S.init(M, NINP, G, bx);
        pg8::EpiProj E{(bf16_t*)(ws + WS_PROJ), (float*)(ws + WS_GATES)};
        pg8::gemm_phase<pg8::EpiProj, pg8::StaticOrder, true, true>(lds, g, S, E, wave);
        for (int it = (G == 256) ? (bx >= 192 ? bx - 192 : 64) : bx; it < 64; it += G) { const int lane = fresh_lane(); gemv5_item<1>(MOD, nullptr, args.in[I_WUP], nullptr, (float*)(ws + WS_BIAS2), lds, it, tid, lane, wave); }
        SEAM(2);
    }
    if (IN(3)) { const int lane = fresh_lane(); p3_rows(args, gw, NGW, lane, bx * NTHREADS + tid, G * NTHREADS); SEAM(3); }
    if (IN(4)) {
        pg8::PG8_LAS_float_ptr Xl = (pg8::PG8_LAS_float_ptr)(lds + RING_BYTES);
        int kq = QLORA, kkv = KVLORA; asm volatile("" : "+s"(kq), "+s"(kkv));
        { pg8::Gemm g{(const bf16_t*)(ws + WS_QN), (const bf16_t*)(ws + WS_WQ), M, NQP, kq}; pg8::StaticOrder S; S.init(M, NQP, G, bx);
          pg8::EpiHead<0> E{(bf16_t*)(ws + WS_Q), nullptr, args.in[I_QHG], nullptr, nullptr, Xl};
          pg8::gemm_phase<pg8::EpiHead<0>, pg8::StaticOrder, true, true>(lds, g, S, E, wave); }
        { pg8::Gemm g{(const bf16_t*)(ws + WS_CKVN), (const bf16_t*)(ws + WS_WKV), MKV, NKV, kkv}; pg8::StaticOrder S; S.init(MKV, NKV, G, G == 256 ? ((bx + 64) & 255) : bx);
          pg8::EpiHead<1> E{(bf16_t*)(ws + WS_K), (bf16_t*)(ws + WS_KVRAW), args.in[I_KHG], (const bf16_t*)(ws + WS_PROJ), (const bf16_t*)(ws + WS_KRC), Xl};
          pg8::gemm_phase<pg8::EpiHead<1>, pg8::StaticOrder, true, true>(lds, g, S, E, wave); }
        SEAM(4);
    }
    if (IN(5)) {
        volatile LAS int* qslot = (volatile LAS int*)(lds + MISC_OFF + 64);
        for (;;) {
            __syncthreads();
            if (wave == 0 && fresh_lane() == 0) *qslot = (int)__hip_atomic_fetch_add(ctl + CW_QUEUE + 64 * args.li, 1u, __ATOMIC_RELAXED, __HIP_MEMORY_SCOPE_AGENT);
            __syncthreads();
            const int idx = __builtin_amdgcn_readfirstlane(*qslot);
            if (idx >= Q_NITEMS) break;
#ifdef PROBE_QLO
            if (args.li == 1 && (idx < PROBE_QLO || idx >= PROBE_QHI)) continue;
#endif
            if (idx < 32) ml::mlstm_seq(args, lds, 1, idx >> 3, (idx >> 1) & 3, idx & 1, wave);
            else if (idx < 288) { const int j = idx - 32, b = j >> 6, h = (j >> 3) & 7, qb = j & 7;
                att::attn_unit((const bf16_t*)(ws + WS_Q), (const bf16_t*)(ws + WS_K), (const bf16_t*)(ws + WS_KVRAW), HBUF, MC + b * TL + qb * 256, h, MC + b * TL, 32, M + b * 256, 36, (char*)lds_raw, wave); }
            else if (idx < 544) { const int j = idx - 288; ml::mlstm_seq(args, lds, 0, j >> 3, (j >> 1) & 3, j & 1, wave); }
            else { const int j = idx - 544, b = j >> 3, h = j & 7;
                att::attn_unit((const bf16_t*)(ws + WS_Q), (const bf16_t*)(ws + WS_K), (const bf16_t*)(ws + WS_KVRAW), HBUF, b * TC, h, b * TC, 4, 0, 4, (char*)lds_raw, wave); }
        }
        SEAM(5);
    }
    if (IN(6)) { const int lane = fresh_lane(); p6b_hm(args, gw, NGW, lane); SEAM(6); }
    if (IN(7)) {
        pg8::Gemm g{HBUF, (const bf16_t*)(ws + WS_WO), M, DM, DM}; pg8::StaticOrder S; S.init(M, DM, G, bx);
        pg8::EpiMix E{args.in[I_XP], args.in[I_XS], X1, (bf16_t*)(ws + WS_XG), MOD, args.in[I_N2G], (float*)(ctl + CW_ROWSQ)};
        pg8::gemm_phase<pg8::EpiMix, pg8::StaticOrder, true, true>(lds, g, S, E, wave);
        SEAM(7);
    }
    if (IN(8)) {
        pg8::Gemm g{(const bf16_t*)(ws + WS_XG), (const bf16_t*)(ws + WS_WUP), M, FF, DM}; pg8::StaticOrder S; S.init(M, FF, G, bx);
        pg8::EpiUp E{(bf16_t*)(ws + WS_U), (const float*)(ctl + CW_ROWSQ), (const float*)(ws + WS_BIAS2)};
        pg8::gemm_phase<pg8::EpiUp, pg8::StaticOrder, true, true>(lds, g, S, E, wave);
        SEAM(8);
    }
    if (IN(9)) {
        pg8::Gemm g{(const bf16_t*)(ws + WS_U), (const bf16_t*)(ws + WS_WDN), M, DM, FF}; pg8::StaticOrder S; S.init(M, DM, G, bx);
        pg8::EpiResGate E{X1, X1 + (size_t)MC * DM, args.out, MOD, 5120};
        pg8::gemm_phase<pg8::EpiResGate, pg8::StaticOrder, true, true>(lds, g, S, E, wave);
    }
static_assert(ml::LDS_ML <= LDSCTL_OFF && att::LDS_ATT <= LDSCTL_OFF, "phase scratch below the LDS control words");
#undef IN
#undef SEAM
#undef tid
}

extern "C" void kernel_launch(void* const* d_in, const int* in_sizes, int n_in, void* d_out, int out_size, void* d_ws, size_t ws_size, hipStream_t stream) {
    static int grid = 0;
    if (grid == 0) {
        if (n_in != 25 || in_sizes[0] != MC * DM || in_sizes[1] != ML * DM || out_size != (int)O_END || ws_size < WS_END) {
            fprintf(stderr, "kernel_launch: unexpected shapes: n_in %d in0 %d in1 %d out %d ws %zu (need >= %zu); nothing launched\n", n_in, n_in > 0 ? in_sizes[0] : -1, n_in > 1 ? in_sizes[1] : -1, out_size, ws_size, (size_t)WS_END); grid = -1; return; }
        int dev = 0, cus = 0, per_cu = 0;
        if (hipGetDevice(&dev) != hipSuccess || hipDeviceGetAttribute(&cus, hipDeviceAttributeMultiprocessorCount, dev) != hipSuccess) { fprintf(stderr, "kernel_launch: device query failed\n"); grid = -1; return; }
        if (hipFuncSetAttribute((const void*)fwd_megakernel, hipFuncAttributeMaxDynamicSharedMemorySize, LDS_BYTES) != hipSuccess) { fprintf(stderr, "kernel_launch: hipFuncSetAttribute failed\n"); grid = -1; return; }
        if (hipOccupancyMaxActiveBlocksPerMultiprocessor(&per_cu, (const void*)fwd_megakernel, NTHREADS, LDS_BYTES) != hipSuccess || per_cu < 1) {
            fprintf(stderr, "kernel_launch: occupancy query reports %d workgroups per CU; nothing launched\n", per_cu); (void)hipGetLastError(); grid = -1; return; }
        grid = cus;
    }
    if (grid < 0) return;
    if (hipMemsetAsync((char*)d_ws + WS_CTL, 0, CTL_ZERO_BYTES, stream) != hipSuccess) { fprintf(stderr, "kernel_launch: memset failed\n"); return; }
    Args a{};
    for (int i = 0; i < 25; ++i) a.in[i] = (const float*)d_in[i];
    a.out = (float*)d_out; a.ws = (unsigned char*)d_ws;
    static const int plist[] = LAUNCH_LIST;
    for (int li = 0; li < (int)(sizeof(plist) / sizeof(int)) / 2; ++li) {
        a.ph_lo = plist[2 * li]; a.ph_hi = plist[2 * li + 1]; a.li = li;
        hipLaunchKernelGGL(fwd_megakernel, dim3(grid), dim3(NTHREADS), LDS_BYTES, stream, a);
        const hipError_t le = hipPeekAtLastError();
        if (le != hipSuccess) { fprintf(stderr, "kernel_launch: launch %d failed: %s\n", li, hipGetErrorName(le)); break; }
    }
}
```

```cpp
#include <hip/hip_runtime.h>
#include <hip/hip_bf16.h>
#include <cstdio>
#include <cstdint>


#define LAS __attribute__((address_space(3)))
#define GAS __attribute__((address_space(1)))
typedef unsigned short bf16_t;
typedef short bf16x8 __attribute__((ext_vector_type(8)));
typedef short s16x4 __attribute__((ext_vector_type(4)));
typedef float f32x4 __attribute__((ext_vector_type(4)));
typedef float f32x2 __attribute__((ext_vector_type(2)));
typedef float f32x16 __attribute__((ext_vector_type(16)));
typedef unsigned u32x4 __attribute__((ext_vector_type(4)));
typedef unsigned u32x2 __attribute__((ext_vector_type(2)));

constexpr int DM = 1024, MC = 8192, ML = 8192, M = 16384, TC = 256, TL = 2048, NBC = 32, NBL = 4;
constexpr int NIN = 2736, NINP = 2816;
constexpr int C_MQ = 0, C_MK = 512, C_MV = 1024, C_MO = 1536, C_QLAT = 2048, C_KVLAT = 2432, C_KROPE = 2688, C_GATE = 2720;
constexpr int QLORA = 384, KVLORA = 256, NQ = 768, NQP = 1024  , NKV = 1024, FF = 4096;
constexpr int MKV = M + NBL * 256;
constexpr float EPS = 1e-6f;

constexpr size_t O_Y = 0, O_Z = 8388608, O_CKV = 16777216, O_KROPE = 18874368, O_C = 19136512, O_N = 23330816, O_M = 23363584, O_END = 23363840;

constexpr size_t MiB = 1u << 20;
constexpr size_t WS_CTL = 0, CTL_ZERO_BYTES = 1 * MiB;
constexpr size_t WS_MOD = 1 * MiB, WS_ROPE = 1 * MiB + 131072;
constexpr size_t WS_WIN = 2 * MiB, WS_WQ = 8 * MiB, WS_WKV = 9 * MiB, WS_WO = 10 * MiB, WS_WUP = 12 * MiB, WS_WDN = 20 * MiB, WS_GATES = 28 * MiB, WS_KRC = 29 * MiB;
constexpr size_t WS_H = 32 * MiB;
constexpr size_t WS_QN = 32 * MiB, WS_CKVN = 44 * MiB;
constexpr size_t WS_PROJ = 64 * MiB, WS_Q = 152 * MiB, WS_KVRAW = 176 * MiB, WS_K = 210 * MiB;
constexpr size_t WS_X1 = 192 * MiB, WS_END = 256 * MiB;
constexpr size_t WS_U = 32 * MiB;
constexpr size_t WS_XG = 160 * MiB;
constexpr size_t WS_CKVC = 31 * MiB;
constexpr size_t WS_BIAS2 = 30 * MiB;
constexpr int CW_TMO = 0, CW_QUEUE = 64, CW_BAR = 4096, CW_ROWSQ = 131072;

__device__ __forceinline__ unsigned cvt_pk_bf16(float lo, float hi) { unsigned r; asm volatile("v_cvt_pk_bf16_f32 %0, %1, %2" : "=v"(r) : "v"(lo), "v"(hi)); return r; }
__device__ __forceinline__ float bf2f(unsigned short x) { return __uint_as_float(((unsigned)x) << 16); }
__device__ __forceinline__ float bflo(unsigned w) { return __uint_as_float(w << 16); }
__device__ __forceinline__ float bfhi(unsigned w) { return __uint_as_float(w & 0xffff0000u); }
__device__ __forceinline__ void unpack8(u32x4 w, float* f) { f[0] = bflo(w.x); f[1] = bfhi(w.x); f[2] = bflo(w.y); f[3] = bfhi(w.y); f[4] = bflo(w.z); f[5] = bfhi(w.z); f[6] = bflo(w.w); f[7] = bfhi(w.w); }
__device__ __forceinline__ u32x4 pack8(const float* f) { u32x4 w; w.x = cvt_pk_bf16(f[0], f[1]); w.y = cvt_pk_bf16(f[2], f[3]); w.z = cvt_pk_bf16(f[4], f[5]); w.w = cvt_pk_bf16(f[6], f[7]); return w; }
__device__ __forceinline__ float wave_sum(float v) {
#pragma unroll
    for (int o = 1; o < 64; o <<= 1) v += __shfl_xor(v, o);
    return v;
}
__device__ __forceinline__ int fresh_lane() { int l; asm volatile("v_mbcnt_lo_u32_b32 %0, -1, 0\n\tv_mbcnt_hi_u32_b32 %0, -1, %0" : "=v"(l)); return l; }
#define LDS_WAIT() asm volatile("s_waitcnt lgkmcnt(0)" ::: "memory")
#define VM_WAIT() asm volatile("s_waitcnt vmcnt(0)" ::: "memory")
#define SBAR() __builtin_amdgcn_sched_barrier(0)
typedef short v4i16_t __attribute__((ext_vector_type(4)));
__device__ __forceinline__ s16x4 tr16(const LAS unsigned char* p) { return __builtin_bit_cast(s16x4, __builtin_amdgcn_ds_read_tr16_b64_v4i16((LAS v4i16_t*)p)); }
#define MK8(L, H) (bf16x8){L[0], L[1], L[2], L[3], H[0], H[1], H[2], H[3]}

namespace pg8 {
#define PG8_LAS __attribute__((address_space(3)))
typedef PG8_LAS float* PG8_LAS_float_ptr;
constexpr int BM = 256, BK = 64, HALF = 128, HTB = HALF * BK * 2  , STAGE_BYTES = 8 * HTB, NXCD = 8, WGM = 8;

__host__ __device__ __forceinline__ int lds_byte(int r, int c) { const int st = (r >> 4) * 2 + (c >> 5), rr = r & 15, cc = c & 31, ob = rr * 64 + cc * 2; return st * 1024 + (ob ^ (((ob >> 9) & 1) << 5)); }
__host__ __device__ __forceinline__ void stage_rc(int b, int& R, int& C) { const int st = b / 1024, sb = b % 1024, swz = sb ^ (((sb >> 9) & 1) << 5); R = (st >> 1) * 16 + swz / 64; C = (st & 1) * 32 + (swz % 64) / 2; }
__host__ __device__ __forceinline__ int perm32(int rho) { const int n = rho >> 4, i = rho & 15; return 8 * (i >> 2) + 4 * n + (i & 3); }

struct Unit { int pm, pn; };
struct Gemm { const bf16_t* A; const bf16_t* Bt; int M, N, K; };

struct StaticOrder {
    int nM, nN, nwg, G, c;
    __host__ __device__ void init(int M, int N, int G_, int c_) { nM = M / BM; nN = N / BM; nwg = nM * nN; G = G_; c = c_; }
    __host__ __device__ bool next(int i, Unit& u) const {
        const long L = (long)i * G + c; if (L >= nwg) return false;
        int wgid = (int)L; { const int q = nwg / NXCD, r = nwg % NXCD, xcd = wgid % NXCD, off = wgid / NXCD; wgid = (xcd < r ? xcd * (q + 1) : r * (q + 1) + (xcd - r) * q) + off; }
        const int nig = WGM * nN, gid = wgid / nig, fm = gid * WGM, gsz = (nM - fm) < WGM ? (nM - fm) : WGM;
        u.pm = fm + ((wgid % nig) % gsz); u.pn = (wgid % nig) / gsz; return true;
    }
    __device__ __forceinline__ void a_ready(const Unit&) const {}
    __device__ __forceinline__ void done(const Unit&) const {}
};


template <int ACT> struct EpiBf16 {
    static constexpr bool PERM = true, AFTER_DRAIN = false;
    bf16_t* O; int ldc;
    __device__ __forceinline__ void operator()(const f32x4 (&acc)[2][2][4][2], const Unit& u, int wr, int wc, int fr, int fq) const {
        const int row0 = u.pm * BM + wr * 64 + fr, col0 = u.pn * BM + wc * 32 + 8 * fq;
#pragma unroll
        for (int ai = 0; ai < 2; ++ai)
#pragma unroll
            for (int m = 0; m < 4; ++m) { bf16_t* rowp = O + (size_t)(row0 + ai * HALF + m * 16) * ldc + col0;
#pragma unroll
                for (int bj = 0; bj < 2; ++bj) { f32x4 v0 = acc[ai][bj][m][0], v1 = acc[ai][bj][m][1];
                    if (ACT == 2) {
#pragma unroll
                        for (int e = 0; e < 4; ++e) { const float a = fmaxf(v0[e], 0.f), b = fmaxf(v1[e], 0.f); v0[e] = a * a; v1[e] = b * b; } }
                    u32x4 w; w.x = cvt_pk_bf16(v0[0], v0[1]); w.y = cvt_pk_bf16(v0[2], v0[3]); w.z = cvt_pk_bf16(v1[0], v1[1]); w.w = cvt_pk_bf16(v1[2], v1[3]);
                    *(u32x4*)(rowp + bj * HALF) = w; } }
    }
};
struct EpiProj {
    static constexpr bool PERM = true, AFTER_DRAIN = false;
    bf16_t* O; float* gates;
    __device__ __forceinline__ void operator()(const f32x4 (&acc)[2][2][4][2], const Unit& u, int wr, int wc, int fr, int fq) const {
        const int row0 = u.pm * BM + wr * 64 + fr, col0 = u.pn * BM + wc * 32 + 8 * fq;
        const float ksc = (u.pn == 2 || u.pn == 3) ? 0.08838834764831845f : 1.0f;
#pragma unroll
        for (int ai = 0; ai < 2; ++ai)
#pragma unroll
            for (int m = 0; m < 4; ++m) { const int row = row0 + ai * HALF + m * 16; bf16_t* rowp = O + (size_t)row * NINP + col0;
#pragma unroll
                for (int bj = 0; bj < 2; ++bj) { const f32x4 v0 = acc[ai][bj][m][0] * ksc, v1 = acc[ai][bj][m][1] * ksc; const int c = col0 + bj * HALF;
                    if (c >= C_GATE && c < C_GATE + 16) { float* gp = gates + (size_t)row * 16 + (c - C_GATE); *(f32x4*)gp = v0; *(f32x4*)(gp + 4) = v1; }
                    u32x4 w; w.x = cvt_pk_bf16(v0[0], v0[1]); w.y = cvt_pk_bf16(v0[2], v0[3]); w.z = cvt_pk_bf16(v1[0], v1[1]); w.w = cvt_pk_bf16(v1[2], v1[3]);
                    *(u32x4*)(rowp + bj * HALF) = w; } }
    }
};
__device__ __forceinline__ float sum_x16_x32(float v) {
    auto a = __builtin_amdgcn_permlane16_swap(__float_as_uint(v), __float_as_uint(v), false, false); v = __uint_as_float(a[0]) + __uint_as_float(a[1]);
    auto b = __builtin_amdgcn_permlane32_swap(__float_as_uint(v), __float_as_uint(v), false, false); return __uint_as_float(b[0]) + __uint_as_float(b[1]);
}
__device__ __forceinline__ float partner_x32(float v, bool upper) {
    auto b = __builtin_amdgcn_permlane32_swap(__float_as_uint(v), __float_as_uint(v), false, false); return __uint_as_float(upper ? b[0] : b[1]);
}
template <int IS_KV> struct EpiHead {
    static constexpr bool PERM = true, AFTER_DRAIN = false;
    bf16_t* O; bf16_t* V; const float* gain; const bf16_t* proj; const bf16_t* krc; PG8_LAS float* X; int row0;
    __device__ __forceinline__ void operator()(const f32x4 (&acc)[2][2][4][2], const Unit& u, int wr, int wc, int fr, int fq) const {
        { const int l_ = fresh_lane(); fr = l_ & 15; fq = l_ >> 4; }
        const int rbase = row0 + u.pm * BM; const bool lat = rbase >= MC && rbase < M;
        PG8_LAS float* Xr = X + 2048;
        const int c8 = 32 * wc + 8 * fq;
        u32x4 krw[2][4];
        if (IS_KV && wc == 2) {
#pragma unroll
            for (int ai = 0; ai < 2; ++ai)
#pragma unroll
                for (int m = 0; m < 4; ++m) { const int row = rbase + ai * HALF + wr * 64 + m * 16 + fr;
                    krw[ai][m] = *(const u32x4*)(row < M ? proj + (size_t)row * NINP + C_KROPE + 8 * fq : krc + (size_t)(row - M) * 32 + 8 * fq); } }
#pragma unroll
        for (int ai = 0; ai < 2; ++ai)
#pragma unroll
            for (int m = 0; m < 4; ++m) { const int rl = ai * HALF + wr * 64 + m * 16 + fr;
#pragma unroll
                for (int bj = 0; bj < 2; ++bj) { const f32x4 v0 = acc[ai][bj][m][0], v1 = acc[ai][bj][m][1];
                    float ss = ((v0.x * v0.x + v0.y * v0.y) + (v0.z * v0.z + v0.w * v0.w)) + ((v1.x * v1.x + v1.y * v1.y) + (v1.z * v1.z + v1.w * v1.w));
                    ss = sum_x16_x32(ss);
                    if (fq == 0) X[(rl * 2 + bj) * 4 + wc] = ss; }
                if (IS_KV && wc == 2) { float kr[8]; unpack8(krw[ai][m], kr); float ss = 0.f;
#pragma unroll
                    for (int e = 0; e < 8; ++e) ss += kr[e] * kr[e];
                    ss = sum_x16_x32(ss);
                    if (fq == 0) Xr[rl] = ss; } }
        asm volatile("s_waitcnt lgkmcnt(0)" ::: "memory"); __builtin_amdgcn_s_barrier(); asm volatile("" ::: "memory");
        f32x4 g0 = (f32x4){0.f, 0.f, 0.f, 0.f}, g1 = g0;
        if (IS_KV ? wc <= 2 : wc < 3) { g0 = *(const f32x4*)(gain + c8); g1 = *(const f32x4*)(gain + c8 + 4); }
#pragma unroll
        for (int ai = 0; ai < 2; ++ai)
#pragma unroll
            for (int m = 0; m < 4; ++m) { const int rl = ai * HALF + wr * 64 + m * 16 + fr, row = rbase + rl;
                float cq[8], sq[8];
                if (wc == 2 && lat) { const int tpos = (row - MC) & (TL - 1); const float pos = (float)((fq & 1) ? (tpos & 63) : (tpos >> 6));
                    constexpr float RINV[8] = {0.15915494309189535f, 0.050329212104487035f, 0.015915494309189534f, 0.0050329212104487035f, 0.0015915494309189534f, 0.00050329212104487035f, 0.00015915494309189535f, 0.000050329212104487035f};
#pragma unroll
                    for (int e = 0; e < 8; ++e) { const float rev = __builtin_amdgcn_fractf(pos * RINV[e]); cq[e] = __builtin_amdgcn_cosf(rev); sq[e] = __builtin_amdgcn_sinf(rev); } }
#pragma unroll
                for (int bj = 0; bj < 2; ++bj) { const int hd = 2 * u.pn + bj;
                    const f32x4 xp = *(const PG8_LAS f32x4*)(X + (rl * 2 + bj) * 4);
                    const float tot = IS_KV ? (xp.x + xp.y) + Xr[rl] : (xp.x + xp.y) + (xp.z + xp.w);
                    const float rstd = __builtin_amdgcn_rsqf(tot * (1.0f / 96.0f) + EPS);
                    if (IS_KV && wc >= 2) {
                        const f32x4 v0 = acc[ai][bj][m][0], v1 = acc[ai][bj][m][1];
                        u32x4 w; w.x = cvt_pk_bf16(v0[0], v0[1]); w.y = cvt_pk_bf16(v0[2], v0[3]); w.z = cvt_pk_bf16(v1[0], v1[1]); w.w = cvt_pk_bf16(v1[2], v1[3]);
                        *(u32x4*)(V + (size_t)row * NKV + hd * 128 + 64 + (c8 - 64)) = w; }
                    if (IS_KV ? wc <= 2 : wc < 3) {
                        float v[8];
                        if (IS_KV && wc == 2) unpack8(krw[ai][m], v);
                        else {
#pragma unroll
                            for (int e = 0; e < 4; ++e) { v[e] = acc[ai][bj][m][0][e]; v[4 + e] = acc[ai][bj][m][1][e]; } }
#pragma unroll
                        for (int e = 0; e < 4; ++e) { v[e] *= rstd * g0[e]; v[4 + e] *= rstd * g1[e]; }
                        if (wc == 2) {
#pragma unroll
                            for (int e = 0; e < 8; ++e) { const float p = partner_x32(v[e], fq >= 2);
                                if (lat) v[e] = fq < 2 ? v[e] * cq[e] - p * sq[e] : p * sq[e] + v[e] * cq[e]; } }
                        u32x4 w; w.x = cvt_pk_bf16(v[0], v[1]); w.y = cvt_pk_bf16(v[2], v[3]); w.z = cvt_pk_bf16(v[4], v[5]); w.w = cvt_pk_bf16(v[6], v[7]);
                        *(u32x4*)(O + (size_t)row * NQ + hd * 96 + c8) = w; } } }
        asm volatile("s_waitcnt lgkmcnt(0)" ::: "memory"); __builtin_amdgcn_s_barrier(); asm volatile("" ::: "memory");
    }
};
struct EpiUp {
    static constexpr bool PERM = true, AFTER_DRAIN = false;
    bf16_t* O; const float* rowsq; const float* bias;
    __device__ __forceinline__ void operator()(const f32x4 (&acc)[2][2][4][2], const Unit& u, int wr, int wc, int fr, int fq) const {
        const int row0 = u.pm * BM + wr * 64 + fr, col0 = u.pn * BM + wc * 32 + 8 * fq;
        const int cond = u.pm < (MC / BM) ? 0 : 1 + (u.pm - MC / BM) / (TL / BM);
        const float* bp = bias + cond * FF + col0;
        f32x4 bv[2][2];
#pragma unroll
        for (int bj = 0; bj < 2; ++bj) { bv[bj][0] = *(const f32x4*)(bp + bj * HALF); bv[bj][1] = *(const f32x4*)(bp + bj * HALF + 4); }
#pragma unroll
        for (int ai = 0; ai < 2; ++ai)
#pragma unroll
            for (int m = 0; m < 4; ++m) { const int row = row0 + ai * HALF + m * 16; bf16_t* rowp = O + (size_t)row * FF + col0;
                const float rstd = 1.0f / sqrtf(__hip_atomic_load(rowsq + row, __ATOMIC_RELAXED, __HIP_MEMORY_SCOPE_AGENT) * (1.0f / DM) + EPS);
#pragma unroll
                for (int bj = 0; bj < 2; ++bj) { f32x4 v0 = acc[ai][bj][m][0] * rstd + bv[bj][0], v1 = acc[ai][bj][m][1] * rstd + bv[bj][1];
#pragma unroll
                    for (int e = 0; e < 4; ++e) { const float a = fmaxf(v0[e], 0.f), b = fmaxf(v1[e], 0.f); v0[e] = a * a; v1[e] = b * b; }
                    u32x4 w; w.x = cvt_pk_bf16(v0[0], v0[1]); w.y = cvt_pk_bf16(v0[2], v0[3]); w.z = cvt_pk_bf16(v1[0], v1[1]); w.w = cvt_pk_bf16(v1[2], v1[3]);
                    *(u32x4*)(rowp + bj * HALF) = w; } }
    }
};
struct EpiMix {
    static constexpr bool PERM = false, AFTER_DRAIN = false;
    const float* xa; const float* xb; float* x1; bf16_t* xg; const float* mod; const float* n2g; float* rowsq;
    __device__ __forceinline__ void operator()(const f32x4 (&acc)[2][2][4][2], const Unit& u, int wr, int wc, int fr, int fq) const {
        const int col0 = u.pn * BM + wc * 32 + 4 * fq;
        const int cond = u.pm < (MC / BM) ? 0 : 1 + (u.pm - MC / BM) / (TL / BM);
        const float* g = mod + cond * 6144 + 2048 + col0; const float* sc = mod + cond * 6144 + 4096 + col0; const float* ng = n2g + col0;
        f32x4 gv[2][2], gm[2][2];
#pragma unroll
        for (int bj = 0; bj < 2; ++bj)
#pragma unroll
            for (int n = 0; n < 2; ++n) { gv[bj][n] = *(const f32x4*)(g + bj * HALF + n * 16); gm[bj][n] = *(const f32x4*)(ng + bj * HALF + n * 16) * (*(const f32x4*)(sc + bj * HALF + n * 16) + 1.0f); }
#pragma unroll
        for (int ai = 0; ai < 2; ++ai)
#pragma unroll
            for (int m = 0; m < 4; ++m) { const int row = u.pm * BM + ai * HALF + wr * 64 + m * 16 + fr;
                const float* xr = (row < MC ? xa + (size_t)row * DM : xb + (size_t)(row - MC) * DM) + col0; float* orow = x1 + (size_t)row * DM + col0; bf16_t* grow = xg + (size_t)row * DM + col0;
                float ss = 0.f;
#pragma unroll
                for (int bj = 0; bj < 2; ++bj)
#pragma unroll
                    for (int n = 0; n < 2; ++n) { const f32x4 xv = *(const f32x4*)(xr + bj * HALF + n * 16); const f32x4 o = xv + gv[bj][n] * acc[ai][bj][m][n];
                        *(f32x4*)(orow + bj * HALF + n * 16) = o; ss += (o.x * o.x + o.y * o.y) + (o.z * o.z + o.w * o.w);
                        const f32x4 og = o * gm[bj][n]; u32x2 w; w.x = cvt_pk_bf16(og.x, og.y); w.y = cvt_pk_bf16(og.z, og.w); *(u32x2*)(grow + bj * HALF + n * 16) = w; }
                ss += __shfl_xor(ss, 16); ss += __shfl_xor(ss, 32);
                if (fq == 0) __hip_atomic_fetch_add(rowsq + row, ss, __ATOMIC_RELAXED, __HIP_MEMORY_SCOPE_AGENT); }
    }
};
struct EpiResGate {
    static constexpr bool PERM = false, AFTER_DRAIN = false;
    const float* xa; const float* xb; float* out; const float* mod; int goff;
    __device__ __forceinline__ void operator()(const f32x4 (&acc)[2][2][4][2], const Unit& u, int wr, int wc, int fr, int fq) const {
        const int col0 = u.pn * BM + wc * 32 + 4 * fq;
        const int cond = u.pm < (MC / BM) ? 0 : 1 + (u.pm - MC / BM) / (TL / BM);
        const float* g = mod + cond * 6144 + goff + col0;
        f32x4 gv[2][2];
#pragma unroll
        for (int bj = 0; bj < 2; ++bj)
#pragma unroll
            for (int n = 0; n < 2; ++n) gv[bj][n] = *(const f32x4*)(g + bj * HALF + n * 16);
#pragma unroll
        for (int ai = 0; ai < 2; ++ai)
#pragma unroll
            for (int m = 0; m < 4; ++m) { const int row = u.pm * BM + ai * HALF + wr * 64 + m * 16 + fr;
                const float* xr = (row < MC ? xa + (size_t)row * DM : xb + (size_t)(row - MC) * DM) + col0; float* orow = out + (size_t)row * DM + col0;
#pragma unroll
                for (int bj = 0; bj < 2; ++bj)
#pragma unroll
                    for (int n = 0; n < 2; ++n) { const f32x4 xv = *(const f32x4*)(xr + bj * HALF + n * 16); *(f32x4*)(orow + bj * HALF + n * 16) = xv + gv[bj][n] * acc[ai][bj][m][n]; } }
    }
};

template <class Epi, class Sched, bool ALIGN_EPI = false, bool SP2 = false>
__device__ __forceinline__ void gemm_phase(PG8_LAS unsigned char* lds, const Gemm g, const Sched& S, const Epi& E, const int wid  ) {
    const int lane = fresh_lane(), tid = wid * 64 + lane;
    const int wr = wid >> 2, wc = wid & 3, fr = lane & 15, fq = lane >> 4;
    const int K = g.K, nt = K / BK;
    unsigned voffA[2], voffB[2];
#pragma unroll
    for (int i = 0; i < 2; ++i) { int R, C; stage_rc(tid * 16 + i * 8192, R, C); const int Rb = Epi::PERM ? ((R & ~31) + perm32(R & 31)) : R;
        voffA[i] = (unsigned)(R * K + C) * 2u; voffB[i] = (unsigned)(Rb * K + C) * 2u; }
    const size_t kstep = (size_t)(BK * 2);
    const size_t hstep = (size_t)HALF * K * 2;
    const size_t tstep = 2 * hstep;
    const unsigned ldsw = (unsigned)wid * 1024u;
    const int aoff = lds_byte(wr * 64 + fr, fq * 8), boff = lds_byte(wc * 32 + fr, fq * 8);
#define PG8_SA(b, h) (((b) * 2 + (h)) * HTB)
#define PG8_SB(b, h) ((4 + (b) * 2 + (h)) * HTB)
#define PG8_STAGE(bufoff, gbase, voff) do { _Pragma("unroll") for (int _i = 0; _i < 2; ++_i) \
        __builtin_amdgcn_global_load_lds((const unsigned*)((const char*)(gbase) + (voff)[_i]), (PG8_LAS unsigned*)(lds + (bufoff) + ldsw + _i * 8192), 16, 0, 0); } while (0)
#define PG8_LDA(dst, b, h) do { _Pragma("unroll") for (int m = 0; m < 4; ++m) _Pragma("unroll") for (int k = 0; k < 2; ++k) dst[m][k] = *(const PG8_LAS bf16x8*)(lds + PG8_SA(b, h) + aoff + m * 2048 + k * 1024); } while (0)
#define PG8_LDB(dst, b, h) do { _Pragma("unroll") for (int n = 0; n < 2; ++n) _Pragma("unroll") for (int k = 0; k < 2; ++k) dst[n][k] = *(const PG8_LAS bf16x8*)(lds + PG8_SB(b, h) + boff + n * 2048 + k * 1024); } while (0)
#define PG8_MMA(ai, bj, At, Bt) do { __builtin_amdgcn_s_setprio(1); _Pragma("unroll") for (int m = 0; m < 4; ++m) _Pragma("unroll") for (int n = 0; n < 2; ++n) _Pragma("unroll") for (int k = 0; k < 2; ++k) \
        acc[ai][bj][m][n] = __builtin_amdgcn_mfma_f32_16x16x32_bf16(Bt[n][k], At[m][k], acc[ai][bj][m][n], 0, 0, 0); __builtin_amdgcn_s_setprio(0); } while (0)
#define PG8_WAIT_V(n) asm volatile("s_waitcnt vmcnt(" #n ")" ::: "memory")
#define PG8_WAIT_L(n) asm volatile("s_waitcnt lgkmcnt(" #n ")" ::: "memory")
#define PG8_BAR __builtin_amdgcn_s_barrier()
#define PG8_SCHED __builtin_amdgcn_sched_barrier(0)
    Unit cur, nxt; int ui = 0;
    if (!S.next(0, cur)) return;
    f32x4 acc[2][2][4][2];
#pragma unroll
    for (int a = 0; a < 2; ++a)
#pragma unroll
        for (int b = 0; b < 2; ++b)
#pragma unroll
            for (int m = 0; m < 4; ++m)
#pragma unroll
                for (int n = 0; n < 2; ++n) acc[a][b][m][n] = (f32x4){0.f, 0.f, 0.f, 0.f};
    bf16x8 At[4][2], B0[2][2], B1[2][2];
    const char* cA = (const char*)g.A + (size_t)cur.pm * tstep; const char* cB = (const char*)g.Bt + (size_t)cur.pn * tstep;
    S.a_ready(cur);
    if constexpr (SP2) {
        PG8_STAGE(PG8_SB(0, 0), cB, voffB); PG8_STAGE(PG8_SB(0, 1), cB + hstep, voffB); PG8_STAGE(PG8_SA(0, 0), cA, voffA); PG8_STAGE(PG8_SA(0, 1), cA + hstep, voffA);
        if (wr == 1) PG8_BAR;
        PG8_WAIT_V(2); PG8_BAR;
        PG8_STAGE(PG8_SB(1, 0), cB + kstep, voffB); PG8_STAGE(PG8_SA(1, 0), cA + kstep, voffA); PG8_STAGE(PG8_SB(1, 1), cB + hstep + kstep, voffB);
        PG8_WAIT_V(6); PG8_BAR;
    } else {
        PG8_STAGE(PG8_SB(0, 0), cB, voffB); PG8_STAGE(PG8_SA(0, 0), cA, voffA); PG8_STAGE(PG8_SB(0, 1), cB + hstep, voffB); PG8_STAGE(PG8_SA(0, 1), cA + hstep, voffA);
        if (wr == 1) PG8_BAR;
        PG8_WAIT_V(4); PG8_BAR;
        PG8_STAGE(PG8_SB(1, 0), cB + kstep, voffB); PG8_STAGE(PG8_SA(1, 0), cA + kstep, voffA); PG8_STAGE(PG8_SB(1, 1), cB + hstep + kstep, voffB);
        PG8_WAIT_V(6); PG8_BAR;
    }
    for (;;) {
        const bool has_next = S.next(ui + 1, nxt);
        const char* nA = has_next ? (const char*)g.A + (size_t)nxt.pm * tstep : cA; const char* nB = has_next ? (const char*)g.Bt + (size_t)nxt.pn * tstep : cB;
        for (int t = 0; t < nt; t += 2) {
            const bool last = (t == nt - 2);
            const char* a1 = cA + (size_t)(t + 1) * kstep;
            const char* a2 = last ? nA : cA + (size_t)(t + 2) * kstep; const char* b2 = last ? nB : cB + (size_t)(t + 2) * kstep;
            const char* a3 = a2 + kstep; const char* b3 = b2 + kstep;
            if (last && has_next) S.a_ready(nxt);
            if constexpr (SP2) {
            PG8_LDB(B0, 0, 0); PG8_LDB(B1, 0, 1); PG8_SCHED; PG8_LDA(At, 0, 0); PG8_STAGE(PG8_SA(1, 1), a1 + hstep, voffA);
            PG8_WAIT_V(8); PG8_WAIT_L(0); PG8_BAR; PG8_MMA(0, 0, At, B0); PG8_MMA(0, 1, At, B1); PG8_BAR; PG8_SCHED;
            PG8_LDA(At, 0, 1); PG8_STAGE(PG8_SB(0, 0), b2, voffB); PG8_STAGE(PG8_SB(0, 1), b2 + hstep, voffB); PG8_STAGE(PG8_SA(0, 0), a2, voffA);
            PG8_WAIT_V(8); PG8_WAIT_L(0); PG8_BAR; PG8_MMA(1, 0, At, B0); PG8_MMA(1, 1, At, B1); PG8_BAR; PG8_SCHED;
            PG8_LDB(B0, 1, 0); PG8_LDB(B1, 1, 1); PG8_SCHED; PG8_LDA(At, 1, 0); PG8_STAGE(PG8_SA(0, 1), a2 + hstep, voffA);
            PG8_WAIT_V(8); PG8_WAIT_L(0); PG8_BAR; PG8_MMA(0, 0, At, B0); PG8_MMA(0, 1, At, B1); PG8_BAR; PG8_SCHED;
            PG8_LDA(At, 1, 1); PG8_STAGE(PG8_SB(1, 0), b3, voffB); PG8_STAGE(PG8_SB(1, 1), b3 + hstep, voffB); PG8_STAGE(PG8_SA(1, 0), a3, voffA);
            PG8_WAIT_V(8); PG8_WAIT_L(0); PG8_BAR; PG8_MMA(1, 0, At, B0); PG8_MMA(1, 1, At, B1); PG8_BAR; PG8_SCHED;
            } else {
            PG8_LDB(B0, 0, 0); PG8_SCHED; PG8_LDA(At, 0, 0); PG8_STAGE(PG8_SA(1, 1), a1 + hstep, voffA);
            PG8_WAIT_L(8); PG8_BAR; PG8_WAIT_L(0); PG8_MMA(0, 0, At, B0); PG8_BAR; PG8_SCHED;
            PG8_LDB(B1, 0, 1); PG8_STAGE(PG8_SB(0, 0), b2, voffB);
            PG8_BAR; PG8_WAIT_L(0); PG8_MMA(0, 1, At, B1); PG8_BAR;
            PG8_LDA(At, 0, 1); PG8_STAGE(PG8_SA(0, 0), a2, voffA);
            PG8_BAR; PG8_WAIT_L(0); PG8_MMA(1, 0, At, B0); PG8_BAR; PG8_SCHED;
            PG8_STAGE(PG8_SB(0, 1), b2 + hstep, voffB);
            PG8_WAIT_V(6); PG8_BAR; PG8_MMA(1, 1, At, B1); PG8_BAR;
            PG8_LDB(B0, 1, 0); PG8_SCHED; PG8_LDA(At, 1, 0); PG8_STAGE(PG8_SA(0, 1), a2 + hstep, voffA);
            PG8_WAIT_L(8); PG8_BAR; PG8_WAIT_L(0); PG8_MMA(0, 0, At, B0); PG8_BAR; PG8_SCHED;
            PG8_LDB(B1, 1, 1); PG8_STAGE(PG8_SB(1, 0), b3, voffB);
            PG8_BAR; PG8_WAIT_L(0); PG8_MMA(0, 1, At, B1); PG8_BAR;
            PG8_LDA(At, 1, 1); PG8_STAGE(PG8_SA(1, 0), a3, voffA);
            PG8_BAR; PG8_WAIT_L(0); PG8_MMA(1, 0, At, B0); PG8_BAR; PG8_SCHED;
            PG8_STAGE(PG8_SB(1, 1), b3 + hstep, voffB);
            PG8_WAIT_V(6); PG8_BAR; PG8_MMA(1, 1, At, B1); PG8_BAR;
            }
        }
        if constexpr (ALIGN_EPI) { if (wr == 0) PG8_BAR; }
        if constexpr (!Epi::AFTER_DRAIN) { E(acc, cur, wr, wc, fr, fq); S.done(cur); }
        if (!has_next) break;
#pragma unroll
        for (int a = 0; a < 2; ++a)
#pragma unroll
            for (int b = 0; b < 2; ++b)
#pragma unroll
                for (int m = 0; m < 4; ++m)
#pragma unroll
                    for (int n = 0; n < 2; ++n) acc[a][b][m][n] = (f32x4){0.f, 0.f, 0.f, 0.f};
        cur = nxt; cA = nA; cB = nB; ++ui;
        if constexpr (ALIGN_EPI) { if (wr == 1) PG8_BAR; }
    }
    PG8_WAIT_V(0);
    if constexpr (!ALIGN_EPI) { if (wr == 0) PG8_BAR; }
    PG8_BAR;
    if constexpr (Epi::AFTER_DRAIN) { E.fused(acc, cur, wr, wc, fr, fq, lds, wid, lane); S.done(cur); }
#undef PG8_SA
#undef PG8_SB
#undef PG8_STAGE
#undef PG8_LDA
#undef PG8_LDB
#undef PG8_MMA
#undef PG8_WAIT_V
#undef PG8_WAIT_L
#undef PG8_BAR
#undef PG8_SCHED
}
}
#define XB_TMO      128
#define XB_XCNT(j)  (256  + 64 * (j))
#define XB_XSUB(j)  (1280 + 64 * (j))
#define XB_XGEN(j)  (2304 + 64 * (j))
#define XB_TOP      3328
#define XB_TOPGEN   3392
#define XCD_BAR_WORDS 3456
#define XB_SPIN_CAP (1u << 18)

__device__ __forceinline__ unsigned xb_ld(unsigned* p)              { return __hip_atomic_load(p, __ATOMIC_RELAXED, __HIP_MEMORY_SCOPE_AGENT); }
__device__ __forceinline__ unsigned xb_add(unsigned* p, unsigned v) { return __hip_atomic_fetch_add(p, v, __ATOMIC_RELAXED, __HIP_MEMORY_SCOPE_AGENT); }
__device__ __forceinline__ unsigned xb_xcc_id() { return (unsigned)__builtin_amdgcn_s_getreg((3 << 11) | 20) & 0xFu; }
#define XB_SPIN(cond, bar) do { unsigned _sp = 0; while (cond) { __builtin_amdgcn_s_sleep(1); \
    if ((++_sp & 255u) == 0u) { if (xb_ld(&(bar)[XB_TMO])) break; if (_sp > XB_SPIN_CAP) { atomicAdd(&(bar)[XB_TMO], 1u); break; } } } } while (0)

struct XcdBarrier {
    unsigned* bar; unsigned x; unsigned w;
    volatile LAS unsigned* st;
};

__device__ __forceinline__ XcdBarrier xcd_barrier_post(unsigned* bar, volatile LAS unsigned* st, unsigned wave) {
    XcdBarrier b; b.bar = bar; b.x = xb_xcc_id(); b.st = st; b.w = wave;
    if (wave == 0u && fresh_lane() == 0) (void)xb_add(&bar[XB_XCNT(b.x)], 1u);
    return b;
}
__device__ __forceinline__ void xcd_barrier_complete(unsigned* bar, unsigned x, unsigned& nloc, unsigned& nx) {
    const unsigned G = gridDim.x * gridDim.y * gridDim.z;
    unsigned sum, cnt, mine, sp = 0u;
    for (;;) {
        sum = 0u; cnt = 0u; mine = 0u;
#pragma unroll
        for (unsigned j = 0; j < 16; ++j) { const unsigned c = xb_ld(&bar[XB_XCNT(j)]); sum += c; cnt += (c > 0u) ? 1u : 0u; mine = (j == x) ? c : mine; }
        if (sum == G) break;
        __builtin_amdgcn_s_sleep(1);
        if ((++sp & 255u) == 0u) { if (xb_ld(&bar[XB_TMO])) break; if (sp > XB_SPIN_CAP) { atomicAdd(&bar[XB_TMO], 1u); break; } }
    }
    nloc = mine > 0u ? mine : 1u; nx = cnt > 0u ? cnt : 1u;
}

__device__ __forceinline__ void xcd_barrier(const XcdBarrier& b) {
    asm volatile("s_waitcnt vmcnt(0)" ::: "memory");
    __syncthreads();
    if (b.w == 0u && fresh_lane() == 0) {
        unsigned* bar = b.bar;
        __builtin_amdgcn_s_waitcnt(0);
        unsigned nloc = b.st[0], nx = b.st[1];
        if (nloc == 0u) { xcd_barrier_complete(bar, b.x, nloc, nx); b.st[0] = nloc; b.st[1] = nx; }
        const unsigned old = xb_add(&bar[XB_XSUB(b.x)], 1u);
        const unsigned gen = old / nloc;
        if (old + 1u == (gen + 1u) * nloc) {
            __builtin_amdgcn_fence(__ATOMIC_RELEASE, "agent");
            asm volatile("s_waitcnt vmcnt(0)" ::: "memory");
            const unsigned og = xb_add(&bar[XB_TOP], 1u);
            const unsigned tg = og / nx;
            if (og + 1u == (tg + 1u) * nx) xb_add(&bar[XB_TOPGEN], 1u);
            else XB_SPIN(xb_ld(&bar[XB_TOPGEN]) == tg, bar);
            __builtin_amdgcn_fence(__ATOMIC_ACQUIRE, "agent");
            xb_add(&bar[XB_XGEN(b.x)], 1u);
            asm volatile("s_waitcnt vmcnt(0)" ::: "memory");
        } else {
            XB_SPIN(xb_ld(&bar[XB_XGEN(b.x)]) == gen, bar);
            __builtin_amdgcn_fence(__ATOMIC_ACQUIRE, "agent");
            asm volatile("s_waitcnt vmcnt(0)" ::: "memory");
        }
    }
    __syncthreads();
}

constexpr int NWAVES = 8, NTHREADS = 512;
constexpr int RING_BYTES = 131072, LDS_BYTES = 163840, LDSCTL_OFF = LDS_BYTES - 1024, MISC_OFF = LDSCTL_OFF + 320;
static_assert(pg8::STAGE_BYTES <= RING_BYTES, "GEMM stage buffers fit the ring");
struct Args { const float* in[25]; float* out; unsigned char* ws; int ph_lo, ph_hi, li, pad; };
enum { I_XP = 0, I_XS, I_CCKV, I_CKROPE, I_SC, I_SN, I_SM, I_C, I_CCTX, I_N1G, I_N2G, I_WADA, I_BADA, I_WIN, I_GATEB, I_MNG, I_QLG, I_KVLG, I_WQ, I_WKV, I_QHG, I_KHG, I_WOUT, I_WUP, I_WDN };

template <int MODE> __device__ __forceinline__ int src_col(int n) {
    if (MODE == 0) return n;
    if (MODE == 2) return (n & 127) < 96 ? (n >> 7) * 96 + (n & 127) : -1;
    if (n < 2048) return n;
    if (n < C_GATE) return n + 16;
    if (n < NIN) return n - 672;
    return -1;
}
template <int MODE>
__device__ __forceinline__ void transpose_item(const float* W, int K, int Nsrc, int Ndst, bf16_t* WT, LAS float* scr, int item, int lane) {
    const int nblk = Ndst / 32, kb = item / nblk, nb = item % nblk, k0 = 64 * kb, n0 = 32 * nb;
    const int sc = src_col<MODE>(n0 + (lane & 31));
#pragma unroll 8
    for (int i = 0; i < 32; ++i) { const int kk = 2 * i + (lane >> 5); scr[kk * 33 + (lane & 31)] = sc >= 0 ? W[(size_t)(k0 + kk) * Nsrc + sc] : 0.f; }
    LDS_WAIT(); asm volatile("" ::: "memory");
    const int c = lane & 7;
#pragma unroll
    for (int j = 0; j < 4; ++j) { const int n = (lane >> 3) + 8 * j; const LAS float* s = scr + (8 * c) * 33 + n;
        u32x4 o; o.x = cvt_pk_bf16(s[0 * 33], s[1 * 33]); o.y = cvt_pk_bf16(s[2 * 33], s[3 * 33]); o.z = cvt_pk_bf16(s[4 * 33], s[5 * 33]); o.w = cvt_pk_bf16(s[6 * 33], s[7 * 33]);
        *(u32x4*)(WT + (size_t)(n0 + n) * K + k0 + 8 * c) = o; }
    LDS_WAIT(); asm volatile("" ::: "memory");
}
template <int MODE>
__device__ __forceinline__ void gemv5_item(const float* c_in, const float* c_ctx, const float* W, const float* b_ada, float* OUT, LAS unsigned char* lds, int item, int tid, int lane, int wave) {
    constexpr int NW_ = MODE == 0 ? 6144 : FF;
    LAS float* s_l = (LAS float*)lds;
    LAS float* red = (LAS float*)(lds + 20480);
    for (int idx = tid; idx < 5120; idx += NTHREADS) { const int c = idx >> 10, k = idx & 1023; if (MODE == 0) { const float v = c == 0 ? c_ctx[k] : c_in[(c - 1) * 1024 + k]; s_l[idx] = v / (1.f + __expf(-v)); } else s_l[idx] = c_in[c * 6144 + 3072 + k]; }
    __syncthreads();
    const int n0 = item * 64, kq = lane >> 4, cq = lane & 15, kbase = wave * 128;
    f32x4 acc[5];
#pragma unroll
    for (int c = 0; c < 5; ++c) acc[c] = (f32x4){0.f, 0.f, 0.f, 0.f};
    const float* wp = W + (size_t)(kbase + kq) * NW_ + n0 + cq * 4;
#pragma unroll 8
    for (int it = 0; it < 32; ++it) { const f32x4 w = *(const f32x4*)(wp + (size_t)it * 4 * NW_); const int k = kbase + it * 4 + kq;
#pragma unroll
        for (int c = 0; c < 5; ++c) acc[c] += s_l[c * 1024 + k] * w; }
#pragma unroll
    for (int c = 0; c < 5; ++c)
#pragma unroll
        for (int e = 0; e < 4; ++e) { float v = acc[c][e]; v += __shfl_xor(v, 16); v += __shfl_xor(v, 32); acc[c][e] = v; }
    if (kq == 0) {
#pragma unroll
        for (int c = 0; c < 5; ++c) *(LAS f32x4*)(red + (wave * 5 + c) * 64 + cq * 4) = acc[c]; }
    __syncthreads();
    if (tid < 320) { const int c = tid >> 6, n = tid & 63; float s = MODE == 0 ? b_ada[n0 + n] : 0.f;
#pragma unroll
        for (int w = 0; w < 8; ++w) s += red[(w * 5 + c) * 64 + n];
        OUT[c * NW_ + n0 + n] = s; }
    __syncthreads();
}
__device__ __forceinline__ void p0_prologue(const Args& a, LAS unsigned char* lds, int tid, int lane, int wave, int G) {
    unsigned char* ws = a.ws;
    const int bx = blockIdx.x;
    if (bx < 96) gemv5_item<0>(a.in[I_C], a.in[I_CCTX], a.in[I_WADA], a.in[I_BADA], (float*)(ws + WS_MOD), lds, bx, tid, lane, wave);
    LAS float* scr = (LAS float*)(lds + wave * 16384);
    const int gw = bx * NWAVES + wave, NGW = G * NWAVES;
    constexpr int I_1 = (DM / 64) * (NINP / 32), I_2 = (QLORA / 64) * (NQP / 32), I_3 = (KVLORA / 64) * (NKV / 32), I_4 = (DM / 64) * (DM / 32), I_5 = (DM / 64) * (FF / 32), I_6 = (FF / 64) * (DM / 32);
    constexpr int NITEMS = I_1 + I_2 + I_3 + I_4 + I_5 + I_6;
    for (int it = gw; it < NITEMS; it += NGW) {
        int r = it;
        if (r < I_1) { transpose_item<1>(a.in[I_WIN], DM, NIN, NINP, (bf16_t*)(ws + WS_WIN), scr, r, lane); continue; } r -= I_1;
        if (r < I_2) { transpose_item<2>(a.in[I_WQ], QLORA, NQ, NQP, (bf16_t*)(ws + WS_WQ), scr, r, lane); continue; } r -= I_2;
        if (r < I_3) { transpose_item<0>(a.in[I_WKV], KVLORA, NKV, NKV, (bf16_t*)(ws + WS_WKV), scr, r, lane); continue; } r -= I_3;
        if (r < I_4) { transpose_item<0>(a.in[I_WOUT], DM, DM, DM, (bf16_t*)(ws + WS_WO), scr, r, lane); continue; } r -= I_4;
        if (r < I_5) { transpose_item<0>(a.in[I_WUP], DM, FF, FF, (bf16_t*)(ws + WS_WUP), scr, r, lane); continue; } r -= I_5;
        transpose_item<0>(a.in[I_WDN], FF, DM, DM, (bf16_t*)(ws + WS_WDN), scr, r, lane);
    }
    for (int i = (bx * NTHREADS + tid); i < NBL * 256 * KVLORA / 8; i += (G * NTHREADS)) { const float* s = a.in[I_CCKV] + (size_t)i * 8; float f[8];
#pragma unroll
        for (int e = 0; e < 8; ++e) f[e] = s[e];
        *(u32x4*)((bf16_t*)(ws + WS_CKVC) + (size_t)i * 8) = pack8(f); }
    for (int i = (bx * NTHREADS + tid); i < NBL * 256 * 32 / 8; i += (G * NTHREADS)) { const float* s = a.in[I_CKROPE] + (size_t)i * 8; float f[8];
#pragma unroll
        for (int e = 0; e < 8; ++e) f[e] = s[e];
        *(u32x4*)((bf16_t*)(ws + WS_KRC) + (size_t)i * 8) = pack8(f); }
    float* rope = (float*)(ws + WS_ROPE);
    for (int idx = bx * NTHREADS + tid; idx < TL * 16; idx += G * NTHREADS) { const int t = idx >> 4, j = idx & 15;
        const float pos = (float)(j < 8 ? (t >> 6) : (t & 63)); const float inv = exp2f(-(float)(j & 7) * 0.125f * 13.287712379549449f);
        float rev = pos * inv * 0.15915494309189535f; rev -= floorf(rev);
        rope[t * 32 + j] = __builtin_amdgcn_cosf(rev); rope[t * 32 + 16 + j] = __builtin_amdgcn_sinf(rev); }
}

__device__ __forceinline__ int cond_of_row(int row) { return row < MC ? 0 : 1 + ((row - MC) >> 11); }
__device__ __forceinline__ void norm_rows(const float* xa, const float* xb, const float* g, const float* MOD, int sh_off, int sc_off, bf16_t* out, int gw, int NGW, int lane) {
    for (int rb = gw * 8; rb < M; rb += NGW * 8) {
        const int cond = cond_of_row(rb);
        const f32x4* g4 = (const f32x4*)g + lane; const f32x4* sc4 = (const f32x4*)(MOD + cond * 6144 + sc_off) + lane; const f32x4* sh4 = (const f32x4*)(MOD + cond * 6144 + sh_off) + lane;
        f32x4 gm[4], sv[4];
#pragma unroll
        for (int j = 0; j < 4; ++j) { gm[j] = g4[64 * j] * (sc4[64 * j] + 1.0f); sv[j] = sh4[64 * j]; }
        for (int r = 0; r < 8; r += 2) {
            f32x4 v[2][4];
#pragma unroll
            for (int q = 0; q < 2; ++q) { const int row = rb + r + q; const f32x4* xr = (const f32x4*)(row < MC ? xa + (size_t)row * DM : xb + (size_t)(row - MC) * DM) + lane;
#pragma unroll
                for (int j = 0; j < 4; ++j) v[q][j] = xr[64 * j]; }
#pragma unroll
            for (int q = 0; q < 2; ++q) { const int row = rb + r + q; float s = 0.f;
#pragma unroll
                for (int j = 0; j < 4; ++j) s += (v[q][j].x * v[q][j].x + v[q][j].y * v[q][j].y) + (v[q][j].z * v[q][j].z + v[q][j].w * v[q][j].w);
                const float rstd = 1.0f / sqrtf(wave_sum(s) * (1.0f / DM) + EPS);
                u32x2* o8 = (u32x2*)(out + (size_t)row * DM) + lane;
#pragma unroll
                for (int j = 0; j < 4; ++j) { const f32x4 o = v[q][j] * rstd * gm[j] + sv[j]; u32x2 w; w.x = cvt_pk_bf16(o.x, o.y); w.y = cvt_pk_bf16(o.z, o.w); o8[64 * j] = w; } } }
    }
}
__device__ __forceinline__ void p3_rows(const Args& a, int gw, int NGW, int lane, int gtid, int NGT) {
    unsigned char* ws = a.ws; const bf16_t* PROJ = (const bf16_t*)(ws + WS_PROJ); bf16_t* QN = (bf16_t*)(ws + WS_QN); bf16_t* CKVN = (bf16_t*)(ws + WS_CKVN);
    float qg[8]; f32x4 kg;
    { const int l8 = lane < 48 ? lane * 8 : 0;
#pragma unroll
      for (int e = 0; e < 8; ++e) qg[e] = a.in[I_QLG][l8 + e];
      kg = *(const f32x4*)(a.in[I_KVLG] + lane * 4); }
    for (int rb = gw * 8; rb < M; rb += NGW * 8)
        for (int r4 = 0; r4 < 8; r4 += 4) {
            u32x4 qw[4]; u32x2 kw4[4]; unsigned short krw[4];
#pragma unroll
            for (int q = 0; q < 4; ++q) { const bf16_t* pr = PROJ + (size_t)(rb + r4 + q) * NINP;
                qw[q] = (u32x4){0u, 0u, 0u, 0u}; if (lane < 48) qw[q] = *(const u32x4*)(pr + C_QLAT + lane * 8);
                kw4[q] = *(const u32x2*)(pr + C_KVLAT + lane * 4); krw[q] = pr[C_KROPE + (lane & 31)]; }
#pragma unroll
            for (int q = 0; q < 4; ++q) { const int row = rb + r4 + q;
                float qv[8]; unpack8(qw[q], qv);
                float s = 0.f;
#pragma unroll
                for (int e = 0; e < 8; ++e) s += qv[e] * qv[e];
                const float rq = 1.0f / sqrtf(wave_sum(s) * (1.0f / QLORA) + EPS);
                if (lane < 48) {
#pragma unroll
                    for (int e = 0; e < 8; ++e) qv[e] *= rq * qg[e];
                    *(u32x4*)(QN + (size_t)row * QLORA + lane * 8) = pack8(qv); }
                const u32x2 kw = kw4[q];
                f32x4 kv = (f32x4){bflo(kw.x), bfhi(kw.x), bflo(kw.y), bfhi(kw.y)};
                const float rk = 1.0f / sqrtf(wave_sum((kv.x * kv.x + kv.y * kv.y) + (kv.z * kv.z + kv.w * kv.w)) * (1.0f / KVLORA) + EPS);
                kv = kv * rk * kg;
                u32x2 ow; ow.x = cvt_pk_bf16(kv.x, kv.y); ow.y = cvt_pk_bf16(kv.z, kv.w);
                *(u32x2*)(CKVN + (size_t)row * KVLORA + lane * 4) = ow;
                if (row < MC) { *(f32x4*)(a.out + O_CKV + (size_t)row * KVLORA + lane * 4) = kv;
                    if (lane < 32) a.out[O_KROPE + (size_t)row * 32 + lane] = bf2f(krw[q]); } } }
}
__device__ __forceinline__ void p5_headnorm(const Args& a, int gw, int NGW, int lane) {
    unsigned char* ws = a.ws; bf16_t* QB = (bf16_t*)(ws + WS_Q); const bf16_t* KVR = (const bf16_t*)(ws + WS_KVRAW); bf16_t* KB = (bf16_t*)(ws + WS_K);
    const bf16_t* PROJ = (const bf16_t*)(ws + WS_PROJ); const float* rope = (const float*)(ws + WS_ROPE);
    const int half = lane >> 5, hh = (lane >> 2) & 7, q4 = lane & 3;
    const bf16_t* KRC = (const bf16_t*)(ws + WS_KRC);
    constexpr int NP5 = (M + MKV) / 2;
    for (int p0 = gw; p0 < NP5; p0 += 2 * NGW) {
        u32x4 raw[2][3];
#pragma unroll
        for (int q = 0; q < 2; ++q) { const int p = p0 + q * NGW; if (p < NP5) {
            const int idx = 2 * p + half; const bool isq = idx < M; const int kr = isq ? idx : idx - M;
            if (isq) { const bf16_t* src = QB + (size_t)kr * NQ + hh * 96 + q4 * 24;
#pragma unroll
                for (int i = 0; i < 3; ++i) raw[q][i] = *(const u32x4*)(src + 8 * i);
            } else {
#pragma unroll
                for (int i = 0; i < 3; ++i) { const int ci = 3 * q4 + i;
                    const bf16_t* src = ci < 8 ? KVR + (size_t)kr * NKV + hh * 128 + 8 * ci : (kr < M ? PROJ + (size_t)kr * NINP + C_KROPE + 8 * (ci - 8) : KRC + (size_t)(kr - M) * 32 + 8 * (ci - 8));
                    raw[q][i] = *(const u32x4*)src; } } } }
#pragma unroll
        for (int q = 0; q < 2; ++q) { const int p = p0 + q * NGW; if (p < NP5) {
            const int idx = 2 * p + half; const bool isq = idx < M; const int kr = isq ? idx : idx - M;
            float v[24];
#pragma unroll
            for (int i = 0; i < 3; ++i) unpack8(raw[q][i], v + 8 * i);
            const float* g = isq ? a.in[I_QHG] : a.in[I_KHG];
            bf16_t* dst = isq ? QB + (size_t)kr * NQ + hh * 96 + q4 * 24 : KB + (size_t)kr * NQ + hh * 96 + q4 * 24;
            const bool dorope = kr >= MC && kr < M;
            float s = 0.f;
#pragma unroll
            for (int i = 0; i < 24; ++i) s += v[i] * v[i];
            s += __shfl_xor(s, 1); s += __shfl_xor(s, 2);
            const float rstd = 1.0f / sqrtf(s * (1.0f / 96.0f) + EPS);
#pragma unroll
            for (int i = 0; i < 24; ++i) v[i] *= rstd * g[q4 * 24 + i];
            float snd[8], rcv[8];
#pragma unroll
            for (int j = 0; j < 8; ++j) { snd[j] = (q4 == 2) ? v[16 + j] : v[8 + j]; rcv[j] = __shfl_xor(snd[j], 1); }
            if (dorope && q4 >= 2) { const float* cs = rope + (size_t)((kr - MC) & (TL - 1)) * 32;
                if (q4 == 2) {
#pragma unroll
                    for (int j = 0; j < 8; ++j) v[16 + j] = v[16 + j] * cs[j] - rcv[j] * cs[16 + j];
                } else {
#pragma unroll
                    for (int j = 0; j < 8; ++j) { const float x1 = v[j], x2 = v[16 + j], c = cs[8 + j], sn = cs[24 + j]; v[j] = x1 * c - x2 * sn; v[16 + j] = x1 * sn + x2 * c;
                        v[8 + j] = rcv[j] * cs[16 + j] + v[8 + j] * cs[j]; }
                } }
#pragma unroll
            for (int i = 0; i < 3; ++i) *(u32x4*)(dst + 8 * i) = pack8(v + 8 * i);
        } }
    }
}
__device__ __forceinline__ void p6b_hm(const Args& a, int gw, int NGW, int lane) {
    unsigned char* ws = a.ws; const bf16_t* HF = (const bf16_t*)a.out; const bf16_t* HB = HF + (size_t)M * 512; const bf16_t* PROJ = (const bf16_t*)(ws + WS_PROJ); bf16_t* A2 = (bf16_t*)(ws + WS_H);
    float mg[8];
#pragma unroll
    for (int e = 0; e < 8; ++e) mg[e] = a.in[I_MNG][lane * 8 + e];
    for (int row0 = gw; row0 < M; row0 += 2 * NGW) {
        u32x4 rf[2], rb_[2], ro[2];
#pragma unroll
        for (int q = 0; q < 2; ++q) { const int row = row0 + q * NGW; if (row < M) {
            rf[q] = *(const u32x4*)(HF + (size_t)row * 512 + lane * 8); rb_[q] = *(const u32x4*)(HB + (size_t)row * 512 + lane * 8);
            ro[q] = *(const u32x4*)(PROJ + (size_t)row * NINP + C_MO + lane * 8); } }
#pragma unroll
        for (int q = 0; q < 2; ++q) { const int row = row0 + q * NGW; if (row < M) {
            float f[8], b[8], o[8]; unpack8(rf[q], f); unpack8(rb_[q], b); unpack8(ro[q], o);
            float s = 0.f;
#pragma unroll
            for (int e = 0; e < 8; ++e) { f[e] += b[e]; s += f[e] * f[e]; }
            s += __shfl_xor(s, 1); s += __shfl_xor(s, 2); s += __shfl_xor(s, 4); s += __shfl_xor(s, 8);
            const float rstd = 1.0f / sqrtf(s * (1.0f / 128.0f) + EPS);
#pragma unroll
            for (int e = 0; e < 8; ++e) f[e] = f[e] * rstd * mg[e] / (1.0f + __expf(-o[e]));
            *(u32x4*)(A2 + (size_t)row * DM + lane * 8) = pack8(f); } }
    }
}

namespace att {
constexpr int QBLK = 32, KVBLK = 64;
constexpr float SCALE = 0.10206207261596577f;
constexpr float THR = 8.f;
constexpr int SHM_V = 64 * 128 * 2, SHM_K = 64 * 256;
constexpr int LDS_ATT = 2 * SHM_V + 2 * SHM_K + 8 * 64 * 4;
#define KSWZ(row, colB) ((row) * 256 + ((colB) ^ (((row) & 7) << 4)))
__device__ __forceinline__ int crow(int r, int hi) { return (r & 3) + 8 * (r >> 2) + 4 * hi; }
__device__ __forceinline__ void partialSM(f32x16& p0, f32x16& p1, float& m_reg, float& mn, float& alpha) {
  constexpr float C = SCALE * 1.4426950408889634f;
  float pmax = p0[0];
#pragma unroll
  for (int r = 1; r < 16; ++r) pmax = fmaxf(pmax, p0[r]);
#pragma unroll
  for (int r = 0; r < 16; ++r) pmax = fmaxf(pmax, p1[r]);
  { auto rr = __builtin_amdgcn_permlane32_swap(__float_as_uint(pmax), __float_as_uint(pmax), false, false);
    pmax = fmaxf(__uint_as_float(rr[0]), __uint_as_float(rr[1])); }
  if (__builtin_expect(__all(pmax - m_reg <= THR / SCALE), 1)) { mn = m_reg; alpha = 1.f; }
  else { mn = fmaxf(m_reg, pmax); alpha = __builtin_amdgcn_exp2f((m_reg - mn) * C); m_reg = mn; }
  float mnC = -mn * C;
#pragma unroll
  for (int r = 0; r < 16; ++r) p0[r] = fmaf(p0[r], C, mnC);
#pragma unroll
  for (int r = 0; r < 16; ++r) p1[r] = fmaf(p1[r], C, mnC);
#pragma unroll
  for (int r = 0; r < 16; ++r) p0[r] = __builtin_amdgcn_exp2f(p0[r]);
}
__device__ __forceinline__ void finishSM(f32x16& p0, f32x16& p1, float alpha, float& l_reg, bf16x8& pa0, bf16x8& pa1, bf16x8& pa2, bf16x8& pa3) {
#pragma unroll
  for (int r = 0; r < 16; ++r) p1[r] = __builtin_amdgcn_exp2f(p1[r]);
  float ps = 0;
#pragma unroll
  for (int r = 0; r < 16; ++r) ps += p0[r];
#pragma unroll
  for (int r = 0; r < 16; ++r) ps += p1[r];
  { auto rr = __builtin_amdgcn_permlane32_swap(__float_as_uint(ps), __float_as_uint(ps), false, false);
    ps = __uint_as_float(rr[0]) + __uint_as_float(rr[1]); }
  l_reg = l_reg * alpha + ps;
#define PK4(P, BASE, OUT) do { unsigned a0 = cvt_pk_bf16(P[BASE + 0], P[BASE + 1]), a1 = cvt_pk_bf16(P[BASE + 2], P[BASE + 3]);   \
    unsigned b0 = cvt_pk_bf16(P[BASE + 4], P[BASE + 5]), b1 = cvt_pk_bf16(P[BASE + 6], P[BASE + 7]);                              \
    auto r0 = __builtin_amdgcn_permlane32_swap(a0, b0, false, false); auto r1 = __builtin_amdgcn_permlane32_swap(a1, b1, false, false); \
    u32x4 w = {r0[0], r1[0], r0[1], r1[1]}; OUT = *reinterpret_cast<bf16x8*>(&w); } while (0)
  PK4(p0, 0, pa0); PK4(p0, 8, pa1); PK4(p1, 0, pa2); PK4(p1, 8, pa3);
#undef PK4
}
__device__ __forceinline__ void qkt(f32x16& p0, f32x16& p1, const char* Ks, const bf16x8* qr, int r32, int hi) {
  p0 = f32x16{}; p1 = f32x16{};
#pragma unroll
  for (int d0 = 0; d0 < 6; ++d0) { int cb = (d0 * 16 + hi * 8) * 2;
    bf16x8 b0 = *reinterpret_cast<const bf16x8*>(Ks + KSWZ(r32, cb));
    bf16x8 b1 = *reinterpret_cast<const bf16x8*>(Ks + KSWZ(32 + r32, cb));
    p0 = __builtin_amdgcn_mfma_f32_32x32x16_bf16(b0, qr[d0], p0, 0, 0, 0);
    p1 = __builtin_amdgcn_mfma_f32_32x32x16_bf16(b1, qr[d0], p1, 0, 0, 0); }
}
__device__ __forceinline__ int v_st(int k, int c) { const int kk = (k & ~0xC) | ((k & 4) << 1) | ((k & 8) >> 1); return ((kk >> 3) * 4 + (c >> 5)) * 512 + ((kk & 7) * 32 + (c & 31)) * 2; }
__device__ __forceinline__ int v_rd_base(int lane) { return ((lane & 3) << 3) | (((lane >> 2) & 3) << 6) | (((lane >> 4) & 1) << 5) | (((lane >> 5) & 1) << 8); }
constexpr int v_rd_off(int d0, int ks, int half) { return d0 * 512 + ks * 4096 + half * 2048; }
template <int OFF> __device__ __forceinline__ s16x4 tr_read(int vb) {
  s16x4 r; asm volatile("ds_read_b64_tr_b16 %0, %1 offset:%2" : "=&v"(r) : "v"(vb), "i"(OFF) : "memory"); return r;
}
template <int D0> __device__ __forceinline__ void pv_one(f32x16& od, int vb, bf16x8 pa0, bf16x8 pa1, bf16x8 pa2, bf16x8 pa3) {
  const s16x4 l0 = tr_read<v_rd_off(D0, 0, 0)>(vb), h0 = tr_read<v_rd_off(D0, 0, 1)>(vb), l1 = tr_read<v_rd_off(D0, 1, 0)>(vb), h1 = tr_read<v_rd_off(D0, 1, 1)>(vb);
  const s16x4 l2 = tr_read<v_rd_off(D0, 2, 0)>(vb), h2 = tr_read<v_rd_off(D0, 2, 1)>(vb), l3 = tr_read<v_rd_off(D0, 3, 0)>(vb), h3 = tr_read<v_rd_off(D0, 3, 1)>(vb);
  asm volatile("s_waitcnt lgkmcnt(0)" ::: "memory"); SBAR();
  od = __builtin_amdgcn_mfma_f32_32x32x16_bf16(pa0, MK8(l0, h0), od, 0, 0, 0);
  od = __builtin_amdgcn_mfma_f32_32x32x16_bf16(pa1, MK8(l1, h1), od, 0, 0, 0);
  od = __builtin_amdgcn_mfma_f32_32x32x16_bf16(pa2, MK8(l2, h2), od, 0, 0, 0);
  od = __builtin_amdgcn_mfma_f32_32x32x16_bf16(pa3, MK8(l3, h3), od, 0, 0, 0);
}
__device__ __forceinline__ void pv_d0(f32x16* o, int vb, bf16x8 pa0, bf16x8 pa1, bf16x8 pa2, bf16x8 pa3) {
  pv_one<0>(o[0], vb, pa0, pa1, pa2, pa3); pv_one<1>(o[1], vb, pa0, pa1, pa2, pa3);
}
__device__ __forceinline__ void attn_unit(const bf16_t* __restrict__ Qg, const bf16_t* __restrict__ Kg, const bf16_t* __restrict__ Vg, bf16_t* __restrict__ Og,
                                          int qrow0, int h, int rowA, int ntA, int rowB, int NT, char* lds, const int wid) {
  const int lane = fresh_lane(), tid = wid * 64 + lane, r32 = lane & 31, hi = lane >> 5;
  char* V_lds = lds; char* K_lds = lds + 2 * SHM_V;
  float* ws = (float*)(lds + 2 * SHM_V + 2 * SHM_K) + wid * 64; float* li_l = ws; float* al_l = ws + 32;
  float m_reg = -1e30f, l_reg = 0; f32x16 o[2] = {}; bf16x8 qr[6];
  const bf16_t* Qw = Qg + (size_t)(qrow0 + wid * QBLK + r32) * NQ + h * 96 + hi * 8;
#pragma unroll
  for (int d0 = 0; d0 < 6; ++d0) qr[d0] = *reinterpret_cast<const bf16x8*>(Qw + d0 * 16);
  const int sr = tid >> 4, sc = (tid & 15) * 8, vst0 = v_st(sr, sc), vst1 = v_st(32 + sr, sc);
  const int vb0 = (int)(uintptr_t)V_lds + v_rd_base(lane);
  const bf16_t* Kh = Kg + h * 96 + sc; const bf16_t* Vh = Vg + h * 128 + 64 + sc;
  struct { bf16x8 vs0, vs1, ks0, ks1; } sr_[2];
#define TROW(j) ((j) < ntA ? rowA + (j) * KVBLK : rowB + ((j) - ntA) * KVBLK)
#define SLOAD(i, j) do { const size_t r0_ = (size_t)(TROW(j) + sr); \
    sr_[i].vs0 = *reinterpret_cast<const bf16x8*>(Vh + r0_ * NKV); sr_[i].vs1 = *reinterpret_cast<const bf16x8*>(Vh + (r0_ + 32) * NKV); \
    sr_[i].ks0 = *reinterpret_cast<const bf16x8*>(Kh + r0_ * NQ); sr_[i].ks1 = *reinterpret_cast<const bf16x8*>(Kh + (r0_ + 32) * NQ); } while (0)
#define SWRITE(b, i) do { *(bf16x8*)(V_lds + (b) * SHM_V + vst0) = sr_[i].vs0;          \
    *(bf16x8*)(V_lds + (b) * SHM_V + vst1) = sr_[i].vs1; int kc = sc * 2;               \
    *(bf16x8*)(K_lds + (b) * SHM_K + KSWZ(sr, kc)) = sr_[i].ks0;                       \
    *(bf16x8*)(K_lds + (b) * SHM_K + KSWZ(32 + sr, kc)) = sr_[i].ks1; } while (0)
#define SWAIT() asm volatile("s_waitcnt vmcnt(4)" ::: "memory")
#define RESC(a) do { if (__any((a) < 1.f)) { if (hi == 0) al_l[r32] = (a); asm volatile("s_waitcnt lgkmcnt(0)" ::: "memory"); \
    _Pragma("unroll") for (int d = 0; d < 2; ++d) _Pragma("unroll") for (int r = 0; r < 16; ++r) o[d][r] *= al_l[crow(r, hi)]; } } while (0)
  f32x16 pA0, pA1, pB0, pB1; float mnA, mnB, alA, alB; bf16x8 pa0, pa1, pa2, pa3;
  constexpr int SE = 0, SO = 1;
  SLOAD(SE, 0); asm volatile("s_waitcnt vmcnt(0)" ::: "memory"); SWRITE(0, SE); __syncthreads();
  qkt(pA0, pA1, K_lds, qr, r32, hi); partialSM(pA0, pA1, m_reg, mnA, alA);
  SLOAD(SO, 1); if (2 < NT) SLOAD(SE, 2);
  SWAIT(); SWRITE(1, SO); __syncthreads();
  for (int j = 1; j + 1 < NT; j += 2) {
    SBAR(); qkt(pB0, pB1, K_lds + SHM_K, qr, r32, hi);
    finishSM(pA0, pA1, alA, l_reg, pa0, pa1, pa2, pa3); SBAR();
    SLOAD(SO, j + 2); SBAR();
    pv_d0(o, vb0, pa0, pa1, pa2, pa3); partialSM(pB0, pB1, m_reg, mnB, alB);
    __syncthreads(); SWAIT(); SWRITE(0, SE);
    RESC(alB); __syncthreads();
    SBAR(); qkt(pA0, pA1, K_lds, qr, r32, hi);
    finishSM(pB0, pB1, alB, l_reg, pa0, pa1, pa2, pa3); SBAR();
    if (j + 3 < NT) SLOAD(SE, j + 3); SBAR();
    pv_d0(o, vb0 + SHM_V, pa0, pa1, pa2, pa3); partialSM(pA0, pA1, m_reg, mnA, alA);
    __syncthreads(); SWAIT(); SWRITE(1, SO);
    RESC(alA); __syncthreads();
  }
  SBAR(); qkt(pB0, pB1, K_lds + SHM_K, qr, r32, hi);
  finishSM(pA0, pA1, alA, l_reg, pa0, pa1, pa2, pa3); SBAR();
  pv_d0(o, vb0, pa0, pa1, pa2, pa3); partialSM(pB0, pB1, m_reg, mnB, alB);
  __syncthreads(); RESC(alB);
  finishSM(pB0, pB1, alB, l_reg, pa0, pa1, pa2, pa3); SBAR();
  pv_d0(o, vb0 + SHM_V, pa0, pa1, pa2, pa3);
  if (hi == 0) li_l[r32] = l_reg; asm volatile("s_waitcnt lgkmcnt(0)" ::: "memory");
  float rli[16];
#pragma unroll
  for (int r = 0; r < 16; ++r) rli[r] = __builtin_amdgcn_rcpf(li_l[crow(r, hi)]);
  bf16_t* Ow = Og + (size_t)(qrow0 + wid * QBLK) * DM + 512 + h * 64;
#pragma unroll
  for (int r = 0; r < 16; ++r) { const int orow = crow(r, hi);
#pragma unroll
    for (int d0 = 0; d0 < 2; ++d0) Ow[(size_t)orow * DM + d0 * 32 + r32] = (bf16_t)(cvt_pk_bf16(o[d0][r] * rli[r], 0.f) & 0xffffu); }
  __syncthreads();
#undef TROW
#undef SLOAD
#undef SWRITE
#undef SWAIT
#undef RESC
}
}

namespace ml {
constexpr int PQ = 272, PP = 144;
constexpr int OFF_Q = 0, OFF_K = 17408, OFF_V = 34816, OFF_W = 52224  , OFF_P = 69632, OFF_CB = 78848, OFF_N = 113664, OFF_QN = 114176, OFF_DP = 114432, OFF_NP = 114944,
              OFF_AA = 116992  , OFF_AC = 125184  , OFF_AB = 133376  , OFF_MC = 141568  , LDS_ML = 141824;
__device__ __forceinline__ f32x4 mfma16(bf16x8 a, bf16x8 b, f32x4 c) { return __builtin_amdgcn_mfma_f32_16x16x32_bf16(a, b, c, 0, 0, 0); }
__device__ __forceinline__ u32x2 pack4(f32x4 v) { u32x2 w; w.x = cvt_pk_bf16(v.x, v.y); w.y = cvt_pk_bf16(v.z, v.w); return w; }

__device__ __forceinline__ void mlstm_seq(const Args& a, LAS unsigned char* lds, int kind, int b, int h, int dir, const int wave) {
    const int lane = fresh_lane(), tid = wave * 64 + lane, g = lane >> 4, i = lane & 15;
    const int T = kind ? TL : TC, nc = T / 64, rowbase = kind ? MC + b * TL : b * TC;
    const bf16_t* PROJ = (const bf16_t*)(a.ws + WS_PROJ); const float* gates = (const float*)(a.ws + WS_GATES);
    bf16_t* Hout = (bf16_t*)a.out + (dir ? (size_t)M * 512 : 0);
#define ROWP(p) (rowbase + (dir ? T - 1 - (p) : (p)))
    LAS float* const sa = (LAS float*)(lds + OFF_AA); LAS float* const sA = (LAS float*)(lds + OFF_AC); LAS float* const sbb = (LAS float*)(lds + OFF_AB); LAS float* const smc = (LAS float*)(lds + OFF_MC);
    const int s0 = tid >> 4, c8 = tid & 15;
    u32x4 pq[2], pk[2], pv[2];
#define LOADCH(c) do { _Pragma("unroll") for (int e = 0; e < 2; ++e) { const bf16_t* rp = PROJ + (size_t)ROWP(64 * (c) + s0 + 32 * e) * NINP + h * 128 + c8 * 8; \
        pq[e] = *(const u32x4*)(rp + C_MQ); pk[e] = *(const u32x4*)(rp + C_MK); pv[e] = *(const u32x4*)(rp + C_MV); } } while (0)
    LOADCH(0);
    { const float gb_i = a.in[I_GATEB][dir * 8 + h], gb_f = a.in[I_GATEB][dir * 8 + 4 + h];
      for (int c = wave; c < nc; c += 8) { const float* gp = gates + (size_t)ROWP(64 * c + lane) * 16 + dir * 8 + h;
        const float gi = gp[0] + gb_i, gf = gp[4] + gb_f;
        const float lf = fminf(gf, 0.f) - log1pf(__expf(-fabsf(gf))); float bs = lf;
#pragma unroll
        for (int o = 1; o < 64; o <<= 1) { const float t = __shfl_up(bs, o); if (lane >= o) bs += t; }
        const float av = gi - bs; float A = av;
#pragma unroll
        for (int o = 1; o < 64; o <<= 1) { const float t = __shfl_up(A, o); if (lane >= o) A = fmaxf(A, t); }
        sa[64 * c + lane] = av; sA[64 * c + lane] = A; sbb[64 * c + lane] = bs; } }
    const int v0 = wave * 16;
    f32x4 accC[8];
    const size_t sidx = (size_t)((b * 2 + dir) * 4 + h);
    LAS float* nl = (LAS float*)(lds + OFF_N);
    if (kind) { const float* C0 = a.in[I_SC] + sidx * 16384;
#pragma unroll
        for (int kb = 0; kb < 8; ++kb) accC[kb] = *(const f32x4*)(C0 + (size_t)(16 * kb + i) * 128 + v0 + 4 * g);
        if (tid < 128) nl[tid] = a.in[I_SN][sidx * 128 + tid];
    } else {
#pragma unroll
        for (int kb = 0; kb < 8; ++kb) accC[kb] = (f32x4){0.f, 0.f, 0.f, 0.f};
        if (tid < 128) nl[tid] = 0.f;
    }
#pragma unroll
    for (int kb = 0; kb < 8; ++kb) *(LAS u32x2*)(lds + OFF_CB + (16 * kb + i) * PQ + (v0 + 4 * g) * 2) = pack4(accC[kb]);
    __syncthreads();
    f32x4 accN = (f32x4){0.f, 0.f, 0.f, 0.f}; if (g == 0) accN[0] = nl[16 * wave + i];
    if (wave == 0) { const int cc = lane < nc ? lane : 0; const float b63 = sbb[64 * cc + 63], A63 = sA[64 * cc + 63]; float m = kind ? a.in[I_SM][sidx] : 0.f;
        for (int c = 0; c < nc; ++c) { if (lane == c) smc[c] = m; m = __shfl(b63, c) + fmaxf(m, __shfl(A63, c)); }
        if (lane == 0) smc[nc] = m; }
    __syncthreads();
    for (int c = 0; c < nc; ++c) {
        const float m_c = smc[c]; const float M63 = fmaxf(m_c, sA[64 * c + 63]); const float decay = __expf(m_c - M63);
#pragma unroll
        for (int e = 0; e < 2; ++e) { const int off = (s0 + 32 * e) * PQ + c8 * 16;
            *(LAS u32x4*)(lds + OFF_Q + off) = pq[e]; *(LAS u32x4*)(lds + OFF_K + off) = pk[e]; *(LAS u32x4*)(lds + OFF_V + off) = pv[e]; }
        if (tid < 64) ((LAS float*)(lds + OFF_W))[tid] = __expf(sa[64 * c + tid] - M63);
        __syncthreads();
        if (c + 1 < nc) LOADCH(c + 1);
        {
            const int tb = wave >> 1, t = 16 * tb + i; const float Mt = fmaxf(m_c, sA[64 * c + t]); float rs = 0.f;
            bf16x8 qf[4], kf0[4], kf1[4];
#pragma unroll
            for (int kk = 0; kk < 4; ++kk) { qf[kk] = *(const LAS bf16x8*)(lds + OFF_Q + t * PQ + (32 * kk + 8 * g) * 2);
                kf0[kk] = *(const LAS bf16x8*)(lds + OFF_K + (32 * (wave & 1) + i) * PQ + (32 * kk + 8 * g) * 2);
                kf1[kk] = *(const LAS bf16x8*)(lds + OFF_K + (32 * (wave & 1) + 16 + i) * PQ + (32 * kk + 8 * g) * 2); }
            const int tq = tid >> 3, part = tid & 7; float qn_q[16];
            unpack8(*(const LAS u32x4*)(lds + OFF_Q + tq * PQ + part * 32), qn_q); unpack8(*(const LAS u32x4*)(lds + OFF_Q + tq * PQ + part * 32 + 16), qn_q + 8);
            f32x4 acc0 = (f32x4){0.f, 0.f, 0.f, 0.f}, acc1 = (f32x4){0.f, 0.f, 0.f, 0.f};
#pragma unroll
            for (int kk = 0; kk < 4; ++kk) { acc0 = mfma16(kf0[kk], qf[kk], acc0); acc1 = mfma16(kf1[kk], qf[kk], acc1); }
            float d = 0.f;
#pragma unroll
            for (int x = 0; x < 16; ++x) d += qn_q[x] * nl[part * 16 + x];
            d += __shfl_xor(d, 1); d += __shfl_xor(d, 2); d += __shfl_xor(d, 4);
            if (part == 0) ((LAS float*)(lds + OFF_QN))[tq] = d;
#pragma unroll
            for (int u = 0; u < 2; ++u) { const int sblk = 2 * (wave & 1) + u; const f32x4 acc = u ? acc1 : acc0; f32x4 p;
#pragma unroll
                for (int r = 0; r < 4; ++r) { const int s = 16 * sblk + 4 * g + r; const float wv = __expf(sa[64 * c + s] - Mt); p[r] = (s <= t) ? acc[r] * wv : 0.f; rs += p[r]; }
                *(LAS u32x2*)(lds + OFF_P + t * PP + (16 * sblk + 4 * g) * 2) = pack4(p); }
            rs += __shfl_xor(rs, 16); rs += __shfl_xor(rs, 32);
            if (g == 0) ((LAS float*)(lds + OFF_DP))[(wave & 1) * 64 + t] = rs;
        }
        __syncthreads();
        {
            const LAS unsigned char* vtr = lds + OFF_V + (8 * g + (i >> 2)) * PQ + (v0 + 4 * (i & 3)) * 2;
            const LAS unsigned char* ctr = lds + OFF_CB + (8 * g + (i >> 2)) * PQ + (v0 + 4 * (i & 3)) * 2;
            bf16x8 vfr[2], pf[2][4], cf[4];
            f32x4 w8[2][2];
#pragma unroll
            for (int kk = 0; kk < 2; ++kk) { const s16x4 lo = tr16(vtr + 32 * kk * PQ), hi_ = tr16(vtr + (32 * kk + 4) * PQ); vfr[kk] = MK8(lo, hi_);
                w8[kk][0] = *(const LAS f32x4*)(lds + OFF_W + (32 * kk + 8 * g) * 4); w8[kk][1] = *(const LAS f32x4*)(lds + OFF_W + (32 * kk + 8 * g + 4) * 4);
#pragma unroll
                for (int tb = 0; tb < 4; ++tb) pf[kk][tb] = *(const LAS bf16x8*)(lds + OFF_P + (16 * tb + i) * PP + (32 * kk + 8 * g) * 2); }
#pragma unroll
            for (int kk = 0; kk < 4; ++kk) { const s16x4 lo = tr16(ctr + 32 * kk * PQ), hi_ = tr16(ctr + (32 * kk + 4) * PQ); cf[kk] = MK8(lo, hi_); }
            f32x4 intra[4], inter[4];
#pragma unroll
            for (int tb = 0; tb < 4; ++tb) { intra[tb] = (f32x4){0.f, 0.f, 0.f, 0.f}; inter[tb] = (f32x4){0.f, 0.f, 0.f, 0.f}; }
#pragma unroll
            for (int kk = 0; kk < 2; ++kk)
#pragma unroll
                for (int tb = 0; tb < 4; ++tb) intra[tb] = mfma16(vfr[kk], pf[kk][tb], intra[tb]);
#pragma unroll
            for (int kk = 0; kk < 4; ++kk) { bf16x8 qf[4];
#pragma unroll
                for (int tb = 0; tb < 4; ++tb) qf[tb] = *(const LAS bf16x8*)(lds + OFF_Q + (16 * tb + i) * PQ + (32 * kk + 8 * g) * 2);
#pragma unroll
                for (int tb = 0; tb < 4; ++tb) inter[tb] = mfma16(cf[kk], qf[tb], inter[tb]); }
            bf16x8 vfw[2], onw[2];
#pragma unroll
            for (int kk = 0; kk < 2; ++kk) { float vf[8]; unpack8(__builtin_bit_cast(u32x4, vfr[kk]), vf); float wv[8];
#pragma unroll
                for (int x = 0; x < 4; ++x) { wv[x] = w8[kk][0][x]; wv[4 + x] = w8[kk][1][x]; }
#pragma unroll
                for (int x = 0; x < 8; ++x) vf[x] *= wv[x];
                vfw[kk] = __builtin_bit_cast(bf16x8, pack8(vf));
                u32x4 ow = pack8(wv); if (i != 0) ow = (u32x4){0u, 0u, 0u, 0u}; onw[kk] = __builtin_bit_cast(bf16x8, ow); }
#pragma unroll
            for (int kb = 0; kb < 8; ++kb) { accC[kb] = accC[kb] * decay; bf16x8 kfr[2];
#pragma unroll
                for (int kk = 0; kk < 2; ++kk) { const LAS unsigned char* kp = lds + OFF_K + (32 * kk + 8 * g + (i >> 2)) * PQ + (16 * kb + 4 * (i & 3)) * 2;
                    const s16x4 lo = tr16(kp), hi_ = tr16(kp + 4 * PQ); kfr[kk] = MK8(lo, hi_); }
                accC[kb] = mfma16(vfw[0], kfr[0], accC[kb]); accC[kb] = mfma16(vfw[1], kfr[1], accC[kb]);
                if (kb == wave) { accN = accN * decay; accN = mfma16(onw[0], kfr[0], accN); accN = mfma16(onw[1], kfr[1], accN); } }
            const LAS float* dp = (const LAS float*)(lds + OFF_DP); const LAS float* qn = (const LAS float*)(lds + OFF_QN);
#pragma unroll
            for (int tb = 0; tb < 4; ++tb) { const int t = 16 * tb + i; const float Mt = fmaxf(m_c, sA[64 * c + t]); const float wi = __expf(m_c - Mt);
                const float den = dp[t] + dp[64 + t] + wi * qn[t]; const float inv = 1.0f / fmaxf(fabsf(den), __expf(-(sbb[64 * c + t] + Mt)));
                const f32x4 hv = (intra[tb] + inter[tb] * wi) * inv;
                *(u32x2*)(Hout + (size_t)ROWP(64 * c + t) * 512 + h * 128 + v0 + 4 * g) = pack4(hv); }
        }
        __syncthreads();
#pragma unroll
        for (int kb = 0; kb < 8; ++kb) *(LAS u32x2*)(lds + OFF_CB + (16 * kb + i) * PQ + (v0 + 4 * g) * 2) = pack4(accC[kb]);
        if (g == 0) nl[16 * wave + i] = accN[0];
    }
    if (kind == 0) {
        float* oC = a.out + O_C + sidx * 16384;
#pragma unroll
        for (int kb = 0; kb < 8; ++kb) *(f32x4*)(oC + (size_t)(16 * kb + i) * 128 + v0 + 4 * g) = accC[kb];
        if (g == 0) a.out[O_N + sidx * 128 + 16 * wave + i] = accN[0];
        if (tid == 0) a.out[O_M + sidx] = smc[nc];
    }
    __syncthreads();
#undef ROWP
#undef LOADCH
}
}

constexpr int NPH = 10;
#ifndef LAUNCH_LIST
#define LAUNCH_LIST {0, 10}
#endif
constexpr int Q_NITEMS = 800;

__global__ void __launch_bounds__(NTHREADS, 2) fwd_megakernel(Args args) {
    extern __shared__ __attribute__((aligned(16))) unsigned char lds_raw[];
    LAS unsigned char* lds = (LAS unsigned char*)lds_raw;
    volatile LAS unsigned* MISC = (volatile LAS unsigned*)(lds + MISC_OFF);
    const int wave = __builtin_amdgcn_readfirstlane(threadIdx.x >> 6);
#define tid (wave * 64 + lane)
    const int G = gridDim.x, bx = blockIdx.x;
    unsigned char* ws = args.ws;
    unsigned* ctl = (unsigned*)(ws + WS_CTL);
    { const int lane = fresh_lane();
    for (int u = tid; u < (LDS_BYTES - LDSCTL_OFF) / 4; u += NTHREADS) ((LAS unsigned*)(lds + LDSCTL_OFF))[u] = 0u; }
    __syncthreads();
    XcdBarrier bar = xcd_barrier_post(ctl + CW_BAR + args.li * XCD_BAR_WORDS, MISC + 8, (unsigned)wave);
    const int lo = args.ph_lo, hi = args.ph_hi;
#define IN(k) (lo <= (k) && (k) < hi)
#define SEAM(k) do { if (IN(k) && IN((k) + 1)) xcd_barrier(bar); } while (0)
    const int gw = bx * NWAVES + wave, NGW = G * NWAVES;
    bf16_t* const HBUF = (bf16_t*)(ws + WS_H);
    float* const MOD = (float*)(ws + WS_MOD);
    float* const X1 = (float*)(ws + WS_X1);

    if (IN(0)) { const int lane = fresh_lane(); p0_prologue(args, lds, tid, lane, wave, G); SEAM(0); }
    if (IN(1)) { const int lane = fresh_lane(); norm_rows(args.in[I_XP], args.in[I_XS], args.in[I_N1G], MOD, 0, 1024, HBUF, gw, NGW, lane); SEAM(1); }
    if (IN(2)) {
        pg8::Gemm g{HBUF, (const bf16_t*)(ws + WS_WIN), M, NINP, DM}; pg8::StaticOrder S; S.init(M, NINP, G, bx);
        pg8::EpiProj E{(bf16_t*)(ws + WS_PROJ), (float*)(ws + WS_GATES)};
        pg8::gemm_phase<pg8::EpiProj, pg8::StaticOrder, true, true>(lds, g, S, E, wave);
        for (int it = (G == 256) ? (bx >= 192 ? bx - 192 : 64) : bx; it < 64; it += G) { const int lane = fresh_lane(); gemv5_item<1>(MOD, nullptr, args.in[I_WUP], nullptr, (float*)(ws + WS_BIAS2), lds, it, tid, lane, wave); }
        if (G == 256 && bx >= 192 && bx < 208) {
            int kkv = KVLORA; asm volatile("" : "+s"(kkv));
            pg8::Gemm g{(const bf16_t*)(ws + WS_CKVC), (const bf16_t*)(ws + WS_WKV), NBL * 256, NKV, kkv}; pg8::StaticOrder S; S.init(NBL * 256, NKV, 16, bx - 192);
            pg8::EpiHead<1> E{(bf16_t*)(ws + WS_K), (bf16_t*)(ws + WS_KVRAW), args.in[I_KHG], (const bf16_t*)(ws + WS_PROJ), (const bf16_t*)(ws + WS_KRC), (pg8::PG8_LAS_float_ptr)(lds + RING_BYTES), M};
            pg8::gemm_phase<pg8::EpiHead<1>, pg8::StaticOrder, true, true>(lds, g, S, E, wave); }
        SEAM(2);
    }
    if (IN(3)) { const int lane = fresh_lane(); p3_rows(args, gw, NGW, lane, bx * NTHREADS + tid, G * NTHREADS); SEAM(3); }
    if (IN(4)) {
        pg8::PG8_LAS_float_ptr Xl = (pg8::PG8_LAS_float_ptr)(lds + RING_BYTES);
        int kq = QLORA, kkv = KVLORA; asm volatile("" : "+s"(kq), "+s"(kkv));
        { pg8::Gemm g{(const bf16_t*)(ws + WS_QN), (const bf16_t*)(ws + WS_WQ), M, NQP, kq}; pg8::StaticOrder S; S.init(M, NQP, G, bx);
          pg8::EpiHead<0> E{(bf16_t*)(ws + WS_Q), nullptr, args.in[I_QHG], nullptr, nullptr, Xl, 0};
          pg8::gemm_phase<pg8::EpiHead<0>, pg8::StaticOrder, true, true>(lds, g, S, E, wave); }
        { pg8::Gemm g{(const bf16_t*)(ws + WS_CKVN), (const bf16_t*)(ws + WS_WKV), M, NKV, kkv}; pg8::StaticOrder S; S.init(M, NKV, G, bx);
          pg8::EpiHead<1> E{(bf16_t*)(ws + WS_K), (bf16_t*)(ws + WS_KVRAW), args.in[I_KHG], (const bf16_t*)(ws + WS_PROJ), (const bf16_t*)(ws + WS_KRC), Xl, 0};
          pg8::gemm_phase<pg8::EpiHead<1>, pg8::StaticOrder, true, true>(lds, g, S, E, wave); }
        if (G != 256) {
            pg8::Gemm g{(const bf16_t*)(ws + WS_CKVC), (const bf16_t*)(ws + WS_WKV), NBL * 256, NKV, kkv}; pg8::StaticOrder S; S.init(NBL * 256, NKV, G, bx);
            pg8::EpiHead<1> E{(bf16_t*)(ws + WS_K), (bf16_t*)(ws + WS_KVRAW), args.in[I_KHG], (const bf16_t*)(ws + WS_PROJ), (const bf16_t*)(ws + WS_KRC), Xl, M};
            pg8::gemm_phase<pg8::EpiHead<1>, pg8::StaticOrder, true, true>(lds, g, S, E, wave); }
        SEAM(4);
    }
    if (IN(5)) {
        volatile LAS int* qslot = (volatile LAS int*)(lds + MISC_OFF + 64);
        for (;;) {
            __syncthreads();
            if (wave == 0 && fresh_lane() == 0) *qslot = (int)__hip_atomic_fetch_add(ctl + CW_QUEUE + 64 * args.li, 1u, __ATOMIC_RELAXED, __HIP_MEMORY_SCOPE_AGENT);
            __syncthreads();
            const int idx = __builtin_amdgcn_readfirstlane(*qslot);
            if (idx >= Q_NITEMS) break;
#ifdef PROBE_QLO
            if (args.li == 1 && (idx < PROBE_QLO || idx >= PROBE_QHI)) continue;
#endif
            if (idx < 32) ml::mlstm_seq(args, lds, 1, idx >> 3, (idx >> 1) & 3, idx & 1, wave);
            else if (idx < 288) { const int j = idx - 32, b = j >> 6, h = (j >> 3) & 7, qb = j & 7;
                att::attn_unit((const bf16_t*)(ws + WS_Q), (const bf16_t*)(ws + WS_K), (const bf16_t*)(ws + WS_KVRAW), HBUF, MC + b * TL + qb * 256, h, MC + b * TL, 32, M + b * 256, 36, (char*)lds_raw, wave); }
            else if (idx < 544) { const int j = idx - 288; ml::mlstm_seq(args, lds, 0, j >> 3, (j >> 1) & 3, j & 1, wave); }
            else { const int j = idx - 544, b = j >> 3, h = j & 7;
                att::attn_unit((const bf16_t*)(ws + WS_Q), (const bf16_t*)(ws + WS_K), (const bf16_t*)(ws + WS_KVRAW), HBUF, b * TC, h, b * TC, 4, 0, 4, (char*)lds_raw, wave); }
        }
        SEAM(5);
    }
    if (IN(6)) { const int lane = fresh_lane(); p6b_hm(args, gw, NGW, lane); SEAM(6); }
    if (IN(7)) {
        pg8::Gemm g{HBUF, (const bf16_t*)(ws + WS_WO), M, DM, DM}; pg8::StaticOrder S; S.init(M, DM, G, bx);
        pg8::EpiMix E{args.in[I_XP], args.in[I_XS], X1, (bf16_t*)(ws + WS_XG), MOD, args.in[I_N2G], (float*)(ctl + CW_ROWSQ)};
        pg8::gemm_phase<pg8::EpiMix, pg8::StaticOrder, true, true>(lds, g, S, E, wave);
        SEAM(7);
    }
    if (IN(8)) {
        pg8::Gemm g{(const bf16_t*)(ws + WS_XG), (const bf16_t*)(ws + WS_WUP), M, FF, DM}; pg8::StaticOrder S; S.init(M, FF, G, bx);
        pg8::EpiUp E{(bf16_t*)(ws + WS_U), (const float*)(ctl + CW_ROWSQ), (const float*)(ws + WS_BIAS2)};
        pg8::gemm_phase<pg8::EpiUp, pg8::StaticOrder, true, true>(lds, g, S, E, wave);
        SEAM(8);
    }
    if (IN(9)) {
        pg8::Gemm g{(const bf16_t*)(ws + WS_U), (const bf16_t*)(ws + WS_WDN), M, DM, FF}; pg8::StaticOrder S; S.init(M, DM, G, bx);
        pg8::EpiResGate E{X1, X1 + (size_t)MC * DM, args.out, MOD, 5120};
        pg8::gemm_phase<pg8::EpiResGate, pg8::StaticOrder, true, true>(lds, g, S, E, wave);
    }
static_assert(ml::LDS_ML <= LDSCTL_OFF && att::LDS_ATT <= LDSCTL_OFF, "phase scratch below the LDS control words");
#undef IN
#undef SEAM
#undef tid
}

extern "C" void kernel_launch(void* const* d_in, const int* in_sizes, int n_in, void* d_out, int out_size, void* d_ws, size_t ws_size, hipStream_t stream) {
    static int grid = 0;
    if (grid == 0) {
        if (n_in != 25 || in_sizes[0] != MC * DM || in_sizes[1] != ML * DM || out_size != (int)O_END || ws_size < WS_END) {
            fprintf(stderr, "kernel_launch: unexpected shapes: n_in %d in0 %d in1 %d out %d ws %zu (need >= %zu); nothing launched\n", n_in, n_in > 0 ? in_sizes[0] : -1, n_in > 1 ? in_sizes[1] : -1, out_size, ws_size, (size_t)WS_END); grid = -1; return; }
        int dev = 0, cus = 0, per_cu = 0;
        if (hipGetDevice(&dev) != hipSuccess || hipDeviceGetAttribute(&cus, hipDeviceAttributeMultiprocessorCount, dev) != hipSuccess) { fprintf(stderr, "kernel_launch: device query failed\n"); grid = -1; return; }
        if (hipFuncSetAttribute((const void*)fwd_megakernel, hipFuncAttributeMaxDynamicSharedMemorySize, LDS_BYTES) != hipSuccess) { fprintf(stderr, "kernel_launch: hipFuncSetAttribute failed\n"); grid = -1; return; }
        if (hipOccupancyMaxActiveBlocksPerMultiprocessor(&per_cu, (const void*)fwd_megakernel, NTHREADS, LDS_BYTES) != hipSuccess || per_cu < 1) {
            fprintf(stderr, "kernel_launch: occupancy query reports %d workgroups per CU; nothing launched\n", per_cu); (void)hipGetLastError(); grid = -1; return; }
        grid = cus;
    }
    if (grid < 0) return;
    if (hipMemsetAsync((char*)d_ws + WS_CTL, 0, CTL_ZERO_BYTES, stream) != hipSuccess) { fprintf(stderr, "kernel_launch: memset failed\n"); return; }
    Args a{};
    for (int i = 0; i < 25; ++i) a.in[i] = (const float*)d_in[i];
    a.out = (float*)d_out; a.ws = (unsigned char*)d_ws;
    static const int plist[] = LAUNCH_LIST;
    for (int li = 0; li < (int)(sizeof(plist) / sizeof(int)) / 2; ++li) {
        a.ph_lo = plist[2 * li]; a.ph_hi = plist[2 * li + 1]; a.li = li;
        hipLaunchKernelGGL(fwd_megakernel, dim3(grid), dim3(NTHREADS), LDS_BYTES, stream, a);
        const hipError_t le = hipPeekAtLastError();
        if (le != hipSuccess) { fprintf(stderr, "kernel_launch: launch %d failed: %s\n", li, hipGetErrorName(le)); break; }
    }
}
```

```cpp
#include <hip/hip_runtime.h>
#include <hip/hip_bf16.h>
#include <cstdio>
#include <cstdint>


#define LAS __attribute__((address_space(3)))
#define GAS __attribute__((address_space(1)))
typedef unsigned short bf16_t;
typedef short bf16x8 __attribute__((ext_vector_type(8)));
typedef short s16x4 __attribute__((ext_vector_type(4)));
typedef float f32x4 __attribute__((ext_vector_type(4)));
typedef float f32x2 __attribute__((ext_vector_type(2)));
typedef float f32x16 __attribute__((ext_vector_type(16)));
typedef unsigned u32x4 __attribute__((ext_vector_type(4)));
typedef unsigned u32x2 __attribute__((ext_vector_type(2)));

constexpr int DM = 1024, MC = 8192, ML = 8192, M = 16384, TC = 256, TL = 2048, NBC = 32, NBL = 4;
constexpr int NIN = 2736, NINP = 2816;
constexpr int C_MQ = 0, C_MK = 512, C_MV = 1024, C_MO = 1536, C_QLAT = 2048, C_KVLAT = 2432, C_KROPE = 2688, C_GATE = 2720;
constexpr int QLORA = 384, KVLORA = 256, NQ = 768, NQP = 1024  , NKV = 1024, FF = 4096;
constexpr int MKV = M + NBL * 256;
constexpr float EPS = 1e-6f;

constexpr size_t O_Y = 0, O_Z = 8388608, O_CKV = 16777216, O_KROPE = 18874368, O_C = 19136512, O_N = 23330816, O_M = 23363584, O_END = 23363840;

constexpr size_t MiB = 1u << 20;
constexpr size_t WS_CTL = 0, CTL_ZERO_BYTES = 1 * MiB;
constexpr size_t WS_MOD = 1 * MiB, WS_ROPE = 1 * MiB + 131072;
constexpr size_t WS_WIN = 2 * MiB, WS_WQ = 8 * MiB, WS_WKV = 9 * MiB, WS_WO = 10 * MiB, WS_WUP = 12 * MiB, WS_WDN = 20 * MiB, WS_GATES = 28 * MiB, WS_KRC = 29 * MiB;
constexpr size_t WS_H = 32 * MiB;
constexpr size_t WS_QN = 32 * MiB, WS_CKVN = 44 * MiB;
constexpr size_t WS_PROJ = 64 * MiB, WS_Q = 152 * MiB, WS_KVRAW = 176 * MiB, WS_K = 210 * MiB;
constexpr size_t WS_X1 = 192 * MiB, WS_END = 256 * MiB;
constexpr size_t WS_U = 32 * MiB;
constexpr size_t WS_XG = 160 * MiB;
constexpr size_t WS_CKVC = 31 * MiB;
constexpr size_t WS_BIAS2 = 30 * MiB;
constexpr int CW_TMO = 0, CW_QUEUE = 64, CW_BAR = 4096, CW_ROWSQ = 131072;

__device__ __forceinline__ unsigned cvt_pk_bf16(float lo, float hi) { unsigned r; asm volatile("v_cvt_pk_bf16_f32 %0, %1, %2" : "=v"(r) : "v"(lo), "v"(hi)); return r; }
__device__ __forceinline__ float bf2f(unsigned short x) { return __uint_as_float(((unsigned)x) << 16); }
__device__ __forceinline__ float bflo(unsigned w) { return __uint_as_float(w << 16); }
__device__ __forceinline__ float bfhi(unsigned w) { return __uint_as_float(w & 0xffff0000u); }
__device__ __forceinline__ void unpack8(u32x4 w, float* f) { f[0] = bflo(w.x); f[1] = bfhi(w.x); f[2] = bflo(w.y); f[3] = bfhi(w.y); f[4] = bflo(w.z); f[5] = bfhi(w.z); f[6] = bflo(w.w); f[7] = bfhi(w.w); }
__device__ __forceinline__ u32x4 pack8(const float* f) { u32x4 w; w.x = cvt_pk_bf16(f[0], f[1]); w.y = cvt_pk_bf16(f[2], f[3]); w.z = cvt_pk_bf16(f[4], f[5]); w.w = cvt_pk_bf16(f[6], f[7]); return w; }
__device__ __forceinline__ float wave_sum(float v) {
#pragma unroll
    for (int o = 1; o < 64; o <<= 1) v += __shfl_xor(v, o);
    return v;
}
__device__ __forceinline__ int fresh_lane() { int l; asm volatile("v_mbcnt_lo_u32_b32 %0, -1, 0\n\tv_mbcnt_hi_u32_b32 %0, -1, %0" : "=v"(l)); return l; }
#define LDS_WAIT() asm volatile("s_waitcnt lgkmcnt(0)" ::: "memory")
#define VM_WAIT() asm volatile("s_waitcnt vmcnt(0)" ::: "memory")
#define SBAR() __builtin_amdgcn_sched_barrier(0)
typedef short v4i16_t __attribute__((ext_vector_type(4)));
__device__ __forceinline__ s16x4 tr16(const LAS unsigned char* p) { return __builtin_bit_cast(s16x4, __builtin_amdgcn_ds_read_tr16_b64_v4i16((LAS v4i16_t*)p)); }
#define MK8(L, H) (bf16x8){L[0], L[1], L[2], L[3], H[0], H[1], H[2], H[3]}

namespace pg8 {
#define PG8_LAS __attribute__((address_space(3)))
typedef PG8_LAS float* PG8_LAS_float_ptr;
constexpr int BM = 256, BK = 64, HALF = 128, HTB = HALF * BK * 2  , STAGE_BYTES = 8 * HTB, NXCD = 8, WGM = 8;

__host__ __device__ __forceinline__ int lds_byte(int r, int c) { const int st = (r >> 4) * 2 + (c >> 5), rr = r & 15, cc = c & 31, ob = rr * 64 + cc * 2; return st * 1024 + (ob ^ (((ob >> 9) & 1) << 5)); }
__host__ __device__ __forceinline__ void stage_rc(int b, int& R, int& C) { const int st = b / 1024, sb = b % 1024, swz = sb ^ (((sb >> 9) & 1) << 5); R = (st >> 1) * 16 + swz / 64; C = (st & 1) * 32 + (swz % 64) / 2; }
__host__ __device__ __forceinline__ int perm32(int rho) { const int n = rho >> 4, i = rho & 15; return 8 * (i >> 2) + 4 * n + (i & 3); }

struct Unit { int pm, pn; };
struct Gemm { const bf16_t* A; const bf16_t* Bt; int M, N, K; };

struct StaticOrder {
    int nM, nN, nwg, G, c;
    __host__ __device__ void init(int M, int N, int G_, int c_) { nM = M / BM; nN = N / BM; nwg = nM * nN; G = G_; c = c_; }
    __host__ __device__ bool next(int i, Unit& u) const {
        const long L = (long)i * G + c; if (L >= nwg) return false;
        int wgid = (int)L; { const int q = nwg / NXCD, r = nwg % NXCD, xcd = wgid % NXCD, off = wgid / NXCD; wgid = (xcd < r ? xcd * (q + 1) : r * (q + 1) + (xcd - r) * q) + off; }
        const int nig = WGM * nN, gid = wgid / nig, fm = gid * WGM, gsz = (nM - fm) < WGM ? (nM - fm) : WGM;
        u.pm = fm + ((wgid % nig) % gsz); u.pn = (wgid % nig) / gsz; return true;
    }
    __device__ __forceinline__ void a_ready(const Unit&) const {}
    __device__ __forceinline__ void done(const Unit&) const {}
};


template <int ACT> struct EpiBf16 {
    static constexpr bool PERM = true, AFTER_DRAIN = false;
    bf16_t* O; int ldc;
    __device__ __forceinline__ void operator()(const f32x4 (&acc)[2][2][4][2], const Unit& u, int wr, int wc, int fr, int fq) const {
        const int row0 = u.pm * BM + wr * 64 + fr, col0 = u.pn * BM + wc * 32 + 8 * fq;
#pragma unroll
        for (int ai = 0; ai < 2; ++ai)
#pragma unroll
            for (int m = 0; m < 4; ++m) { bf16_t* rowp = O + (size_t)(row0 + ai * HALF + m * 16) * ldc + col0;
#pragma unroll
                for (int bj = 0; bj < 2; ++bj) { f32x4 v0 = acc[ai][bj][m][0], v1 = acc[ai][bj][m][1];
                    if (ACT == 2) {
#pragma unroll
                        for (int e = 0; e < 4; ++e) { const float a = fmaxf(v0[e], 0.f), b = fmaxf(v1[e], 0.f); v0[e] = a * a; v1[e] = b * b; } }
                    u32x4 w; w.x = cvt_pk_bf16(v0[0], v0[1]); w.y = cvt_pk_bf16(v0[2], v0[3]); w.z = cvt_pk_bf16(v1[0], v1[1]); w.w = cvt_pk_bf16(v1[2], v1[3]);
                    *(u32x4*)(rowp + bj * HALF) = w; } }
    }
};
struct EpiProj {
    static constexpr bool PERM = true, AFTER_DRAIN = false;
    bf16_t* O; float* gates;
    __device__ __forceinline__ void operator()(const f32x4 (&acc)[2][2][4][2], const Unit& u, int wr, int wc, int fr, int fq) const {
        const int row0 = u.pm * BM + wr * 64 + fr, col0 = u.pn * BM + wc * 32 + 8 * fq;
        const float ksc = (u.pn == 2 || u.pn == 3) ? 0.08838834764831845f : 1.0f;
#pragma unroll
        for (int ai = 0; ai < 2; ++ai)
#pragma unroll
            for (int m = 0; m < 4; ++m) { const int row = row0 + ai * HALF + m * 16; bf16_t* rowp = O + (size_t)row * NINP + col0;
#pragma unroll
                for (int bj = 0; bj < 2; ++bj) { const f32x4 v0 = acc[ai][bj][m][0] * ksc, v1 = acc[ai][bj][m][1] * ksc; const int c = col0 + bj * HALF;
                    if (c >= C_GATE && c < C_GATE + 16) { float* gp = gates + (size_t)row * 16 + (c - C_GATE); *(f32x4*)gp = v0; *(f32x4*)(gp + 4) = v1; }
                    u32x4 w; w.x = cvt_pk_bf16(v0[0], v0[1]); w.y = cvt_pk_bf16(v0[2], v0[3]); w.z = cvt_pk_bf16(v1[0], v1[1]); w.w = cvt_pk_bf16(v1[2], v1[3]);
                    *(u32x4*)(rowp + bj * HALF) = w; } }
    }
};
__device__ __forceinline__ float sum_x16_x32(float v) {
    auto a = __builtin_amdgcn_permlane16_swap(__float_as_uint(v), __float_as_uint(v), false, false); v = __uint_as_float(a[0]) + __uint_as_float(a[1]);
    auto b = __builtin_amdgcn_permlane32_swap(__float_as_uint(v), __float_as_uint(v), false, false); return __uint_as_float(b[0]) + __uint_as_float(b[1]);
}
__device__ __forceinline__ float partner_x32(float v, bool upper) {
    auto b = __builtin_amdgcn_permlane32_swap(__float_as_uint(v), __float_as_uint(v), false, false); return __uint_as_float(upper ? b[0] : b[1]);
}
template <int IS_KV> struct EpiHead {
    static constexpr bool PERM = true, AFTER_DRAIN = false;
    bf16_t* O; bf16_t* V; const float* gain; const bf16_t* proj; const bf16_t* krc; PG8_LAS float* X; int row0;
    __device__ __forceinline__ void operator()(const f32x4 (&acc)[2][2][4][2], const Unit& u, int wr, int wc, int fr, int fq) const {
        { const int l_ = fresh_lane(); fr = l_ & 15; fq = l_ >> 4; }
        const int rbase = row0 + u.pm * BM; const bool lat = rbase >= MC && rbase < M;
        PG8_LAS float* Xr = X + 2048;
        const int c8 = 32 * wc + 8 * fq;
        u32x4 krw[2][4];
        if (IS_KV && wc == 2) {
#pragma unroll
            for (int ai = 0; ai < 2; ++ai)
#pragma unroll
                for (int m = 0; m < 4; ++m) { const int row = rbase + ai * HALF + wr * 64 + m * 16 + fr;
                    krw[ai][m] = *(const u32x4*)(row < M ? proj + (size_t)row * NINP + C_KROPE + 8 * fq : krc + (size_t)(row - M) * 32 + 8 * fq); } }
#pragma unroll
        for (int ai = 0; ai < 2; ++ai)
#pragma unroll
            for (int m = 0; m < 4; ++m) { const int rl = ai * HALF + wr * 64 + m * 16 + fr;
#pragma unroll
                for (int bj = 0; bj < 2; ++bj) { const f32x4 v0 = acc[ai][bj][m][0], v1 = acc[ai][bj][m][1];
                    float ss = ((v0.x * v0.x + v0.y * v0.y) + (v0.z * v0.z + v0.w * v0.w)) + ((v1.x * v1.x + v1.y * v1.y) + (v1.z * v1.z + v1.w * v1.w));
                    ss = sum_x16_x32(ss);
                    if (fq == 0) X[(rl * 2 + bj) * 4 + wc] = ss; }
                if (IS_KV && wc == 2) { float kr[8]; unpack8(krw[ai][m], kr); float ss = 0.f;
#pragma unroll
                    for (int e = 0; e < 8; ++e) ss += kr[e] * kr[e];
                    ss = sum_x16_x32(ss);
                    if (fq == 0) Xr[rl] = ss; } }
        asm volatile("s_waitcnt lgkmcnt(0)" ::: "memory"); __builtin_amdgcn_s_barrier(); asm volatile("" ::: "memory");
        f32x4 g0 = (f32x4){0.f, 0.f, 0.f, 0.f}, g1 = g0;
        if (IS_KV ? wc <= 2 : wc < 3) { g0 = *(const f32x4*)(gain + c8); g1 = *(const f32x4*)(gain + c8 + 4); }
#pragma unroll
        for (int ai = 0; ai < 2; ++ai)
#pragma unroll
            for (int m = 0; m < 4; ++m) { const int rl = ai * HALF + wr * 64 + m * 16 + fr, row = rbase + rl;
                float cq[8], sq[8];
                if (wc == 2 && lat) { const int tpos = (row - MC) & (TL - 1); const float pos = (float)((fq & 1) ? (tpos & 63) : (tpos >> 6));
                    constexpr float RINV[8] = {0.15915494309189535f, 0.050329212104487035f, 0.015915494309189534f, 0.0050329212104487035f, 0.0015915494309189534f, 0.00050329212104487035f, 0.00015915494309189535f, 0.000050329212104487035f};
#pragma unroll
                    for (int e = 0; e < 8; ++e) { const float rev = __builtin_amdgcn_fractf(pos * RINV[e]); cq[e] = __builtin_amdgcn_cosf(rev); sq[e] = __builtin_amdgcn_sinf(rev); } }
#pragma unroll
                for (int bj = 0; bj < 2; ++bj) { const int hd = 2 * u.pn + bj;
                    const f32x4 xp = *(const PG8_LAS f32x4*)(X + (rl * 2 + bj) * 4);
                    const float tot = IS_KV ? (xp.x + xp.y) + Xr[rl] : (xp.x + xp.y) + (xp.z + xp.w);
                    const float rstd = __builtin_amdgcn_rsqf(tot * (1.0f / 96.0f) + EPS);
                    if (IS_KV && wc >= 2) {
                        const f32x4 v0 = acc[ai][bj][m][0], v1 = acc[ai][bj][m][1];
                        u32x4 w; w.x = cvt_pk_bf16(v0[0], v0[1]); w.y = cvt_pk_bf16(v0[2], v0[3]); w.z = cvt_pk_bf16(v1[0], v1[1]); w.w = cvt_pk_bf16(v1[2], v1[3]);
                        *(u32x4*)(V + (size_t)row * NKV + hd * 128 + 64 + (c8 - 64)) = w; }
                    if (IS_KV ? wc <= 2 : wc < 3) {
                        float v[8];
                        if (IS_KV && wc == 2) unpack8(krw[ai][m], v);
                        else {
#pragma unroll
                            for (int e = 0; e < 4; ++e) { v[e] = acc[ai][bj][m][0][e]; v[4 + e] = acc[ai][bj][m][1][e]; } }
#pragma unroll
                        for (int e = 0; e < 4; ++e) { v[e] *= rstd * g0[e]; v[4 + e] *= rstd * g1[e]; }
                        if (wc == 2) {
#pragma unroll
                            for (int e = 0; e < 8; ++e) { const float p = partner_x32(v[e], fq >= 2);
                                if (lat) v[e] = fq < 2 ? v[e] * cq[e] - p * sq[e] : p * sq[e] + v[e] * cq[e]; } }
                        u32x4 w; w.x = cvt_pk_bf16(v[0], v[1]); w.y = cvt_pk_bf16(v[2], v[3]); w.z = cvt_pk_bf16(v[4], v[5]); w.w = cvt_pk_bf16(v[6], v[7]);
                        *(u32x4*)(O + (size_t)row * NQ + hd * 96 + c8) = w; } } }
        asm volatile("s_waitcnt lgkmcnt(0)" ::: "memory"); __builtin_amdgcn_s_barrier(); asm volatile("" ::: "memory");
    }
};
struct EpiDown {
    static constexpr bool PERM = false, AFTER_DRAIN = false;
    const bf16_t* x1; float* out; const float* mod;
    __device__ __forceinline__ void operator()(const f32x4 (&acc)[2][2][4][2], const Unit& u, int wr, int wc, int fr, int fq) const {
        const int col0 = u.pn * BM + wc * 32 + 4 * fq;
        const int cond = u.pm < (MC / BM) ? 0 : 1 + (u.pm - MC / BM) / (TL / BM);
        const float* g = mod + cond * 6144 + 5120 + col0;
        f32x4 gv[2][2];
#pragma unroll
        for (int bj = 0; bj < 2; ++bj)
#pragma unroll
            for (int n = 0; n < 2; ++n) gv[bj][n] = *(const f32x4*)(g + bj * HALF + n * 16);
#pragma unroll
        for (int ai = 0; ai < 2; ++ai)
#pragma unroll
            for (int m = 0; m < 4; ++m) { const int row = u.pm * BM + ai * HALF + wr * 64 + m * 16 + fr;
                const bf16_t* xr = x1 + (size_t)row * DM + col0; float* orow = out + (size_t)row * DM + col0;
#pragma unroll
                for (int bj = 0; bj < 2; ++bj)
#pragma unroll
                    for (int n = 0; n < 2; ++n) { const u32x2 w = *(const u32x2*)(xr + bj * HALF + n * 16); const f32x4 xv = (f32x4){bflo(w.x), bfhi(w.x), bflo(w.y), bfhi(w.y)};
                        *(f32x4*)(orow + bj * HALF + n * 16) = xv + gv[bj][n] * acc[ai][bj][m][n]; } }
    }
};
struct EpiUp {
    static constexpr bool PERM = true, AFTER_DRAIN = false;
    bf16_t* O; const float* rowsq; const float* bias;
    __device__ __forceinline__ void operator()(const f32x4 (&acc)[2][2][4][2], const Unit& u, int wr, int wc, int fr, int fq) const {
        const int row0 = u.pm * BM + wr * 64 + fr, col0 = u.pn * BM + wc * 32 + 8 * fq;
        const int cond = u.pm < (MC / BM) ? 0 : 1 + (u.pm - MC / BM) / (TL / BM);
        const float* bp = bias + cond * FF + col0;
        f32x4 bv[2][2];
#pragma unroll
        for (int bj = 0; bj < 2; ++bj) { bv[bj][0] = *(const f32x4*)(bp + bj * HALF); bv[bj][1] = *(const f32x4*)(bp + bj * HALF + 4); }
#pragma unroll
        for (int ai = 0; ai < 2; ++ai)
#pragma unroll
            for (int m = 0; m < 4; ++m) { const int row = row0 + ai * HALF + m * 16; bf16_t* rowp = O + (size_t)row * FF + col0;
                const float rstd = 1.0f / sqrtf(__hip_atomic_load(rowsq + row, __ATOMIC_RELAXED, __HIP_MEMORY_SCOPE_AGENT) * (1.0f / DM) + EPS);
#pragma unroll
                for (int bj = 0; bj < 2; ++bj) { f32x4 v0 = acc[ai][bj][m][0] * rstd + bv[bj][0], v1 = acc[ai][bj][m][1] * rstd + bv[bj][1];
#pragma unroll
                    for (int e = 0; e < 4; ++e) { const float a = fmaxf(v0[e], 0.f), b = fmaxf(v1[e], 0.f); v0[e] = a * a; v1[e] = b * b; }
                    u32x4 w; w.x = cvt_pk_bf16(v0[0], v0[1]); w.y = cvt_pk_bf16(v0[2], v0[3]); w.z = cvt_pk_bf16(v1[0], v1[1]); w.w = cvt_pk_bf16(v1[2], v1[3]);
                    *(u32x4*)(rowp + bj * HALF) = w; } }
    }
};
struct EpiMix {
    static constexpr bool PERM = false, AFTER_DRAIN = false;
    const float* xa; const float* xb; bf16_t* x1; bf16_t* xg; const float* mod; const float* n2g; float* rowsq;
    __device__ __forceinline__ void operator()(const f32x4 (&acc)[2][2][4][2], const Unit& u, int wr, int wc, int fr, int fq) const {
        const int col0 = u.pn * BM + wc * 32 + 4 * fq;
        const int cond = u.pm < (MC / BM) ? 0 : 1 + (u.pm - MC / BM) / (TL / BM);
        const float* g = mod + cond * 6144 + 2048 + col0; const float* sc = mod + cond * 6144 + 4096 + col0; const float* ng = n2g + col0;
        f32x4 gv[2][2], gm[2][2];
#pragma unroll
        for (int bj = 0; bj < 2; ++bj)
#pragma unroll
            for (int n = 0; n < 2; ++n) { gv[bj][n] = *(const f32x4*)(g + bj * HALF + n * 16); gm[bj][n] = *(const f32x4*)(ng + bj * HALF + n * 16) * (*(const f32x4*)(sc + bj * HALF + n * 16) + 1.0f); }
#pragma unroll
        for (int ai = 0; ai < 2; ++ai)
#pragma unroll
            for (int m = 0; m < 4; ++m) { const int row = u.pm * BM + ai * HALF + wr * 64 + m * 16 + fr;
                const float* xr = (row < MC ? xa + (size_t)row * DM : xb + (size_t)(row - MC) * DM) + col0; bf16_t* orow = x1 + (size_t)row * DM + col0; bf16_t* grow = xg + (size_t)row * DM + col0;
                float ss = 0.f;
#pragma unroll
                for (int bj = 0; bj < 2; ++bj)
#pragma unroll
                    for (int n = 0; n < 2; ++n) { const f32x4 xv = *(const f32x4*)(xr + bj * HALF + n * 16); const f32x4 o = xv + gv[bj][n] * acc[ai][bj][m][n];
                        { u32x2 w1; w1.x = cvt_pk_bf16(o.x, o.y); w1.y = cvt_pk_bf16(o.z, o.w); *(u32x2*)(orow + bj * HALF + n * 16) = w1; } ss += (o.x * o.x + o.y * o.y) + (o.z * o.z + o.w * o.w);
                        const f32x4 og = o * gm[bj][n]; u32x2 w; w.x = cvt_pk_bf16(og.x, og.y); w.y = cvt_pk_bf16(og.z, og.w); *(u32x2*)(grow + bj * HALF + n * 16) = w; }
                ss += __shfl_xor(ss, 16); ss += __shfl_xor(ss, 32);
                if (fq == 0) __hip_atomic_fetch_add(rowsq + row, ss, __ATOMIC_RELAXED, __HIP_MEMORY_SCOPE_AGENT); }
    }
};
struct EpiResGate {
    static constexpr bool PERM = false, AFTER_DRAIN = false;
    const float* xa; const float* xb; float* out; const float* mod; int goff;
    __device__ __forceinline__ void operator()(const f32x4 (&acc)[2][2][4][2], const Unit& u, int wr, int wc, int fr, int fq) const {
        const int col0 = u.pn * BM + wc * 32 + 4 * fq;
        const int cond = u.pm < (MC / BM) ? 0 : 1 + (u.pm - MC / BM) / (TL / BM);
        const float* g = mod + cond * 6144 + goff + col0;
        f32x4 gv[2][2];
#pragma unroll
        for (int bj = 0; bj < 2; ++bj)
#pragma unroll
            for (int n = 0; n < 2; ++n) gv[bj][n] = *(const f32x4*)(g + bj * HALF + n * 16);
#pragma unroll
        for (int ai = 0; ai < 2; ++ai)
#pragma unroll
            for (int m = 0; m < 4; ++m) { const int row = u.pm * BM + ai * HALF + wr * 64 + m * 16 + fr;
                const float* xr = (row < MC ? xa + (size_t)row * DM : xb + (size_t)(row - MC) * DM) + col0; float* orow = out + (size_t)row * DM + col0;
#pragma unroll
                for (int bj = 0; bj < 2; ++bj)
#pragma unroll
                    for (int n = 0; n < 2; ++n) { const f32x4 xv = *(const f32x4*)(xr + bj * HALF + n * 16); *(f32x4*)(orow + bj * HALF + n * 16) = xv + gv[bj][n] * acc[ai][bj][m][n]; } }
    }
};

template <class Epi, class Sched, bool ALIGN_EPI = false, bool SP2 = false>
__device__ __forceinline__ void gemm_phase(PG8_LAS unsigned char* lds, const Gemm g, const Sched& S, const Epi& E, const int wid  ) {
    const int lane = fresh_lane(), tid = wid * 64 + lane;
    const int wr = wid >> 2, wc = wid & 3, fr = lane & 15, fq = lane >> 4;
    const int K = g.K, nt = K / BK;
    unsigned voffA[2], voffB[2];
#pragma unroll
    for (int i = 0; i < 2; ++i) { int R, C; stage_rc(tid * 16 + i * 8192, R, C); const int Rb = Epi::PERM ? ((R & ~31) + perm32(R & 31)) : R;
        voffA[i] = (unsigned)(R * K + C) * 2u; voffB[i] = (unsigned)(Rb * K + C) * 2u; }
    const size_t kstep = (size_t)(BK * 2);
    const size_t hstep = (size_t)HALF * K * 2;
    const size_t tstep = 2 * hstep;
    const unsigned ldsw = (unsigned)wid * 1024u;
    const int aoff = lds_byte(wr * 64 + fr, fq * 8), boff = lds_byte(wc * 32 + fr, fq * 8);
#define PG8_SA(b, h) (((b) * 2 + (h)) * HTB)
#define PG8_SB(b, h) ((4 + (b) * 2 + (h)) * HTB)
#define PG8_STAGE(bufoff, gbase, voff) do { _Pragma("unroll") for (int _i = 0; _i < 2; ++_i) \
        __builtin_amdgcn_global_load_lds((const unsigned*)((const char*)(gbase) + (voff)[_i]), (PG8_LAS unsigned*)(lds + (bufoff) + ldsw + _i * 8192), 16, 0, 0); } while (0)
#define PG8_LDA(dst, b, h) do { _Pragma("unroll") for (int m = 0; m < 4; ++m) _Pragma("unroll") for (int k = 0; k < 2; ++k) dst[m][k] = *(const PG8_LAS bf16x8*)(lds + PG8_SA(b, h) + aoff + m * 2048 + k * 1024); } while (0)
#define PG8_LDB(dst, b, h) do { _Pragma("unroll") for (int n = 0; n < 2; ++n) _Pragma("unroll") for (int k = 0; k < 2; ++k) dst[n][k] = *(const PG8_LAS bf16x8*)(lds + PG8_SB(b, h) + boff + n * 2048 + k * 1024); } while (0)
#define PG8_MMA(ai, bj, At, Bt) do { __builtin_amdgcn_s_setprio(1); _Pragma("unroll") for (int m = 0; m < 4; ++m) _Pragma("unroll") for (int n = 0; n < 2; ++n) _Pragma("unroll") for (int k = 0; k < 2; ++k) \
        acc[ai][bj][m][n] = __builtin_amdgcn_mfma_f32_16x16x32_bf16(Bt[n][k], At[m][k], acc[ai][bj][m][n], 0, 0, 0); __builtin_amdgcn_s_setprio(0); } while (0)
#define PG8_WAIT_V(n) asm volatile("s_waitcnt vmcnt(" #n ")" ::: "memory")
#define PG8_WAIT_L(n) asm volatile("s_waitcnt lgkmcnt(" #n ")" ::: "memory")
#define PG8_BAR __builtin_amdgcn_s_barrier()
#define PG8_SCHED __builtin_amdgcn_sched_barrier(0)
    Unit cur, nxt; int ui = 0;
    if (!S.next(0, cur)) return;
    f32x4 acc[2][2][4][2];
#pragma unroll
    for (int a = 0; a < 2; ++a)
#pragma unroll
        for (int b = 0; b < 2; ++b)
#pragma unroll
            for (int m = 0; m < 4; ++m)
#pragma unroll
                for (int n = 0; n < 2; ++n) acc[a][b][m][n] = (f32x4){0.f, 0.f, 0.f, 0.f};
    bf16x8 At[4][2], B0[2][2], B1[2][2];
    const char* cA = (const char*)g.A + (size_t)cur.pm * tstep; const char* cB = (const char*)g.Bt + (size_t)cur.pn * tstep;
    S.a_ready(cur);
    if constexpr (SP2) {
        PG8_STAGE(PG8_SB(0, 0), cB, voffB); PG8_STAGE(PG8_SB(0, 1), cB + hstep, voffB); PG8_STAGE(PG8_SA(0, 0), cA, voffA); PG8_STAGE(PG8_SA(0, 1), cA + hstep, voffA);
        if (wr == 1) PG8_BAR;
        PG8_WAIT_V(2); PG8_BAR;
        PG8_STAGE(PG8_SB(1, 0), cB + kstep, voffB); PG8_STAGE(PG8_SA(1, 0), cA + kstep, voffA); PG8_STAGE(PG8_SB(1, 1), cB + hstep + kstep, voffB);
        PG8_WAIT_V(6); PG8_BAR;
    } else {
        PG8_STAGE(PG8_SB(0, 0), cB, voffB); PG8_STAGE(PG8_SA(0, 0), cA, voffA); PG8_STAGE(PG8_SB(0, 1), cB + hstep, voffB); PG8_STAGE(PG8_SA(0, 1), cA + hstep, voffA);
        if (wr == 1) PG8_BAR;
        PG8_WAIT_V(4); PG8_BAR;
        PG8_STAGE(PG8_SB(1, 0), cB + kstep, voffB); PG8_STAGE(PG8_SA(1, 0), cA + kstep, voffA); PG8_STAGE(PG8_SB(1, 1), cB + hstep + kstep, voffB);
        PG8_WAIT_V(6); PG8_BAR;
    }
    for (;;) {
        const bool has_next = S.next(ui + 1, nxt);
        const char* nA = has_next ? (const char*)g.A + (size_t)nxt.pm * tstep : cA; const char* nB = has_next ? (const char*)g.Bt + (size_t)nxt.pn * tstep : cB;
        for (int t = 0; t < nt; t += 2) {
            const bool last = (t == nt - 2);
            const char* a1 = cA + (size_t)(t + 1) * kstep;
            const char* a2 = last ? nA : cA + (size_t)(t + 2) * kstep; const char* b2 = last ? nB : cB + (size_t)(t + 2) * kstep;
            const char* a3 = a2 + kstep; const char* b3 = b2 + kstep;
            if (last && has_next) S.a_ready(nxt);
            if constexpr (SP2) {
            PG8_LDB(B0, 0, 0); PG8_LDB(B1, 0, 1); PG8_SCHED; PG8_LDA(At, 0, 0); PG8_STAGE(PG8_SA(1, 1), a1 + hstep, voffA);
            PG8_WAIT_V(8); PG8_WAIT_L(0); PG8_BAR; PG8_MMA(0, 0, At, B0); PG8_MMA(0, 1, At, B1); PG8_BAR; PG8_SCHED;
            PG8_LDA(At, 0, 1); PG8_STAGE(PG8_SB(0, 0), b2, voffB); PG8_STAGE(PG8_SB(0, 1), b2 + hstep, voffB); PG8_STAGE(PG8_SA(0, 0), a2, voffA);
            PG8_WAIT_V(8); PG8_WAIT_L(0); PG8_BAR; PG8_MMA(1, 0, At, B0); PG8_MMA(1, 1, At, B1); PG8_BAR; PG8_SCHED;
            PG8_LDB(B0, 1, 0); PG8_LDB(B1, 1, 1); PG8_SCHED; PG8_LDA(At, 1, 0); PG8_STAGE(PG8_SA(0, 1), a2 + hstep, voffA);
            PG8_WAIT_V(8); PG8_WAIT_L(0); PG8_BAR; PG8_MMA(0, 0, At, B0); PG8_MMA(0, 1, At, B1); PG8_BAR; PG8_SCHED;
            PG8_LDA(At, 1, 1); PG8_STAGE(PG8_SB(1, 0), b3, voffB); PG8_STAGE(PG8_SB(1, 1), b3 + hstep, voffB); PG8_STAGE(PG8_SA(1, 0), a3, voffA);
            PG8_WAIT_V(8); PG8_WAIT_L(0); PG8_BAR; PG8_MMA(1, 0, At, B0); PG8_MMA(1, 1, At, B1); PG8_BAR; PG8_SCHED;
            } else {
            PG8_LDB(B0, 0, 0); PG8_SCHED; PG8_LDA(At, 0, 0); PG8_STAGE(PG8_SA(1, 1), a1 + hstep, voffA);
            PG8_WAIT_L(8); PG8_BAR; PG8_WAIT_L(0); PG8_MMA(0, 0, At, B0); PG8_BAR; PG8_SCHED;
            PG8_LDB(B1, 0, 1); PG8_STAGE(PG8_SB(0, 0), b2, voffB);
            PG8_BAR; PG8_WAIT_L(0); PG8_MMA(0, 1, At, B1); PG8_BAR;
            PG8_LDA(At, 0, 1); PG8_STAGE(PG8_SA(0, 0), a2, voffA);
            PG8_BAR; PG8_WAIT_L(0); PG8_MMA(1, 0, At, B0); PG8_BAR; PG8_SCHED;
            PG8_STAGE(PG8_SB(0, 1), b2 + hstep, voffB);
            PG8_WAIT_V(6); PG8_BAR; PG8_MMA(1, 1, At, B1); PG8_BAR;
            PG8_LDB(B0, 1, 0); PG8_SCHED; PG8_LDA(At, 1, 0); PG8_STAGE(PG8_SA(0, 1), a2 + hstep, voffA);
            PG8_WAIT_L(8); PG8_BAR; PG8_WAIT_L(0); PG8_MMA(0, 0, At, B0); PG8_BAR; PG8_SCHED;
            PG8_LDB(B1, 1, 1); PG8_STAGE(PG8_SB(1, 0), b3, voffB);
            PG8_BAR; PG8_WAIT_L(0); PG8_MMA(0, 1, At, B1); PG8_BAR;
            PG8_LDA(At, 1, 1); PG8_STAGE(PG8_SA(1, 0), a3, voffA);
            PG8_BAR; PG8_WAIT_L(0); PG8_MMA(1, 0, At, B0); PG8_BAR; PG8_SCHED;
            PG8_STAGE(PG8_SB(1, 1), b3 + hstep, voffB);
            PG8_WAIT_V(6); PG8_BAR; PG8_MMA(1, 1, At, B1); PG8_BAR;
            }
        }
        if constexpr (ALIGN_EPI) { if (wr == 0) PG8_BAR; }
        if constexpr (!Epi::AFTER_DRAIN) { E(acc, cur, wr, wc, fr, fq); S.done(cur); }
        if (!has_next) break;
#pragma unroll
        for (int a = 0; a < 2; ++a)
#pragma unroll
            for (int b = 0; b < 2; ++b)
#pragma unroll
                for (int m = 0; m < 4; ++m)
#pragma unroll
                    for (int n = 0; n < 2; ++n) acc[a][b][m][n] = (f32x4){0.f, 0.f, 0.f, 0.f};
        cur = nxt; cA = nA; cB = nB; ++ui;
        if constexpr (ALIGN_EPI) { if (wr == 1) PG8_BAR; }
    }
    PG8_WAIT_V(0);
    if constexpr (!ALIGN_EPI) { if (wr == 0) PG8_BAR; }
    PG8_BAR;
    if constexpr (Epi::AFTER_DRAIN) { E.fused(acc, cur, wr, wc, fr, fq, lds, wid, lane); S.done(cur); }
#undef PG8_SA
#undef PG8_SB
#undef PG8_STAGE
#undef PG8_LDA
#undef PG8_LDB
#undef PG8_MMA
#undef PG8_WAIT_V
#undef PG8_WAIT_L
#undef PG8_BAR
#undef PG8_SCHED
}
}
#define XB_TMO      128
#define XB_XCNT(j)  (256  + 64 * (j))
#define XB_XSUB(j)  (1280 + 64 * (j))
#define XB_XGEN(j)  (2304 + 64 * (j))
#define XB_TOP      3328
#define XB_TOPGEN   3392
#define XCD_BAR_WORDS 3456
#define XB_SPIN_CAP (1u << 18)

__device__ __forceinline__ unsigned xb_ld(unsigned* p)              { return __hip_atomic_load(p, __ATOMIC_RELAXED, __HIP_MEMORY_SCOPE_AGENT); }
__device__ __forceinline__ unsigned xb_add(unsigned* p, unsigned v) { return __hip_atomic_fetch_add(p, v, __ATOMIC_RELAXED, __HIP_MEMORY_SCOPE_AGENT); }
__device__ __forceinline__ unsigned xb_xcc_id() { return (unsigned)__builtin_amdgcn_s_getreg((3 << 11) | 20) & 0xFu; }
#define XB_SPIN(cond, bar) do { unsigned _sp = 0; while (cond) { __builtin_amdgcn_s_sleep(1); \
    if ((++_sp & 255u) == 0u) { if (xb_ld(&(bar)[XB_TMO])) break; if (_sp > XB_SPIN_CAP) { atomicAdd(&(bar)[XB_TMO], 1u); break; } } } } while (0)

struct XcdBarrier {
    unsigned* bar; unsigned x; unsigned w;
    volatile LAS unsigned* st;
};

__device__ __forceinline__ XcdBarrier xcd_barrier_post(unsigned* bar, volatile LAS unsigned* st, unsigned wave) {
    XcdBarrier b; b.bar = bar; b.x = xb_xcc_id(); b.st = st; b.w = wave;
    if (wave == 0u && fresh_lane() == 0) (void)xb_add(&bar[XB_XCNT(b.x)], 1u);
    return b;
}
__device__ __forceinline__ void xcd_barrier_complete(unsigned* bar, unsigned x, unsigned& nloc, unsigned& nx) {
    const unsigned G = gridDim.x * gridDim.y * gridDim.z;
    unsigned sum, cnt, mine, sp = 0u;
    for (;;) {
        sum = 0u; cnt = 0u; mine = 0u;
#pragma unroll
        for (unsigned j = 0; j < 16; ++j) { const unsigned c = xb_ld(&bar[XB_XCNT(j)]); sum += c; cnt += (c > 0u) ? 1u : 0u; mine = (j == x) ? c : mine; }
        if (sum == G) break;
        __builtin_amdgcn_s_sleep(1);
        if ((++sp & 255u) == 0u) { if (xb_ld(&bar[XB_TMO])) break; if (sp > XB_SPIN_CAP) { atomicAdd(&bar[XB_TMO], 1u); break; } }
    }
    nloc = mine > 0u ? mine : 1u; nx = cnt > 0u ? cnt : 1u;
}

__device__ __forceinline__ void xcd_barrier(const XcdBarrier& b) {
    asm volatile("s_waitcnt vmcnt(0)" ::: "memory");
    __syncthreads();
    if (b.w == 0u && fresh_lane() == 0) {
        unsigned* bar = b.bar;
        __builtin_amdgcn_s_waitcnt(0);
        unsigned nloc = b.st[0], nx = b.st[1];
        if (nloc == 0u) { xcd_barrier_complete(bar, b.x, nloc, nx); b.st[0] = nloc; b.st[1] = nx; }
        const unsigned old = xb_add(&bar[XB_XSUB(b.x)], 1u);
        const unsigned gen = old / nloc;
        if (old + 1u == (gen + 1u) * nloc) {
            __builtin_amdgcn_fence(__ATOMIC_RELEASE, "agent");
            asm volatile("s_waitcnt vmcnt(0)" ::: "memory");
            const unsigned og = xb_add(&bar[XB_TOP], 1u);
            const unsigned tg = og / nx;
            if (og + 1u == (tg + 1u) * nx) xb_add(&bar[XB_TOPGEN], 1u);
            else XB_SPIN(xb_ld(&bar[XB_TOPGEN]) == tg, bar);
            __builtin_amdgcn_fence(__ATOMIC_ACQUIRE, "agent");
            xb_add(&bar[XB_XGEN(b.x)], 1u);
            asm volatile("s_waitcnt vmcnt(0)" ::: "memory");
        } else {
            XB_SPIN(xb_ld(&bar[XB_XGEN(b.x)]) == gen, bar);
            __builtin_amdgcn_fence(__ATOMIC_ACQUIRE, "agent");
            asm volatile("s_waitcnt vmcnt(0)" ::: "memory");
        }
    }
    __syncthreads();
}

constexpr int NWAVES = 8, NTHREADS = 512;
constexpr int RING_BYTES = 131072, LDS_BYTES = 163840, LDSCTL_OFF = LDS_BYTES - 1024, MISC_OFF = LDSCTL_OFF + 320;
static_assert(pg8::STAGE_BYTES <= RING_BYTES, "GEMM stage buffers fit the ring");
struct Args { const float* in[25]; float* out; unsigned char* ws; int ph_lo, ph_hi, li, pad; };
enum { I_XP = 0, I_XS, I_CCKV, I_CKROPE, I_SC, I_SN, I_SM, I_C, I_CCTX, I_N1G, I_N2G, I_WADA, I_BADA, I_WIN, I_GATEB, I_MNG, I_QLG, I_KVLG, I_WQ, I_WKV, I_QHG, I_KHG, I_WOUT, I_WUP, I_WDN };

template <int MODE> __device__ __forceinline__ int src_col(int n) {
    if (MODE == 0) return n;
    if (MODE == 2) return (n & 127) < 96 ? (n >> 7) * 96 + (n & 127) : -1;
    if (n < 2048) return n;
    if (n < C_GATE) return n + 16;
    if (n < NIN) return n - 672;
    return -1;
}
template <int MODE>
__device__ __forceinline__ void transpose_item(const float* W, int K, int Nsrc, int Ndst, bf16_t* WT, LAS float* scr, int item, int lane) {
    const int nblk = Ndst / 32, kb = item / nblk, nb = item % nblk, k0 = 64 * kb, n0 = 32 * nb;
    const int sc = src_col<MODE>(n0 + (lane & 31));
#pragma unroll 8
    for (int i = 0; i < 32; ++i) { const int kk = 2 * i + (lane >> 5); scr[kk * 33 + (lane & 31)] = sc >= 0 ? W[(size_t)(k0 + kk) * Nsrc + sc] : 0.f; }
    LDS_WAIT(); asm volatile("" ::: "memory");
    const int c = lane & 7;
#pragma unroll
    for (int j = 0; j < 4; ++j) { const int n = (lane >> 3) + 8 * j; const LAS float* s = scr + (8 * c) * 33 + n;
        u32x4 o; o.x = cvt_pk_bf16(s[0 * 33], s[1 * 33]); o.y = cvt_pk_bf16(s[2 * 33], s[3 * 33]); o.z = cvt_pk_bf16(s[4 * 33], s[5 * 33]); o.w = cvt_pk_bf16(s[6 * 33], s[7 * 33]);
        *(u32x4*)(WT + (size_t)(n0 + n) * K + k0 + 8 * c) = o; }
    LDS_WAIT(); asm volatile("" ::: "memory");
}
template <int MODE>
__device__ __forceinline__ void gemv5_item(const float* c_in, const float* c_ctx, const float* W, const float* b_ada, float* OUT, LAS unsigned char* lds, int item, int tid, int lane, int wave) {
    constexpr int NW_ = MODE == 0 ? 6144 : FF;
    LAS float* s_l = (LAS float*)lds;
    LAS float* red = (LAS float*)(lds + 20480);
    for (int idx = tid; idx < 5120; idx += NTHREADS) { const int c = idx >> 10, k = idx & 1023; if (MODE == 0) { const float v = c == 0 ? c_ctx[k] : c_in[(c - 1) * 1024 + k]; s_l[idx] = v / (1.f + __expf(-v)); } else s_l[idx] = c_in[c * 6144 + 3072 + k]; }
    __syncthreads();
    const int n0 = item * 64, kq = lane >> 4, cq = lane & 15, kbase = wave * 128;
    f32x4 acc[5];
#pragma unroll
    for (int c = 0; c < 5; ++c) acc[c] = (f32x4){0.f, 0.f, 0.f, 0.f};
    const float* wp = W + (size_t)(kbase + kq) * NW_ + n0 + cq * 4;
#pragma unroll 8
    for (int it = 0; it < 32; ++it) { const f32x4 w = *(const f32x4*)(wp + (size_t)it * 4 * NW_); const int k = kbase + it * 4 + kq;
#pragma unroll
        for (int c = 0; c < 5; ++c) acc[c] += s_l[c * 1024 + k] * w; }
#pragma unroll
    for (int c = 0; c < 5; ++c)
#pragma unroll
        for (int e = 0; e < 4; ++e) { float v = acc[c][e]; v += __shfl_xor(v, 16); v += __shfl_xor(v, 32); acc[c][e] = v; }
    if (kq == 0) {
#pragma unroll
        for (int c = 0; c < 5; ++c) *(LAS f32x4*)(red + (wave * 5 + c) * 64 + cq * 4) = acc[c]; }
    __syncthreads();
    if (tid < 320) { const int c = tid >> 6, n = tid & 63; float s = MODE == 0 ? b_ada[n0 + n] : 0.f;
#pragma unroll
        for (int w = 0; w < 8; ++w) s += red[(w * 5 + c) * 64 + n];
        OUT[c * NW_ + n0 + n] = s; }
    __syncthreads();
}
__device__ __forceinline__ void p0_prologue(const Args& a, LAS unsigned char* lds, int tid, int lane, int wave, int G) {
    unsigned char* ws = a.ws;
    const int bx = blockIdx.x;
    if (bx < 96) gemv5_item<0>(a.in[I_C], a.in[I_CCTX], a.in[I_WADA], a.in[I_BADA], (float*)(ws + WS_MOD), lds, bx, tid, lane, wave);
    LAS float* scr = (LAS float*)(lds + wave * 16384);
    const int gw = bx * NWAVES + wave, NGW = G * NWAVES;
    constexpr int I_1 = (DM / 64) * (NINP / 32), I_2 = (QLORA / 64) * (NQP / 32), I_3 = (KVLORA / 64) * (NKV / 32), I_4 = (DM / 64) * (DM / 32), I_5 = (DM / 64) * (FF / 32), I_6 = (FF / 64) * (DM / 32);
    constexpr int NITEMS = I_1 + I_2 + I_3 + I_4 + I_5 + I_6;
    for (int it = gw; it < NITEMS; it += NGW) {
        int r = it;
        if (r < I_1) { transpose_item<1>(a.in[I_WIN], DM, NIN, NINP, (bf16_t*)(ws + WS_WIN), scr, r, lane); continue; } r -= I_1;
        if (r < I_2) { transpose_item<2>(a.in[I_WQ], QLORA, NQ, NQP, (bf16_t*)(ws + WS_WQ), scr, r, lane); continue; } r -= I_2;
        if (r < I_3) { transpose_item<0>(a.in[I_WKV], KVLORA, NKV, NKV, (bf16_t*)(ws + WS_WKV), scr, r, lane); continue; } r -= I_3;
        if (r < I_4) { transpose_item<0>(a.in[I_WOUT], DM, DM, DM, (bf16_t*)(ws + WS_WO), scr, r, lane); continue; } r -= I_4;
        if (r < I_5) { transpose_item<0>(a.in[I_WUP], DM, FF, FF, (bf16_t*)(ws + WS_WUP), scr, r, lane); continue; } r -= I_5;
        transpose_item<0>(a.in[I_WDN], FF, DM, DM, (bf16_t*)(ws + WS_WDN), scr, r, lane);
    }
    for (int i = (bx * NTHREADS + tid); i < NBL * 256 * KVLORA / 8; i += (G * NTHREADS)) { const float* s = a.in[I_CCKV] + (size_t)i * 8; float f[8];
#pragma unroll
        for (int e = 0; e < 8; ++e) f[e] = s[e];
        *(u32x4*)((bf16_t*)(ws + WS_CKVC) + (size_t)i * 8) = pack8(f); }
    for (int i = (bx * NTHREADS + tid); i < NBL * 256 * 32 / 8; i += (G * NTHREADS)) { const float* s = a.in[I_CKROPE] + (size_t)i * 8; float f[8];
#pragma unroll
        for (int e = 0; e < 8; ++e) f[e] = s[e];
        *(u32x4*)((bf16_t*)(ws + WS_KRC) + (size_t)i * 8) = pack8(f); }
    float* rope = (float*)(ws + WS_ROPE);
    for (int idx = bx * NTHREADS + tid; idx < TL * 16; idx += G * NTHREADS) { const int t = idx >> 4, j = idx & 15;
        const float pos = (float)(j < 8 ? (t >> 6) : (t & 63)); const float inv = exp2f(-(float)(j & 7) * 0.125f * 13.287712379549449f);
        float rev = pos * inv * 0.15915494309189535f; rev -= floorf(rev);
        rope[t * 32 + j] = __builtin_amdgcn_cosf(rev); rope[t * 32 + 16 + j] = __builtin_amdgcn_sinf(rev); }
}

__device__ __forceinline__ int cond_of_row(int row) { return row < MC ? 0 : 1 + ((row - MC) >> 11); }
__device__ __forceinline__ void norm_rows(const float* xa, const float* xb, const float* g, const float* MOD, int sh_off, int sc_off, bf16_t* out, int gw, int NGW, int lane) {
    for (int rb = gw * 8; rb < M; rb += NGW * 8) {
        const int cond = cond_of_row(rb);
        const f32x4* g4 = (const f32x4*)g + lane; const f32x4* sc4 = (const f32x4*)(MOD + cond * 6144 + sc_off) + lane; const f32x4* sh4 = (const f32x4*)(MOD + cond * 6144 + sh_off) + lane;
        f32x4 gm[4], sv[4];
#pragma unroll
        for (int j = 0; j < 4; ++j) { gm[j] = g4[64 * j] * (sc4[64 * j] + 1.0f); sv[j] = sh4[64 * j]; }
        for (int r = 0; r < 8; r += 2) {
            f32x4 v[2][4];
#pragma unroll
            for (int q = 0; q < 2; ++q) { const int row = rb + r + q; const f32x4* xr = (const f32x4*)(row < MC ? xa + (size_t)row * DM : xb + (size_t)(row - MC) * DM) + lane;
#pragma unroll
                for (int j = 0; j < 4; ++j) v[q][j] = xr[64 * j]; }
#pragma unroll
            for (int q = 0; q < 2; ++q) { const int row = rb + r + q; float s = 0.f;
#pragma unroll
                for (int j = 0; j < 4; ++j) s += (v[q][j].x * v[q][j].x + v[q][j].y * v[q][j].y) + (v[q][j].z * v[q][j].z + v[q][j].w * v[q][j].w);
                const float rstd = 1.0f / sqrtf(wave_sum(s) * (1.0f / DM) + EPS);
                u32x2* o8 = (u32x2*)(out + (size_t)row * DM) + lane;
#pragma unroll
                for (int j = 0; j < 4; ++j) { const f32x4 o = v[q][j] * rstd * gm[j] + sv[j]; u32x2 w; w.x = cvt_pk_bf16(o.x, o.y); w.y = cvt_pk_bf16(o.z, o.w); o8[64 * j] = w; } } }
    }
}
__device__ __forceinline__ void p3_rows(const Args& a, int gw, int NGW, int lane, int gtid, int NGT) {
    unsigned char* ws = a.ws; const bf16_t* PROJ = (const bf16_t*)(ws + WS_PROJ); bf16_t* QN = (bf16_t*)(ws + WS_QN); bf16_t* CKVN = (bf16_t*)(ws + WS_CKVN);
    float qg[8]; f32x4 kg;
    { const int l8 = lane < 48 ? lane * 8 : 0;
#pragma unroll
      for (int e = 0; e < 8; ++e) qg[e] = a.in[I_QLG][l8 + e];
      kg = *(const f32x4*)(a.in[I_KVLG] + lane * 4); }
    for (int rb = gw * 8; rb < M; rb += NGW * 8)
        for (int r4 = 0; r4 < 8; r4 += 4) {
            u32x4 qw[4]; u32x2 kw4[4]; unsigned short krw[4];
#pragma unroll
            for (int q = 0; q < 4; ++q) { const bf16_t* pr = PROJ + (size_t)(rb + r4 + q) * NINP;
                qw[q] = (u32x4){0u, 0u, 0u, 0u}; if (lane < 48) qw[q] = *(const u32x4*)(pr + C_QLAT + lane * 8);
                kw4[q] = *(const u32x2*)(pr + C_KVLAT + lane * 4); krw[q] = pr[C_KROPE + (lane & 31)]; }
#pragma unroll
            for (int q = 0; q < 4; ++q) { const int row = rb + r4 + q;
                float qv[8]; unpack8(qw[q], qv);
                float s = 0.f;
#pragma unroll
                for (int e = 0; e < 8; ++e) s += qv[e] * qv[e];
                const float rq = 1.0f / sqrtf(wave_sum(s) * (1.0f / QLORA) + EPS);
                if (lane < 48) {
#pragma unroll
                    for (int e = 0; e < 8; ++e) qv[e] *= rq * qg[e];
                    *(u32x4*)(QN + (size_t)row * QLORA + lane * 8) = pack8(qv); }
                const u32x2 kw = kw4[q];
                f32x4 kv = (f32x4){bflo(kw.x), bfhi(kw.x), bflo(kw.y), bfhi(kw.y)};
                const float rk = 1.0f / sqrtf(wave_sum((kv.x * kv.x + kv.y * kv.y) + (kv.z * kv.z + kv.w * kv.w)) * (1.0f / KVLORA) + EPS);
                kv = kv * rk * kg;
                u32x2 ow; ow.x = cvt_pk_bf16(kv.x, kv.y); ow.y = cvt_pk_bf16(kv.z, kv.w);
                *(u32x2*)(CKVN + (size_t)row * KVLORA + lane * 4) = ow;
                if (row < MC) { *(f32x4*)(a.out + O_CKV + (size_t)row * KVLORA + lane * 4) = kv;
                    if (lane < 32) a.out[O_KROPE + (size_t)row * 32 + lane] = bf2f(krw[q]); } } }
}
__device__ __forceinline__ void p5_headnorm(const Args& a, int gw, int NGW, int lane) {
    unsigned char* ws = a.ws; bf16_t* QB = (bf16_t*)(ws + WS_Q); const bf16_t* KVR = (const bf16_t*)(ws + WS_KVRAW); bf16_t* KB = (bf16_t*)(ws + WS_K);
    const bf16_t* PROJ = (const bf16_t*)(ws + WS_PROJ); const float* rope = (const float*)(ws + WS_ROPE);
    const int half = lane >> 5, hh = (lane >> 2) & 7, q4 = lane & 3;
    const bf16_t* KRC = (const bf16_t*)(ws + WS_KRC);
    constexpr int NP5 = (M + MKV) / 2;
    for (int p0 = gw; p0 < NP5; p0 += 2 * NGW) {
        u32x4 raw[2][3];
#pragma unroll
        for (int q = 0; q < 2; ++q) { const int p = p0 + q * NGW; if (p < NP5) {
            const int idx = 2 * p + half; const bool isq = idx < M; const int kr = isq ? idx : idx - M;
            if (isq) { const bf16_t* src = QB + (size_t)kr * NQ + hh * 96 + q4 * 24;
#pragma unroll
                for (int i = 0; i < 3; ++i) raw[q][i] = *(const u32x4*)(src + 8 * i);
            } else {
#pragma unroll
                for (int i = 0; i < 3; ++i) { const int ci = 3 * q4 + i;
                    const bf16_t* src = ci < 8 ? KVR + (size_t)kr * NKV + hh * 128 + 8 * ci : (kr < M ? PROJ + (size_t)kr * NINP + C_KROPE + 8 * (ci - 8) : KRC + (size_t)(kr - M) * 32 + 8 * (ci - 8));
                    raw[q][i] = *(const u32x4*)src; } } } }
#pragma unroll
        for (int q = 0; q < 2; ++q) { const int p = p0 + q * NGW; if (p < NP5) {
            const int idx = 2 * p + half; const bool isq = idx < M; const int kr = isq ? idx : idx - M;
            float v[24];
#pragma unroll
            for (int i = 0; i < 3; ++i) unpack8(raw[q][i], v + 8 * i);
            const float* g = isq ? a.in[I_QHG] : a.in[I_KHG];
            bf16_t* dst = isq ? QB + (size_t)kr * NQ + hh * 96 + q4 * 24 : KB + (size_t)kr * NQ + hh * 96 + q4 * 24;
            const bool dorope = kr >= MC && kr < M;
            float s = 0.f;
#pragma unroll
            for (int i = 0; i < 24; ++i) s += v[i] * v[i];
            s += __shfl_xor(s, 1); s += __shfl_xor(s, 2);
            const float rstd = 1.0f / sqrtf(s * (1.0f / 96.0f) + EPS);
#pragma unroll
            for (int i = 0; i < 24; ++i) v[i] *= rstd * g[q4 * 24 + i];
            float snd[8], rcv[8];
#pragma unroll
            for (int j = 0; j < 8; ++j) { snd[j] = (q4 == 2) ? v[16 + j] : v[8 + j]; rcv[j] = __shfl_xor(snd[j], 1); }
            if (dorope && q4 >= 2) { const float* cs = rope + (size_t)((kr - MC) & (TL - 1)) * 32;
                if (q4 == 2) {
#pragma unroll
                    for (int j = 0; j < 8; ++j) v[16 + j] = v[16 + j] * cs[j] - rcv[j] * cs[16 + j];
                } else {
#pragma unroll
                    for (int j = 0; j < 8; ++j) { const float x1 = v[j], x2 = v[16 + j], c = cs[8 + j], sn = cs[24 + j]; v[j] = x1 * c - x2 * sn; v[16 + j] = x1 * sn + x2 * c;
                        v[8 + j] = rcv[j] * cs[16 + j] + v[8 + j] * cs[j]; }
                } }
#pragma unroll
            for (int i = 0; i < 3; ++i) *(u32x4*)(dst + 8 * i) = pack8(v + 8 * i);
        } }
    }
}
__device__ __forceinline__ void p6b_hm(const Args& a, int gw, int NGW, int lane) {
    unsigned char* ws = a.ws; const bf16_t* HF = (const bf16_t*)a.out; const bf16_t* HB = HF + (size_t)M * 512; const bf16_t* PROJ = (const bf16_t*)(ws + WS_PROJ); bf16_t* A2 = (bf16_t*)(ws + WS_H);
    float mg[8];
#pragma unroll
    for (int e = 0; e < 8; ++e) mg[e] = a.in[I_MNG][lane * 8 + e];
    for (int row0 = gw; row0 < M; row0 += 2 * NGW) {
        u32x4 rf[2], rb_[2], ro[2];
#pragma unroll
        for (int q = 0; q < 2; ++q) { const int row = row0 + q * NGW; if (row < M) {
            rf[q] = *(const u32x4*)(HF + (size_t)row * 512 + lane * 8); rb_[q] = *(const u32x4*)(HB + (size_t)row * 512 + lane * 8);
            ro[q] = *(const u32x4*)(PROJ + (size_t)row * NINP + C_MO + lane * 8); } }
#pragma unroll
        for (int q = 0; q < 2; ++q) { const int row = row0 + q * NGW; if (row < M) {
            float f[8], b[8], o[8]; unpack8(rf[q], f); unpack8(rb_[q], b); unpack8(ro[q], o);
            float s = 0.f;
#pragma unroll
            for (int e = 0; e < 8; ++e) { f[e] += b[e]; s += f[e] * f[e]; }
            s += __shfl_xor(s, 1); s += __shfl_xor(s, 2); s += __shfl_xor(s, 4); s += __shfl_xor(s, 8);
            const float rstd = 1.0f / sqrtf(s * (1.0f / 128.0f) + EPS);
#pragma unroll
            for (int e = 0; e < 8; ++e) f[e] = f[e] * rstd * mg[e] / (1.0f + __expf(-o[e]));
            *(u32x4*)(A2 + (size_t)row * DM + lane * 8) = pack8(f); } }
    }
}

namespace att {
constexpr int QBLK = 32, KVBLK = 64;
constexpr float SCALE = 0.10206207261596577f;
constexpr float THR = 8.f;
constexpr int SHM_V = 64 * 128 * 2, SHM_K = 64 * 256;
constexpr int LDS_ATT = 2 * SHM_V + 2 * SHM_K + 8 * 64 * 4;
#define KSWZ(row, colB) ((row) * 256 + ((colB) ^ (((row) & 7) << 4)))
__device__ __forceinline__ int crow(int r, int hi) { return (r & 3) + 8 * (r >> 2) + 4 * hi; }
__device__ __forceinline__ void partialSM(f32x16& p0, f32x16& p1, float& m_reg, float& mn, float& alpha) {
  constexpr float C = SCALE * 1.4426950408889634f;
  float pmax = p0[0];
#pragma unroll
  for (int r = 1; r < 16; ++r) pmax = fmaxf(pmax, p0[r]);
#pragma unroll
  for (int r = 0; r < 16; ++r) pmax = fmaxf(pmax, p1[r]);
  { auto rr = __builtin_amdgcn_permlane32_swap(__float_as_uint(pmax), __float_as_uint(pmax), false, false);
    pmax = fmaxf(__uint_as_float(rr[0]), __uint_as_float(rr[1])); }
  if (__builtin_expect(__all(pmax - m_reg <= THR / SCALE), 1)) { mn = m_reg; alpha = 1.f; }
  else { mn = fmaxf(m_reg, pmax); alpha = __builtin_amdgcn_exp2f((m_reg - mn) * C); m_reg = mn; }
  float mnC = -mn * C;
#pragma unroll
  for (int r = 0; r < 16; ++r) p0[r] = fmaf(p0[r], C, mnC);
#pragma unroll
  for (int r = 0; r < 16; ++r) p1[r] = fmaf(p1[r], C, mnC);
#pragma unroll
  for (int r = 0; r < 16; ++r) p0[r] = __builtin_amdgcn_exp2f(p0[r]);
}
__device__ __forceinline__ void finishSM(f32x16& p0, f32x16& p1, float alpha, float& l_reg, bf16x8& pa0, bf16x8& pa1, bf16x8& pa2, bf16x8& pa3) {
#pragma unroll
  for (int r = 0; r < 16; ++r) p1[r] = __builtin_amdgcn_exp2f(p1[r]);
  float ps = 0;
#pragma unroll
  for (int r = 0; r < 16; ++r) ps += p0[r];
#pragma unroll
  for (int r = 0; r < 16; ++r) ps += p1[r];
  { auto rr = __builtin_amdgcn_permlane32_swap(__float_as_uint(ps), __float_as_uint(ps), false, false);
    ps = __uint_as_float(rr[0]) + __uint_as_float(rr[1]); }
  l_reg = l_reg * alpha + ps;
#define PK4(P, BASE, OUT) do { unsigned a0 = cvt_pk_bf16(P[BASE + 0], P[BASE + 1]), a1 = cvt_pk_bf16(P[BASE + 2], P[BASE + 3]);   \
    unsigned b0 = cvt_pk_bf16(P[BASE + 4], P[BASE + 5]), b1 = cvt_pk_bf16(P[BASE + 6], P[BASE + 7]);                              \
    auto r0 = __builtin_amdgcn_permlane32_swap(a0, b0, false, false); auto r1 = __builtin_amdgcn_permlane32_swap(a1, b1, false, false); \
    u32x4 w = {r0[0], r1[0], r0[1], r1[1]}; OUT = *reinterpret_cast<bf16x8*>(&w); } while (0)
  PK4(p0, 0, pa0); PK4(p0, 8, pa1); PK4(p1, 0, pa2); PK4(p1, 8, pa3);
#undef PK4
}
__device__ __forceinline__ void qkt(f32x16& p0, f32x16& p1, const char* Ks, const bf16x8* qr, int r32, int hi) {
  p0 = f32x16{}; p1 = f32x16{};
#pragma unroll
  for (int d0 = 0; d0 < 6; ++d0) { int cb = (d0 * 16 + hi * 8) * 2;
    bf16x8 b0 = *reinterpret_cast<const bf16x8*>(Ks + KSWZ(r32, cb));
    bf16x8 b1 = *reinterpret_cast<const bf16x8*>(Ks + KSWZ(32 + r32, cb));
    p0 = __builtin_amdgcn_mfma_f32_32x32x16_bf16(b0, qr[d0], p0, 0, 0, 0);
    p1 = __builtin_amdgcn_mfma_f32_32x32x16_bf16(b1, qr[d0], p1, 0, 0, 0); }
}
__device__ __forceinline__ int v_st(int k, int c) { const int kk = (k & ~0xC) | ((k & 4) << 1) | ((k & 8) >> 1); return ((kk >> 3) * 4 + (c >> 5)) * 512 + ((kk & 7) * 32 + (c & 31)) * 2; }
__device__ __forceinline__ int v_rd_base(int lane) { return ((lane & 3) << 3) | (((lane >> 2) & 3) << 6) | (((lane >> 4) & 1) << 5) | (((lane >> 5) & 1) << 8); }
constexpr int v_rd_off(int d0, int ks, int half) { return d0 * 512 + ks * 4096 + half * 2048; }
template <int OFF> __device__ __forceinline__ s16x4 tr_read(int vb) {
  s16x4 r; asm volatile("ds_read_b64_tr_b16 %0, %1 offset:%2" : "=&v"(r) : "v"(vb), "i"(OFF) : "memory"); return r;
}
template <int D0> __device__ __forceinline__ void pv_one(f32x16& od, int vb, bf16x8 pa0, bf16x8 pa1, bf16x8 pa2, bf16x8 pa3) {
  const s16x4 l0 = tr_read<v_rd_off(D0, 0, 0)>(vb), h0 = tr_read<v_rd_off(D0, 0, 1)>(vb), l1 = tr_read<v_rd_off(D0, 1, 0)>(vb), h1 = tr_read<v_rd_off(D0, 1, 1)>(vb);
  const s16x4 l2 = tr_read<v_rd_off(D0, 2, 0)>(vb), h2 = tr_read<v_rd_off(D0, 2, 1)>(vb), l3 = tr_read<v_rd_off(D0, 3, 0)>(vb), h3 = tr_read<v_rd_off(D0, 3, 1)>(vb);
  asm volatile("s_waitcnt lgkmcnt(0)" ::: "memory"); SBAR();
  od = __builtin_amdgcn_mfma_f32_32x32x16_bf16(pa0, MK8(l0, h0), od, 0, 0, 0);
  od = __builtin_amdgcn_mfma_f32_32x32x16_bf16(pa1, MK8(l1, h1), od, 0, 0, 0);
  od = __builtin_amdgcn_mfma_f32_32x32x16_bf16(pa2, MK8(l2, h2), od, 0, 0, 0);
  od = __builtin_amdgcn_mfma_f32_32x32x16_bf16(pa3, MK8(l3, h3), od, 0, 0, 0);
}
__device__ __forceinline__ void pv_d0(f32x16* o, int vb, bf16x8 pa0, bf16x8 pa1, bf16x8 pa2, bf16x8 pa3) {
  pv_one<0>(o[0], vb, pa0, pa1, pa2, pa3); pv_one<1>(o[1], vb, pa0, pa1, pa2, pa3);
}
__device__ __forceinline__ void attn_unit(const bf16_t* __restrict__ Qg, const bf16_t* __restrict__ Kg, const bf16_t* __restrict__ Vg, bf16_t* __restrict__ Og,
                                          int qrow0, int h, int rowA, int ntA, int rowB, int NT, char* lds, const int wid) {
  const int lane = fresh_lane(), tid = wid * 64 + lane, r32 = lane & 31, hi = lane >> 5;
  char* V_lds = lds; char* K_lds = lds + 2 * SHM_V;
  float* ws = (float*)(lds + 2 * SHM_V + 2 * SHM_K) + wid * 64; float* li_l = ws; float* al_l = ws + 32;
  float m_reg = -1e30f, l_reg = 0; f32x16 o[2] = {}; bf16x8 qr[6];
  const bf16_t* Qw = Qg + (size_t)(qrow0 + wid * QBLK + r32) * NQ + h * 96 + hi * 8;
#pragma unroll
  for (int d0 = 0; d0 < 6; ++d0) qr[d0] = *reinterpret_cast<const bf16x8*>(Qw + d0 * 16);
  const int sr = tid >> 4, sc = (tid & 15) * 8, vst0 = v_st(sr, sc), vst1 = v_st(32 + sr, sc);
  const int vb0 = (int)(uintptr_t)V_lds + v_rd_base(lane);
  const bf16_t* Kh = Kg + h * 96 + sc; const bf16_t* Vh = Vg + h * 128 + 64 + sc;
  struct { bf16x8 vs0, vs1, ks0, ks1; } sr_[2];
#define TROW(j) ((j) < ntA ? rowA + (j) * KVBLK : rowB + ((j) - ntA) * KVBLK)
#define SLOAD(i, j) do { const size_t r0_ = (size_t)(TROW(j) + sr); \
    sr_[i].vs0 = *reinterpret_cast<const bf16x8*>(Vh + r0_ * NKV); sr_[i].vs1 = *reinterpret_cast<const bf16x8*>(Vh + (r0_ + 32) * NKV); \
    sr_[i].ks0 = *reinterpret_cast<const bf16x8*>(Kh + r0_ * NQ); sr_[i].ks1 = *reinterpret_cast<const bf16x8*>(Kh + (r0_ + 32) * NQ); } while (0)
#define SWRITE(b, i) do { *(bf16x8*)(V_lds + (b) * SHM_V + vst0) = sr_[i].vs0;          \
    *(bf16x8*)(V_lds + (b) * SHM_V + vst1) = sr_[i].vs1; int kc = sc * 2;               \
    *(bf16x8*)(K_lds + (b) * SHM_K + KSWZ(sr, kc)) = sr_[i].ks0;                       \
    *(bf16x8*)(K_lds + (b) * SHM_K + KSWZ(32 + sr, kc)) = sr_[i].ks1; } while (0)
#define SWAIT() asm volatile("s_waitcnt vmcnt(4)" ::: "memory")
#define RESC(a) do { if (__any((a) < 1.f)) { if (hi == 0) al_l[r32] = (a); asm volatile("s_waitcnt lgkmcnt(0)" ::: "memory"); \
    _Pragma("unroll") for (int d = 0; d < 2; ++d) _Pragma("unroll") for (int r = 0; r < 16; ++r) o[d][r] *= al_l[crow(r, hi)]; } } while (0)
  f32x16 pA0, pA1, pB0, pB1; float mnA, mnB, alA, alB; bf16x8 pa0, pa1, pa2, pa3;
  constexpr int SE = 0, SO = 1;
  SLOAD(SE, 0); asm volatile("s_waitcnt vmcnt(0)" ::: "memory"); SWRITE(0, SE); __syncthreads();
  qkt(pA0, pA1, K_lds, qr, r32, hi); partialSM(pA0, pA1, m_reg, mnA, alA);
  SLOAD(SO, 1); if (2 < NT) SLOAD(SE, 2);
  SWAIT(); SWRITE(1, SO); __syncthreads();
  for (int j = 1; j + 1 < NT; j += 2) {
    SBAR(); qkt(pB0, pB1, K_lds + SHM_K, qr, r32, hi);
    finishSM(pA0, pA1, alA, l_reg, pa0, pa1, pa2, pa3); SBAR();
    SLOAD(SO, j + 2); SBAR();
    pv_d0(o, vb0, pa0, pa1, pa2, pa3); partialSM(pB0, pB1, m_reg, mnB, alB);
    __syncthreads(); SWAIT(); SWRITE(0, SE);
    RESC(alB); __syncthreads();
    SBAR(); qkt(pA0, pA1, K_lds, qr, r32, hi);
    finishSM(pB0, pB1, alB, l_reg, pa0, pa1, pa2, pa3); SBAR();
    if (j + 3 < NT) SLOAD(SE, j + 3); SBAR();
    pv_d0(o, vb0 + SHM_V, pa0, pa1, pa2, pa3); partialSM(pA0, pA1, m_reg, mnA, alA);
    __syncthreads(); SWAIT(); SWRITE(1, SO);
    RESC(alA); __syncthreads();
  }
  SBAR(); qkt(pB0, pB1, K_lds + SHM_K, qr, r32, hi);
  finishSM(pA0, pA1, alA, l_reg, pa0, pa1, pa2, pa3); SBAR();
  pv_d0(o, vb0, pa0, pa1, pa2, pa3); partialSM(pB0, pB1, m_reg, mnB, alB);
  __syncthreads(); RESC(alB);
  finishSM(pB0, pB1, alB, l_reg, pa0, pa1, pa2, pa3); SBAR();
  pv_d0(o, vb0 + SHM_V, pa0, pa1, pa2, pa3);
  if (hi == 0) li_l[r32] = l_reg; asm volatile("s_waitcnt lgkmcnt(0)" ::: "memory");
  float rli[16];
#pragma unroll
  for (int r = 0; r < 16; ++r) rli[r] = __builtin_amdgcn_rcpf(li_l[crow(r, hi)]);
  bf16_t* Ow = Og + (size_t)(qrow0 + wid * QBLK) * DM + 512 + h * 64;
#pragma unroll
  for (int r = 0; r < 16; ++r) { const int orow = crow(r, hi);
#pragma unroll
    for (int d0 = 0; d0 < 2; ++d0) Ow[(size_t)orow * DM + d0 * 32 + r32] = (bf16_t)(cvt_pk_bf16(o[d0][r] * rli[r], 0.f) & 0xffffu); }
  __syncthreads();
#undef TROW
#undef SLOAD
#undef SWRITE
#undef SWAIT
#undef RESC
}
}

namespace ml {
constexpr int PQ = 272, PP = 144;
constexpr int OFF_Q = 0, OFF_K = 17408, OFF_V = 34816, OFF_W = 52224  , OFF_P = 69632, OFF_CB = 78848, OFF_N = 113664, OFF_QN = 114176, OFF_DP = 114432, OFF_NP = 114944,
              OFF_AA = 116992  , OFF_AC = 125184  , OFF_AB = 133376  , OFF_MC = 141568  , LDS_ML = 141824;
__device__ __forceinline__ f32x4 mfma16(bf16x8 a, bf16x8 b, f32x4 c) { return __builtin_amdgcn_mfma_f32_16x16x32_bf16(a, b, c, 0, 0, 0); }
__device__ __forceinline__ u32x2 pack4(f32x4 v) { u32x2 w; w.x = cvt_pk_bf16(v.x, v.y); w.y = cvt_pk_bf16(v.z, v.w); return w; }

__device__ __forceinline__ void mlstm_seq(const Args& a, LAS unsigned char* lds, int kind, int b, int h, int dir, const int wave) {
    const int lane = fresh_lane(), tid = wave * 64 + lane, g = lane >> 4, i = lane & 15;
    const int T = kind ? TL : TC, nc = T / 64, rowbase = kind ? MC + b * TL : b * TC;
    const bf16_t* PROJ = (const bf16_t*)(a.ws + WS_PROJ); const float* gates = (const float*)(a.ws + WS_GATES);
    bf16_t* Hout = (bf16_t*)a.out + (dir ? (size_t)M * 512 : 0);
#define ROWP(p) (rowbase + (dir ? T - 1 - (p) : (p)))
    LAS float* const sa = (LAS float*)(lds + OFF_AA); LAS float* const sA = (LAS float*)(lds + OFF_AC); LAS float* const sbb = (LAS float*)(lds + OFF_AB); LAS float* const smc = (LAS float*)(lds + OFF_MC);
    const int s0 = tid >> 4, c8 = tid & 15;
    u32x4 pq[2], pk[2], pv[2];
#define LOADCH(c) do { _Pragma("unroll") for (int e = 0; e < 2; ++e) { const bf16_t* rp = PROJ + (size_t)ROWP(64 * (c) + s0 + 32 * e) * NINP + h * 128 + c8 * 8; \
        pq[e] = *(const u32x4*)(rp + C_MQ); pk[e] = *(const u32x4*)(rp + C_MK); pv[e] = *(const u32x4*)(rp + C_MV); } } while (0)
    LOADCH(0);
    { const float gb_i = a.in[I_GATEB][dir * 8 + h], gb_f = a.in[I_GATEB][dir * 8 + 4 + h];
      for (int c = wave; c < nc; c += 8) { const float* gp = gates + (size_t)ROWP(64 * c + lane) * 16 + dir * 8 + h;
        const float gi = gp[0] + gb_i, gf = gp[4] + gb_f;
        const float lf = fminf(gf, 0.f) - log1pf(__expf(-fabsf(gf))); float bs = lf;
#pragma unroll
        for (int o = 1; o < 64; o <<= 1) { const float t = __shfl_up(bs, o); if (lane >= o) bs += t; }
        const float av = gi - bs; float A = av;
#pragma unroll
        for (int o = 1; o < 64; o <<= 1) { const float t = __shfl_up(A, o); if (lane >= o) A = fmaxf(A, t); }
        sa[64 * c + lane] = av; sA[64 * c + lane] = A; sbb[64 * c + lane] = bs; } }
    const int v0 = wave * 16;
    f32x4 accC[8];
    const size_t sidx = (size_t)((b * 2 + dir) * 4 + h);
    LAS float* nl = (LAS float*)(lds + OFF_N);
    if (kind) { const float* C0 = a.in[I_SC] + sidx * 16384;
#pragma unroll
        for (int kb = 0; kb < 8; ++kb) accC[kb] = *(const f32x4*)(C0 + (size_t)(16 * kb + i) * 128 + v0 + 4 * g);
        if (tid < 128) nl[tid] = a.in[I_SN][sidx * 128 + tid];
    } else {
#pragma unroll
        for (int kb = 0; kb < 8; ++kb) accC[kb] = (f32x4){0.f, 0.f, 0.f, 0.f};
        if (tid < 128) nl[tid] = 0.f;
    }
#pragma unroll
    for (int kb = 0; kb < 8; ++kb) *(LAS u32x2*)(lds + OFF_CB + (16 * kb + i) * PQ + (v0 + 4 * g) * 2) = pack4(accC[kb]);
    __syncthreads();
    f32x4 accN = (f32x4){0.f, 0.f, 0.f, 0.f}; if (g == 0) accN[0] = nl[16 * wave + i];
    if (wave == 0) { const int cc = lane < nc ? lane : 0; const float b63 = sbb[64 * cc + 63], A63 = sA[64 * cc + 63]; float m = kind ? a.in[I_SM][sidx] : 0.f;
        for (int c = 0; c < nc; ++c) { if (lane == c) smc[c] = m; m = __shfl(b63, c) + fmaxf(m, __shfl(A63, c)); }
        if (lane == 0) smc[nc] = m; }
    __syncthreads();
    for (int c = 0; c < nc; ++c) {
        const float m_c = smc[c]; const float M63 = fmaxf(m_c, sA[64 * c + 63]); const float decay = __expf(m_c - M63);
#pragma unroll
        for (int e = 0; e < 2; ++e) { const int off = (s0 + 32 * e) * PQ + c8 * 16;
            *(LAS u32x4*)(lds + OFF_Q + off) = pq[e]; *(LAS u32x4*)(lds + OFF_K + off) = pk[e]; *(LAS u32x4*)(lds + OFF_V + off) = pv[e]; }
        if (tid < 64) ((LAS float*)(lds + OFF_W))[tid] = __expf(sa[64 * c + tid] - M63);
        __syncthreads();
        if (c + 1 < nc) LOADCH(c + 1);
        {
            const int tb = wave >> 1, t = 16 * tb + i; const float Mt = fmaxf(m_c, sA[64 * c + t]); float rs = 0.f;
            bf16x8 qf[4], kf0[4], kf1[4];
#pragma unroll
            for (int kk = 0; kk < 4; ++kk) { qf[kk] = *(const LAS bf16x8*)(lds + OFF_Q + t * PQ + (32 * kk + 8 * g) * 2);
                kf0[kk] = *(const LAS bf16x8*)(lds + OFF_K + (32 * (wave & 1) + i) * PQ + (32 * kk + 8 * g) * 2);
                kf1[kk] = *(const LAS bf16x8*)(lds + OFF_K + (32 * (wave & 1) + 16 + i) * PQ + (32 * kk + 8 * g) * 2); }
            const int tq = tid >> 3, part = tid & 7; float qn_q[16];
            unpack8(*(const LAS u32x4*)(lds + OFF_Q + tq * PQ + part * 32), qn_q); unpack8(*(const LAS u32x4*)(lds + OFF_Q + tq * PQ + part * 32 + 16), qn_q + 8);
            f32x4 acc0 = (f32x4){0.f, 0.f, 0.f, 0.f}, acc1 = (f32x4){0.f, 0.f, 0.f, 0.f};
#pragma unroll
            for (int kk = 0; kk < 4; ++kk) { acc0 = mfma16(kf0[kk], qf[kk], acc0); acc1 = mfma16(kf1[kk], qf[kk], acc1); }
            float d = 0.f;
#pragma unroll
            for (int x = 0; x < 16; ++x) d += qn_q[x] * nl[part * 16 + x];
            d += __shfl_xor(d, 1); d += __shfl_xor(d, 2); d += __shfl_xor(d, 4);
            if (part == 0) ((LAS float*)(lds + OFF_QN))[tq] = d;
#pragma unroll
            for (int u = 0; u < 2; ++u) { const int sblk = 2 * (wave & 1) + u; const f32x4 acc = u ? acc1 : acc0; f32x4 p;
#pragma unroll
                for (int r = 0; r < 4; ++r) { const int s = 16 * sblk + 4 * g + r; const float wv = __expf(sa[64 * c + s] - Mt); p[r] = (s <= t) ? acc[r] * wv : 0.f; rs += p[r]; }
                *(LAS u32x2*)(lds + OFF_P + t * PP + (16 * sblk + 4 * g) * 2) = pack4(p); }
            rs += __shfl_xor(rs, 16); rs += __shfl_xor(rs, 32);
            if (g == 0) ((LAS float*)(lds + OFF_DP))[(wave & 1) * 64 + t] = rs;
        }
        __syncthreads();
        {
            const LAS unsigned char* vtr = lds + OFF_V + (8 * g + (i >> 2)) * PQ + (v0 + 4 * (i & 3)) * 2;
            const LAS unsigned char* ctr = lds + OFF_CB + (8 * g + (i >> 2)) * PQ + (v0 + 4 * (i & 3)) * 2;
            bf16x8 vfr[2], pf[2][4], cf[4];
            f32x4 w8[2][2];
#pragma unroll
            for (int kk = 0; kk < 2; ++kk) { const s16x4 lo = tr16(vtr + 32 * kk * PQ), hi_ = tr16(vtr + (32 * kk + 4) * PQ); vfr[kk] = MK8(lo, hi_);
                w8[kk][0] = *(const LAS f32x4*)(lds + OFF_W + (32 * kk + 8 * g) * 4); w8[kk][1] = *(const LAS f32x4*)(lds + OFF_W + (32 * kk + 8 * g + 4) * 4);
#pragma unroll
                for (int tb = 0; tb < 4; ++tb) pf[kk][tb] = *(const LAS bf16x8*)(lds + OFF_P + (16 * tb + i) * PP + (32 * kk + 8 * g) * 2); }
#pragma unroll
            for (int kk = 0; kk < 4; ++kk) { const s16x4 lo = tr16(ctr + 32 * kk * PQ), hi_ = tr16(ctr + (32 * kk + 4) * PQ); cf[kk] = MK8(lo, hi_); }
            f32x4 intra[4], inter[4];
#pragma unroll
            for (int tb = 0; tb < 4; ++tb) { intra[tb] = (f32x4){0.f, 0.f, 0.f, 0.f}; inter[tb] = (f32x4){0.f, 0.f, 0.f, 0.f}; }
#pragma unroll
            for (int kk = 0; kk < 2; ++kk)
#pragma unroll
                for (int tb = 0; tb < 4; ++tb) intra[tb] = mfma16(vfr[kk], pf[kk][tb], intra[tb]);
#pragma unroll
            for (int kk = 0; kk < 4; ++kk) { bf16x8 qf[4];
#pragma unroll
                for (int tb = 0; tb < 4; ++tb) qf[tb] = *(const LAS bf16x8*)(lds + OFF_Q + (16 * tb + i) * PQ + (32 * kk + 8 * g) * 2);
#pragma unroll
                for (int tb = 0; tb < 4; ++tb) inter[tb] = mfma16(cf[kk], qf[tb], inter[tb]); }
            bf16x8 vfw[2], onw[2];
#pragma unroll
            for (int kk = 0; kk < 2; ++kk) { float vf[8]; unpack8(__builtin_bit_cast(u32x4, vfr[kk]), vf); float wv[8];
#pragma unroll
                for (int x = 0; x < 4; ++x) { wv[x] = w8[kk][0][x]; wv[4 + x] = w8[kk][1][x]; }
#pragma unroll
                for (int x = 0; x < 8; ++x) vf[x] *= wv[x];
                vfw[kk] = __builtin_bit_cast(bf16x8, pack8(vf));
                u32x4 ow = pack8(wv); if (i != 0) ow = (u32x4){0u, 0u, 0u, 0u}; onw[kk] = __builtin_bit_cast(bf16x8, ow); }
#pragma unroll
            for (int kb = 0; kb < 8; ++kb) { accC[kb] = accC[kb] * decay; bf16x8 kfr[2];
#pragma unroll
                for (int kk = 0; kk < 2; ++kk) { const LAS unsigned char* kp = lds + OFF_K + (32 * kk + 8 * g + (i >> 2)) * PQ + (16 * kb + 4 * (i & 3)) * 2;
                    const s16x4 lo = tr16(kp), hi_ = tr16(kp + 4 * PQ); kfr[kk] = MK8(lo, hi_); }
                accC[kb] = mfma16(vfw[0], kfr[0], accC[kb]); accC[kb] = mfma16(vfw[1], kfr[1], accC[kb]);
                if (kb == wave) { accN = accN * decay; accN = mfma16(onw[0], kfr[0], accN); accN = mfma16(onw[1], kfr[1], accN); } }
            const LAS float* dp = (const LAS float*)(lds + OFF_DP); const LAS float* qn = (const LAS float*)(lds + OFF_QN);
#pragma unroll
            for (int tb = 0; tb < 4; ++tb) { const int t = 16 * tb + i; const float Mt = fmaxf(m_c, sA[64 * c + t]); const float wi = __expf(m_c - Mt);
                const float den = dp[t] + dp[64 + t] + wi * qn[t]; const float inv = 1.0f / fmaxf(fabsf(den), __expf(-(sbb[64 * c + t] + Mt)));
                const f32x4 hv = (intra[tb] + inter[tb] * wi) * inv;
                *(u32x2*)(Hout + (size_t)ROWP(64 * c + t) * 512 + h * 128 + v0 + 4 * g) = pack4(hv); }
        }
        __syncthreads();
#pragma unroll
        for (int kb = 0; kb < 8; ++kb) *(LAS u32x2*)(lds + OFF_CB + (16 * kb + i) * PQ + (v0 + 4 * g) * 2) = pack4(accC[kb]);
        if (g == 0) nl[16 * wave + i] = accN[0];
    }
    if (kind == 0) {
        float* oC = a.out + O_C + sidx * 16384;
#pragma unroll
        for (int kb = 0; kb < 8; ++kb) *(f32x4*)(oC + (size_t)(16 * kb + i) * 128 + v0 + 4 * g) = accC[kb];
        if (g == 0) a.out[O_N + sidx * 128 + 16 * wave + i] = accN[0];
        if (tid == 0) a.out[O_M + sidx] = smc[nc];
    }
    __syncthreads();
#undef ROWP
#undef LOADCH
}
}

constexpr int NPH = 10;
#ifndef LAUNCH_LIST
#define LAUNCH_LIST {0, 10}
#endif
constexpr int Q_NITEMS = 800;

__global__ void __launch_bounds__(NTHREADS, 2) fwd_megakernel(Args args) {
    extern __shared__ __attribute__((aligned(16))) unsigned char lds_raw[];
    LAS unsigned char* lds = (LAS unsigned char*)lds_raw;
    volatile LAS unsigned* MISC = (volatile LAS unsigned*)(lds + MISC_OFF);
    const int wave = __builtin_amdgcn_readfirstlane(threadIdx.x >> 6);
#define tid (wave * 64 + lane)
    const int G = gridDim.x, bx = blockIdx.x;
    unsigned char* ws = args.ws;
    unsigned* ctl = (unsigned*)(ws + WS_CTL);
    { const int lane = fresh_lane();
    for (int u = tid; u < (LDS_BYTES - LDSCTL_OFF) / 4; u += NTHREADS) ((LAS unsigned*)(lds + LDSCTL_OFF))[u] = 0u; }
    __syncthreads();
    XcdBarrier bar = xcd_barrier_post(ctl + CW_BAR + args.li * XCD_BAR_WORDS, MISC + 8, (unsigned)wave);
    const int lo = args.ph_lo, hi = args.ph_hi;
#define IN(k) (lo <= (k) && (k) < hi)
#define SEAM(k) do { if (IN(k) && IN((k) + 1)) xcd_barrier(bar); } while (0)
    const int gw = bx * NWAVES + wave, NGW = G * NWAVES;
    bf16_t* const HBUF = (bf16_t*)(ws + WS_H);
    float* const MOD = (float*)(ws + WS_MOD);
    bf16_t* const X1 = (bf16_t*)(ws + WS_X1);

    if (IN(0)) { const int lane = fresh_lane(); p0_prologue(args, lds, tid, lane, wave, G); SEAM(0); }
    if (IN(1)) { const int lane = fresh_lane(); norm_rows(args.in[I_XP], args.in[I_XS], args.in[I_N1G], MOD, 0, 1024, HBUF, gw, NGW, lane); SEAM(1); }
    if (IN(2)) {
        pg8::Gemm g{HBUF, (const bf16_t*)(ws + WS_WIN), M, NINP, DM}; pg8::StaticOrder S; S.init(M, NINP, G, bx);
        pg8::EpiProj E{(bf16_t*)(ws + WS_PROJ), (float*)(ws + WS_GATES)};
        pg8::gemm_phase<pg8::EpiProj, pg8::StaticOrder, true, true>(lds, g, S, E, wave);
        for (int it = (G == 256) ? (bx >= 192 ? bx - 192 : 64) : bx; it < 64; it += G) { const int lane = fresh_lane(); gemv5_item<1>(MOD, nullptr, args.in[I_WUP], nullptr, (float*)(ws + WS_BIAS2), lds, it, tid, lane, wave); }
        if (G == 256 && bx >= 192 && bx < 208) {
            int kkv = KVLORA; asm volatile("" : "+s"(kkv));
            pg8::Gemm g{(const bf16_t*)(ws + WS_CKVC), (const bf16_t*)(ws + WS_WKV), NBL * 256, NKV, kkv}; pg8::StaticOrder S; S.init(NBL * 256, NKV, 16, bx - 192);
            pg8::EpiHead<1> E{(bf16_t*)(ws + WS_K), (bf16_t*)(ws + WS_KVRAW), args.in[I_KHG], (const bf16_t*)(ws + WS_PROJ), (const bf16_t*)(ws + WS_KRC), (pg8::PG8_LAS_float_ptr)(lds + RING_BYTES), M};
            pg8::gemm_phase<pg8::EpiHead<1>, pg8::StaticOrder, true, true>(lds, g, S, E, wave); }
        SEAM(2);
    }
    if (IN(3)) { const int lane = fresh_lane(); p3_rows(args, gw, NGW, lane, bx * NTHREADS + tid, G * NTHREADS); SEAM(3); }
    if (IN(4)) {
        pg8::PG8_LAS_float_ptr Xl = (pg8::PG8_LAS_float_ptr)(lds + RING_BYTES);
        int kq = QLORA, kkv = KVLORA; asm volatile("" : "+s"(kq), "+s"(kkv));
        { pg8::Gemm g{(const bf16_t*)(ws + WS_QN), (const bf16_t*)(ws + WS_WQ), M, NQP, kq}; pg8::StaticOrder S; S.init(M, NQP, G, bx);
          pg8::EpiHead<0> E{(bf16_t*)(ws + WS_Q), nullptr, args.in[I_QHG], nullptr, nullptr, Xl, 0};
          pg8::gemm_phase<pg8::EpiHead<0>, pg8::StaticOrder, true, true>(lds, g, S, E, wave); }
        { pg8::Gemm g{(const bf16_t*)(ws + WS_CKVN), (const bf16_t*)(ws + WS_WKV), M, NKV, kkv}; pg8::StaticOrder S; S.init(M, NKV, G, bx);
          pg8::EpiHead<1> E{(bf16_t*)(ws + WS_K), (bf16_t*)(ws + WS_KVRAW), args.in[I_KHG], (const bf16_t*)(ws + WS_PROJ), (const bf16_t*)(ws + WS_KRC), Xl, 0};
          pg8::gemm_phase<pg8::EpiHead<1>, pg8::StaticOrder, true, true>(lds, g, S, E, wave); }
        if (G != 256) {
            pg8::Gemm g{(const bf16_t*)(ws + WS_CKVC), (const bf16_t*)(ws + WS_WKV), NBL * 256, NKV, kkv}; pg8::StaticOrder S; S.init(NBL * 256, NKV, G, bx);
            pg8::EpiHead<1> E{(bf16_t*)(ws + WS_K), (bf16_t*)(ws + WS_KVRAW), args.in[I_KHG], (const bf16_t*)(ws + WS_PROJ), (const bf16_t*)(ws + WS_KRC), Xl, M};
            pg8::gemm_phase<pg8::EpiHead<1>, pg8::StaticOrder, true, true>(lds, g, S, E, wave); }
        SEAM(4);
    }
    if (IN(5)) {
        volatile LAS int* qslot = (volatile LAS int*)(lds + MISC_OFF + 64);
        for (;;) {
            __syncthreads();
            if (wave == 0 && fresh_lane() == 0) *qslot = (int)__hip_atomic_fetch_add(ctl + CW_QUEUE + 64 * args.li, 1u, __ATOMIC_RELAXED, __HIP_MEMORY_SCOPE_AGENT);
            __syncthreads();
            const int idx = __builtin_amdgcn_readfirstlane(*qslot);
            if (idx >= Q_NITEMS) break;
#ifdef PROBE_QLO
            if (args.li == 1 && (idx < PROBE_QLO || idx >= PROBE_QHI)) continue;
#endif
            if (idx < 32) ml::mlstm_seq(args, lds, 1, idx >> 3, (idx >> 1) & 3, idx & 1, wave);
            else if (idx < 288) { const int j = idx - 32, b = j >> 6, h = (j >> 3) & 7, qb = j & 7;
                att::attn_unit((const bf16_t*)(ws + WS_Q), (const bf16_t*)(ws + WS_K), (const bf16_t*)(ws + WS_KVRAW), HBUF, MC + b * TL + qb * 256, h, MC + b * TL, 32, M + b * 256, 36, (char*)lds_raw, wave); }
            else if (idx < 544) { const int j = idx - 288; ml::mlstm_seq(args, lds, 0, j >> 3, (j >> 1) & 3, j & 1, wave); }
            else { const int j = idx - 544, b = j >> 3, h = j & 7;
                att::attn_unit((const bf16_t*)(ws + WS_Q), (const bf16_t*)(ws + WS_K), (const bf16_t*)(ws + WS_KVRAW), HBUF, b * TC, h, b * TC, 4, 0, 4, (char*)lds_raw, wave); }
        }
        SEAM(5);
    }
    if (IN(6)) { const int lane = fresh_lane(); p6b_hm(args, gw, NGW, lane); SEAM(6); }
    if (IN(7)) {
        pg8::Gemm g{HBUF, (const bf16_t*)(ws + WS_WO), M, DM, DM}; pg8::StaticOrder S; S.init(M, DM, G, bx);
        pg8::EpiMix E{args.in[I_XP], args.in[I_XS], X1, (bf16_t*)(ws + WS_XG), MOD, args.in[I_N2G], (float*)(ctl + CW_ROWSQ)};
        pg8::gemm_phase<pg8::EpiMix, pg8::StaticOrder, true, true>(lds, g, S, E, wave);
        SEAM(7);
    }
    if (IN(8)) {
        pg8::Gemm g{(const bf16_t*)(ws + WS_XG), (const bf16_t*)(ws + WS_WUP), M, FF, DM}; pg8::StaticOrder S; S.init(M, FF, G, bx);
        pg8::EpiUp E{(bf16_t*)(ws + WS_U), (const float*)(ctl + CW_ROWSQ), (const float*)(ws + WS_BIAS2)};
        pg8::gemm_phase<pg8::EpiUp, pg8::StaticOrder, true, true>(lds, g, S, E, wave);
        SEAM(8);
    }
    if (IN(9)) {
        pg8::Gemm g{(const bf16_t*)(ws + WS_U), (const bf16_t*)(ws + WS_WDN), M, DM, FF}; pg8::StaticOrder S; S.init(M, DM, G, bx);
        pg8::EpiDown E{X1, args.out, MOD};
        pg8::gemm_phase<pg8::EpiDown, pg8::StaticOrder, true, true>(lds, g, S, E, wave);
    }
static_assert(ml::LDS_ML <= LDSCTL_OFF && att::LDS_ATT <= LDSCTL_OFF, "phase scratch below the LDS control words");
#undef IN
#undef SEAM
#undef tid
}

extern "C" void kernel_launch(void* const* d_in, const int* in_sizes, int n_in, void* d_out, int out_size, void* d_ws, size_t ws_size, hipStream_t stream) {
    static int grid = 0;
    if (grid == 0) {
        if (n_in != 25 || in_sizes[0] != MC * DM || in_sizes[1] != ML * DM || out_size != (int)O_END || ws_size < WS_END) {
            fprintf(stderr, "kernel_launch: unexpected shapes: n_in %d in0 %d in1 %d out %d ws %zu (need >= %zu); nothing launched\n", n_in, n_in > 0 ? in_sizes[0] : -1, n_in > 1 ? in_sizes[1] : -1, out_size, ws_size, (size_t)WS_END); grid = -1; return; }
        int dev = 0, cus = 0, per_cu = 0;
        if (hipGetDevice(&dev) != hipSuccess || hipDeviceGetAttribute(&cus, hipDeviceAttributeMultiprocessorCount, dev) != hipSuccess) { fprintf(stderr, "kernel_launch: device query failed\n"); grid = -1; return; }
        if (hipFuncSetAttribute((const void*)fwd_megakernel, hipFuncAttributeMaxDynamicSharedMemorySize, LDS_BYTES) != hipSuccess) { fprintf(stderr, "kernel_launch: hipFuncSetAttribute failed\n"); grid = -1; return; }
        if (hipOccupancyMaxActiveBlocksPerMultiprocessor(&per_cu, (const void*)fwd_megakernel, NTHREADS, LDS_BYTES) != hipSuccess || per_cu < 1) {
            fprintf(stderr, "kernel_launch: occupancy query reports %d workgroups per CU; nothing launched\n", per_cu); (void)hipGetLastError(); grid = -1; return; }
        grid = cus;
    }
    if (grid < 0) return;
    if (hipMemsetAsync((char*)d_ws + WS_CTL, 0, CTL_ZERO_BYTES, stream) != hipSuccess) { fprintf(stderr, "kernel_launch: memset failed\n"); return; }
    Args a{};
    for (int i = 0; i < 25; ++i) a.in[i] = (const float*)d_in[i];
    a.out = (float*)d_out; a.ws = (unsigned char*)d_ws;
    static const int plist[] = LAUNCH_LIST;
    for (int li = 0; li < (int)(sizeof(plist) / sizeof(int)) / 2; ++li) {
        a.ph_lo = plist[2 * li]; a.ph_hi = plist[2 * li + 1]; a.li = li;
        hipLaunchKernelGGL(fwd_megakernel, dim3(grid), dim3(NTHREADS), LDS_BYTES, stream, a);
        const hipError_t le = hipPeekAtLastError();
        if (le != hipSuccess) { fprintf(stderr, "kernel_launch: launch %d failed: %s\n", li, hipGetErrorName(le)); break; }
    }
}
```
